# Optimizing an MI355X kernel written in HIP

```python
import math
import jax
import jax.numpy as jnp
from jax import lax
import numpy as np

D_MODEL = 2048
BATCH = 2
SEQ = 8192
DEPTH = 4

N_A = DEPTH // 2
N_B = DEPTH - N_A
D_FF = 5632
FFN_RES = 0.5
PLE_DIM = 256
EPS = 1e-6
GLA_HEADS = 4
GLA_QK = D_MODEL // 2
GLA_V = D_MODEL
GLA_DK = GLA_QK // GLA_HEADS
GLA_DV = GLA_V // GLA_HEADS
GLA_RANK = 16
GLA_GATE_NORM = 16.0
GLA_CHUNK = 64
GLA_IN = 2 * GLA_QK + 2 * GLA_V + GLA_RANK
HEAD_DIM = 64
N_Q_HEADS = D_MODEL // HEAD_DIM
N_KV_HEADS = 4
GROUP = N_Q_HEADS // N_KV_HEADS
Q_W = N_Q_HEADS * HEAD_DIM
KV_W = N_KV_HEADS * HEAD_DIM
WINDOW = 128
BLOCK = WINDOW
N_BUCKETS = 32
MAX_DISTANCE = WINDOW

kernel_name = "yoco_gla_swa_sink_macaron_hybrid"


def rms_norm(x, g):
    xf = x.astype(jnp.float32)
    y = xf * lax.rsqrt(jnp.mean(xf * xf, axis=-1, keepdims=True) + EPS)
    return (y * g.astype(jnp.float32)).astype(x.dtype)


def swiglu(h, wg, wu, wd):
    return (jax.nn.silu(h @ wg) * (h @ wu)) @ wd


def gla_mixer(h, w_in, w_a2, b_a, g_o, w_o):
    bsz, L, _ = h.shape
    H, dk, dv, C = GLA_HEADS, GLA_DK, GLA_DV, GLA_CHUNK
    nc = L // C
    f32 = jnp.float32
    proj = h @ w_in
    q, k, v, r, a1 = jnp.split(proj, [GLA_QK, 2 * GLA_QK, 2 * GLA_QK + GLA_V, 2 * GLA_QK + 2 * GLA_V], axis=-1)
    log_a = jax.nn.log_sigmoid((a1 @ w_a2 + b_a).astype(f32)) / GLA_GATE_NORM

    def to_chunks(t, d):
        return t.reshape(bsz, nc, C, H, d).transpose(0, 3, 1, 2, 4)

    q = to_chunks(q, dk).astype(f32) * (dk ** -0.5)
    k = to_chunks(k, dk).astype(f32)
    v = to_chunks(v, dv).astype(f32)
    b = jnp.cumsum(to_chunks(log_a, dk), axis=3)
    b_last = b[:, :, :, -1:, :]
    q_dec = q * jnp.exp(b)
    k_inv = k * jnp.exp(-b)
    k_dec = k * jnp.exp(b_last - b)
    causal = jnp.tril(jnp.ones((C, C), dtype=bool))
    attn = jnp.where(causal, jnp.einsum('bhnik,bhnjk->bhnij', q_dec, k_inv), 0.0)
    o_intra = jnp.einsum('bhnij,bhnjv->bhniv', attn, v)

    def step(S, xs):
        qd, kd, vv, dec = xs
        o = jnp.einsum('bhck,bhkv->bhcv', qd, S)
        S = dec[..., None] * S + jnp.einsum('bhck,bhcv->bhkv', kd, vv)
        return S, o

    S0 = jnp.zeros((bsz, H, dk, dv), f32)
    xs = (jnp.moveaxis(q_dec, 2, 0), jnp.moveaxis(k_dec, 2, 0), jnp.moveaxis(v, 2, 0),
          jnp.moveaxis(jnp.exp(b_last[:, :, :, 0, :]), 2, 0))
    _, o_inter = lax.scan(step, S0, xs)
    o = o_intra + jnp.moveaxis(o_inter, 0, 2)
    o = o.transpose(0, 2, 3, 1, 4).reshape(bsz, L, H, dv)
    o = rms_norm(o, g_o).astype(h.dtype).reshape(bsz, L, H * dv)
    return (o * jax.nn.silu(r)) @ w_o


def shared_kv(h, g_kv, w_kv, g_k):
    bsz, L, _ = h.shape
    nb = L // BLOCK
    kv = rms_norm(h, g_kv) @ w_kv
    k, v = jnp.split(kv, [KV_W], axis=-1)
    k = rms_norm(k.reshape(bsz, L, N_KV_HEADS, HEAD_DIM), g_k)
    v = v.reshape(bsz, L, N_KV_HEADS, HEAD_DIM)

    def banded(t):
        tb = t.reshape(bsz, nb, BLOCK, N_KV_HEADS, HEAD_DIM)
        prev = jnp.pad(tb[:, :-1], ((0, 0), (1, 0), (0, 0), (0, 0), (0, 0)))
        return jnp.concatenate([prev, tb], axis=2)

    return banded(k), banded(v)


def t5_bucket(d):
    max_exact = N_BUCKETS // 2
    is_small = d < max_exact
    df = jnp.maximum(d, 1).astype(jnp.float32)
    large = max_exact + (jnp.log(df / max_exact) / math.log(MAX_DISTANCE / max_exact)
                         * (N_BUCKETS - max_exact)).astype(jnp.int32)
    large = jnp.minimum(large, N_BUCKETS - 1)
    return jnp.where(is_small, d, large)


def swa_mixer(h, k_band, v_band, bias, mask, w_q, g_q, sinks, w_o):
    bsz, L, _ = h.shape
    nb = L // BLOCK
    q = rms_norm((h @ w_q).reshape(bsz, L, N_KV_HEADS, GROUP, HEAD_DIM), g_q)
    q = q.reshape(bsz, nb, BLOCK, N_KV_HEADS, GROUP, HEAD_DIM)
    s = jnp.einsum('bnqkgd,bnskd->bkgnqs', q, k_band,
                   preferred_element_type=jnp.float32) * (HEAD_DIM ** -0.5)
    s = jnp.where(mask, s + bias, -jnp.inf)
    sink = sinks.astype(jnp.float32).reshape(N_KV_HEADS, GROUP, 1, 1, 1)
    m = jnp.maximum(jnp.max(s, axis=-1, keepdims=True), sink)
    pr = jnp.exp(s - m)
    pr = pr / (jnp.sum(pr, axis=-1, keepdims=True) + jnp.exp(sink - m))
    o = jnp.einsum('bkgnqs,bnskd->bnqkgd', pr.astype(v_band.dtype), v_band)
    return o.reshape(bsz, L, Q_W) @ w_o


def setup_inputs(seed: int = 0) -> dict:
    key = jax.random.key(seed)
    ks = jax.random.split(key, 21)
    f32 = jnp.float32

    def nrm(k, shape, scale):
        return jax.random.normal(k, shape, f32) * scale

    def gain(k, shape):
        return 1.0 + 0.02 * jax.random.normal(k, shape, f32)

    return {
        'x': nrm(ks[0], (BATCH, SEQ, D_MODEL), 1.0),
        'p': nrm(ks[1], (DEPTH, BATCH, SEQ, PLE_DIM), 1.0),
        'norm_g': gain(ks[2], (DEPTH, 4, D_MODEL)),
        'ffn_wg': nrm(ks[3], (DEPTH, 2, D_MODEL, D_FF), D_MODEL ** -0.5),
        'ffn_wu': nrm(ks[4], (DEPTH, 2, D_MODEL, D_FF), D_MODEL ** -0.5),
        'ffn_wd': nrm(ks[5], (DEPTH, 2, D_FF, D_MODEL), D_FF ** -0.5),
        'ple_w': nrm(ks[6], (DEPTH, PLE_DIM, D_MODEL), PLE_DIM ** -0.5),
        'ple_gate_w': nrm(ks[7], (DEPTH, D_MODEL, D_MODEL), D_MODEL ** -0.5),
        'gla_w_in': nrm(ks[8], (N_A, D_MODEL, GLA_IN), D_MODEL ** -0.5),
        'gla_w_a2': nrm(ks[9], (N_A, GLA_RANK, GLA_QK), GLA_RANK ** -0.5),
        'gla_b_a': nrm(ks[10], (N_A, GLA_QK), 0.1),
        'gla_norm_g': gain(ks[11], (N_A, GLA_DV)),
        'gla_w_o': nrm(ks[12], (N_A, GLA_V, D_MODEL), GLA_V ** -0.5),
        'kv_norm_g': gain(ks[13], (D_MODEL,)),
        'w_kv': nrm(ks[14], (D_MODEL, 2 * KV_W), D_MODEL ** -0.5),
        'k_norm_g': gain(ks[15], (HEAD_DIM,)),
        'rel_bias': nrm(ks[16], (N_BUCKETS, N_Q_HEADS), 0.5),
        'swa_w_q': nrm(ks[17], (N_B, D_MODEL, Q_W), D_MODEL ** -0.5),
        'q_norm_g': gain(ks[18], (N_B, HEAD_DIM)),
        'sinks': nrm(ks[19], (N_B, N_Q_HEADS), 0.5),
        'swa_w_o': nrm(ks[20], (N_B, Q_W, D_MODEL), Q_W ** -0.5),
    }


def reference(x, p, norm_g, ffn_wg, ffn_wu, ffn_wd, ple_w, ple_gate_w,
              gla_w_in, gla_w_a2, gla_b_a, gla_norm_g, gla_w_o,
              kv_norm_g, w_kv, k_norm_g, rel_bias, swa_w_q, q_norm_g, sinks, swa_w_o):
    L = x.shape[1]
    nb = L // BLOCK
    qi = jnp.arange(BLOCK)[:, None]
    sj = jnp.arange(2 * BLOCK)[None, :]
    dist = qi + BLOCK - sj
    in_win = (dist >= 0) & (dist < WINDOW)
    kpos = jnp.arange(nb)[:, None, None] * BLOCK - BLOCK + sj[None]
    mask = in_win[None] & (kpos >= 0)
    bias = rel_bias[t5_bucket(jnp.maximum(dist, 0))].astype(jnp.float32)
    bias = bias.transpose(2, 0, 1).reshape(N_KV_HEADS, GROUP, 1, BLOCK, 2 * BLOCK)

    h = x
    k_band = None
    v_band = None
    for i in range(DEPTH):
        if i == N_A:
            k_band, v_band = shared_kv(h, kv_norm_g, w_kv, k_norm_g)
        h = h + FFN_RES * swiglu(rms_norm(h, norm_g[i, 0]), ffn_wg[i, 0], ffn_wu[i, 0], ffn_wd[i, 0])
        hn = rms_norm(h, norm_g[i, 1])
        if i < N_A:
            h = h + gla_mixer(hn, gla_w_in[i], gla_w_a2[i], gla_b_a[i], gla_norm_g[i], gla_w_o[i])
        else:
            j = i - N_A
            h = h + swa_mixer(hn, k_band, v_band, bias, mask, swa_w_q[j], q_norm_g[j], sinks[j], swa_w_o[j])
        h = h + FFN_RES * swiglu(rms_norm(h, norm_g[i, 2]), ffn_wg[i, 1], ffn_wu[i, 1], ffn_wd[i, 1])
        gate = jax.nn.sigmoid(rms_norm(h, norm_g[i, 3]) @ ple_gate_w[i])
        h = h + gate * (p[i] @ ple_w[i])
    return h
```

```cpp
#include <hip/hip_runtime.h>
#include <cstdio>
#include <cstdint>
#define MK_ONE_LAUNCH 1
namespace pg8 {
#define PG8_LAS __attribute__((address_space(3)))
typedef unsigned short bf16_t;
typedef short bf16x8 __attribute__((ext_vector_type(8)));
typedef float f32x4 __attribute__((ext_vector_type(4)));
typedef unsigned u32x4 __attribute__((ext_vector_type(4)));
constexpr int BM = 256, BK = 64, HALF = 128, HTB = HALF * BK * 2  , STAGE_BYTES = 8 * HTB, NXCD = 8, WGM = 8;

__host__ __device__ __forceinline__ int lds_byte(int r, int c) { const int st = (r >> 4) * 2 + (c >> 5), rr = r & 15, cc = c & 31, ob = rr * 64 + cc * 2; return st * 1024 + (ob ^ (((ob >> 9) & 1) << 5)); }
__host__ __device__ __forceinline__ void stage_rc(int b, int& R, int& C) { const int st = b / 1024, sb = b % 1024, swz = sb ^ (((sb >> 9) & 1) << 5); R = (st >> 1) * 16 + swz / 64; C = (st & 1) * 32 + (swz % 64) / 2; }
__host__ __device__ __forceinline__ int perm32(int rho) { const int n = rho >> 4, i = rho & 15; return 8 * (i >> 2) + 4 * n + (i & 3); }

struct Unit { int pm, pn; };
struct Gemm { const bf16_t* A; const bf16_t* Bt; int M, N, K, ld; int pm_mask = -1, pn_mask = -1; };

struct StaticOrder {
    int nM, nN, nwg, G, c, wgm;
    __host__ __device__ void init(int M, int N, int G_, int c_, int wgm_ = WGM) { nM = M / BM; nN = N / BM; nwg = nM * nN; G = G_; c = c_; wgm = wgm_; }
    __host__ __device__ bool next(int i, Unit& u) const {
        const long L = (long)i * G + c; if (L >= nwg) return false;
        int wgid = (int)L; { const int q = nwg / NXCD, r = nwg % NXCD, xcd = wgid % NXCD, off = wgid / NXCD; wgid = (xcd < r ? xcd * (q + 1) : r * (q + 1) + (xcd - r) * q) + off; }
        const int nig = wgm * nN, gid = wgid / nig, fm = gid * wgm, gsz = (nM - fm) < wgm ? (nM - fm) : wgm;
        u.pm = fm + ((wgid % nig) % gsz); u.pn = (wgid % nig) / gsz; return true;
    }
    __device__ __forceinline__ void a_ready(const Unit&) const {}
    __device__ __forceinline__ void done(const Unit&) const {}
};
typedef float cvt_f32x2_t __attribute__((ext_vector_type(2))); typedef __bf16 cvt_bf16x2_t __attribute__((ext_vector_type(2)));
__device__ __forceinline__ unsigned cvt_pk_bf16(float lo, float hi) { cvt_f32x2_t v = {lo, hi}; cvt_bf16x2_t b = __builtin_convertvector(v, cvt_bf16x2_t); return __builtin_bit_cast(unsigned, b); }
typedef float f32x2 __attribute__((ext_vector_type(2)));
constexpr float RMS_EPS = 1e-6f;
constexpr int DM = 2048, DFF = 5632 + 64;
typedef unsigned u32x2 __attribute__((ext_vector_type(2)));
__device__ __forceinline__ float bf2f(unsigned short b) { return __uint_as_float((unsigned)b << 16); }
__device__ __forceinline__ float sigmoid_f(float x) { return __builtin_amdgcn_rcpf(1.0f + __builtin_amdgcn_exp2f(-1.4426950408889634f * x)); }
__device__ __forceinline__ u32x4 pack8(const f32x4& a, const f32x4& b) { u32x4 w; w.x = cvt_pk_bf16(a[0], a[1]); w.y = cvt_pk_bf16(a[2], a[3]); w.z = cvt_pk_bf16(b[0], b[1]); w.w = cvt_pk_bf16(b[2], b[3]); return w; }
__device__ __forceinline__ void unpack8(const u32x4& w, f32x4& a, f32x4& b) {
    a[0] = __uint_as_float(w.x << 16); a[1] = __uint_as_float(w.x & 0xffff0000u); a[2] = __uint_as_float(w.y << 16); a[3] = __uint_as_float(w.y & 0xffff0000u);
    b[0] = __uint_as_float(w.z << 16); b[1] = __uint_as_float(w.z & 0xffff0000u); b[2] = __uint_as_float(w.w << 16); b[3] = __uint_as_float(w.w & 0xffff0000u); }
__device__ __forceinline__ float dot4(const f32x4& a) { return (a[0] * a[0] + a[1] * a[1]) + (a[2] * a[2] + a[3] * a[3]); }
__device__ __forceinline__ void row_rstd8(const float* ss, const Unit& u, int wr, int fr, int fq, float (&rs)[2][4]) {
#pragma unroll
    for (int ai = 0; ai < 2; ++ai)
#pragma unroll
        for (int m = 0; m < 4; ++m) {
            const int row = u.pm * BM + ai * HALF + wr * 64 + m * 16 + fr;
            const f32x4* p = (const f32x4*)(ss + (size_t)row * 32 + fq * 8);
            const f32x4 a = p[0], b = p[1];
            float s = ((a[0] + a[1]) + (a[2] + a[3])) + ((b[0] + b[1]) + (b[2] + b[3]));
            s += __shfl_xor(s, 16); s += __shfl_xor(s, 32);
            rs[ai][m] = 1.0f / sqrtf(s * (1.0f / (float)DM) + RMS_EPS);
        }
}
constexpr int STG_PITCH_B = 20, STG_PITCH_F = 36, STG_BYTES = 16 * STG_PITCH_F * 4;
typedef PG8_LAS unsigned* Stg;
constexpr int STG_LDS_OFF = STAGE_BYTES + 1024;
__device__ __forceinline__ Stg stg_ptr(int wr, int wc) { extern __shared__ __attribute__((aligned(16))) unsigned char pg8_dyn_lds[]; return (Stg)((PG8_LAS unsigned char*)pg8_dyn_lds + STG_LDS_OFF + (wr * 4 + wc) * (16 * 36 * 4)); }
__device__ __forceinline__ int stg_lane() { int l; asm volatile("v_mbcnt_lo_u32_b32 %0, -1, 0\n\tv_mbcnt_hi_u32_b32 %0, -1, %0" : "=v"(l)); return l; }
__device__ __forceinline__ void st_bf16_patch(const Stg S, int ln, int fr, int fq, const u32x4& w, bf16_t* dst, int ld) {
    *(PG8_LAS u32x4*)(S + fr * STG_PITCH_B + 4 * fq) = w;
    const u32x4 t = *(const PG8_LAS u32x4*)(S + (ln >> 2) * STG_PITCH_B + 4 * (ln & 3));
    *(u32x4*)(dst + (size_t)(ln >> 2) * ld + 8 * (ln & 3)) = t;
}
__device__ __forceinline__ void xp_f32_patch(const Stg S, int ln, int fr, int fq, const f32x4& v0, const f32x4& v1, f32x4 (&t)[2]) {
    PG8_LAS float* f = (PG8_LAS float*)S;
    *(PG8_LAS f32x4*)(f + fr * STG_PITCH_F + 8 * fq) = v0; *(PG8_LAS f32x4*)(f + fr * STG_PITCH_F + 8 * fq + 4) = v1;
#pragma unroll
    for (int hf = 0; hf < 2; ++hf) t[hf] = *(const PG8_LAS f32x4*)(f + ((ln >> 3) + 8 * hf) * STG_PITCH_F + 4 * (ln & 7));
}
template <bool NOEPI = false> struct EpiSwiGLU_T {
    static constexpr bool PERM = true, AFTER_DRAIN = false;
    bf16_t* O; const float* ss;;
    __device__ __forceinline__ void operator()(const f32x4 (&acc)[2][2][4][2], const Unit& u, int wr, int wc, int fr, int fq) const {
        if (NOEPI) {
            f32x4 t = {0.f, 0.f, 0.f, 0.f};
#pragma unroll
            for (int ai = 0; ai < 2; ++ai)
#pragma unroll
                for (int bj = 0; bj < 2; ++bj)
#pragma unroll
                    for (int m = 0; m < 4; ++m) { t += acc[ai][bj][m][0]; t += acc[ai][bj][m][1]; }
            if (t[0] + t[1] + t[2] + t[3] == 12345.678f) O[0] = 1;
            return; }
        const int ln = stg_lane(); const Stg sg = stg_ptr(wr, wc);
        float rs[2][4]; row_rstd8(ss, u, wr, fr, fq, rs);
        const int col0 = u.pn * HALF + wc * 32;
#pragma unroll
        for (int ai = 0; ai < 2; ++ai)
#pragma unroll
            for (int m = 0; m < 4; ++m) {
                const int row0 = u.pm * BM + ai * HALF + wr * 64 + m * 16; const float r = rs[ai][m];
                f32x4 o[2];
#pragma unroll
                for (int n = 0; n < 2; ++n) { const f32x4 g = acc[ai][0][m][n] * r, uu = acc[ai][1][m][n] * r;
#pragma unroll
                    for (int i = 0; i < 4; ++i) o[n][i] = g[i] * sigmoid_f(g[i]) * uu[i]; }
                st_bf16_patch(sg, ln, fr, fq, pack8(o[0], o[1]), O + (size_t)row0 * DFF + col0, DFF);
            }
    }
};
typedef EpiSwiGLU_T<false> EpiSwiGLU;
template <bool BASE16 = false, bool OUT32 = true> struct EpiResid_T {
    static constexpr bool PERM = true, AFTER_DRAIN = false;
    const float* base; float* out; bf16_t* hb; float* sso; float scale; const bf16_t* hbi;
    __device__ __forceinline__ void operator()(const f32x4 (&acc)[2][2][4][2], const Unit& u, int wr, int wc, int fr, int fq) const {
        const int ln = stg_lane(); const Stg sg = stg_ptr(wr, wc);
        const int colw = u.pn * BM + wc * 32 + 4 * (ln & 7);
#pragma unroll
        for (int ai = 0; ai < 2; ++ai)
#pragma unroll
            for (int mh = 0; mh < 2; ++mh) {
                const int rowa = u.pm * BM + ai * HALF + wr * 64 + (ln >> 3);
                f32x4 bs[2][2][2];
#pragma unroll
                for (int mm = 0; mm < 2; ++mm)
#pragma unroll
                    for (int bj = 0; bj < 2; ++bj)
#pragma unroll
                        for (int hf = 0; hf < 2; ++hf) { const size_t off = (size_t)(rowa + (2 * mh + mm) * 16 + 8 * hf) * DM + colw + bj * HALF;
                            if (BASE16) { const u32x2 w = *(const u32x2*)(hbi + off); bs[mm][bj][hf] = (f32x4){__uint_as_float(w.x << 16), __uint_as_float(w.x & 0xffff0000u), __uint_as_float(w.y << 16), __uint_as_float(w.y & 0xffff0000u)}; }
                            else bs[mm][bj][hf] = *(const f32x4*)(base + off); }
#pragma unroll
                for (int mm = 0; mm < 2; ++mm) { const int m = 2 * mh + mm;
                    const int row0 = rowa + m * 16; float s[2] = {0.f, 0.f};
#pragma unroll
                    for (int bj = 0; bj < 2; ++bj) {
                        f32x4 t[2]; xp_f32_patch(sg, ln, fr, fq, acc[ai][bj][m][0] * scale, acc[ai][bj][m][1] * scale, t);
#pragma unroll
                        for (int hf = 0; hf < 2; ++hf) { const size_t off = (size_t)(row0 + 8 * hf) * DM + colw + bj * HALF;
                            const f32x4 h = bs[mm][bj][hf] + t[hf];
                            if (OUT32) *(f32x4*)(out + off) = h; u32x2 w; w.x = cvt_pk_bf16(h[0], h[1]); w.y = cvt_pk_bf16(h[2], h[3]); *(u32x2*)(hb + off) = w;
                            s[hf] += dot4(h); }
                    }
#pragma unroll
                    for (int hf = 0; hf < 2; ++hf) { float q = s[hf]; q += __shfl_xor(q, 1); q += __shfl_xor(q, 2); q += __shfl_xor(q, 4);
                        if ((ln & 7) == 0) sso[(size_t)(row0 + 8 * hf) * 32 + u.pn * 4 + wc] = q; }
                }
                asm volatile("" ::: "memory");
            }
    }
};
typedef EpiResid_T<false, true> EpiResid;
template <bool BASE16 = false, bool OUT32 = true> struct EpiPleGate_T {
    static constexpr bool PERM = true, AFTER_DRAIN = false;
    float* h; bf16_t* hb; const float* ssi; float* sso; const bf16_t* pp; const bf16_t* hbi;
    __device__ __forceinline__ void operator()(const f32x4 (&acc)[2][2][4][2], const Unit& u, int wr, int wc, int fr, int fq) const {
        const int ln = stg_lane(); const Stg sg = stg_ptr(wr, wc);
        float rs[2][4]; row_rstd8(ssi, u, wr, fr, fq, rs);
        const int colw = u.pn * BM + wc * 32 + 4 * (ln & 7);
#pragma unroll
        for (int ai = 0; ai < 2; ++ai)
#pragma unroll
            for (int m = 0; m < 4; ++m) {
                const int row0 = u.pm * BM + ai * HALF + wr * 64 + m * 16 + (ln >> 3); const float r = rs[ai][m]; float s[2] = {0.f, 0.f};
                f32x4 bs[2][2]; u32x2 pq[2][2];
#pragma unroll
                for (int bj = 0; bj < 2; ++bj)
#pragma unroll
                    for (int hf = 0; hf < 2; ++hf) { const size_t off = (size_t)(row0 + 8 * hf) * DM + colw + bj * HALF; pq[bj][hf] = *(const u32x2*)(pp + off);
                        if (BASE16) { const u32x2 w = *(const u32x2*)(hbi + off); bs[bj][hf] = (f32x4){__uint_as_float(w.x << 16), __uint_as_float(w.x & 0xffff0000u), __uint_as_float(w.y << 16), __uint_as_float(w.y & 0xffff0000u)}; }
                        else bs[bj][hf] = *(const f32x4*)(h + off); }
#pragma unroll
                for (int bj = 0; bj < 2; ++bj) {
                    f32x4 g0, g1;
#pragma unroll
                    for (int i = 0; i < 4; ++i) { g0[i] = sigmoid_f(acc[ai][bj][m][0][i] * r); g1[i] = sigmoid_f(acc[ai][bj][m][1][i] * r); }
                    f32x4 t[2]; xp_f32_patch(sg, ln, fr, fq, g0, g1, t);
#pragma unroll
                    for (int hf = 0; hf < 2; ++hf) { const size_t off = (size_t)(row0 + 8 * hf) * DM + colw + bj * HALF;
                        const u32x2 pw = pq[bj][hf]; f32x4 pv; pv[0] = __uint_as_float(pw.x << 16); pv[1] = __uint_as_float(pw.x & 0xffff0000u); pv[2] = __uint_as_float(pw.y << 16); pv[3] = __uint_as_float(pw.y & 0xffff0000u);
                        const f32x4 hn = bs[bj][hf] + t[hf] * pv;
                        if (OUT32) *(f32x4*)(h + off) = hn; u32x2 w; w.x = cvt_pk_bf16(hn[0], hn[1]); w.y = cvt_pk_bf16(hn[2], hn[3]); *(u32x2*)(hb + off) = w;
                        s[hf] += dot4(hn); }
                }
#pragma unroll
                for (int hf = 0; hf < 2; ++hf) { float q = s[hf]; q += __shfl_xor(q, 1); q += __shfl_xor(q, 2); q += __shfl_xor(q, 4);
                    if ((ln & 7) == 0) sso[(size_t)(row0 + 8 * hf) * 32 + u.pn * 4 + wc] = q; }
                asm volatile("" ::: "memory");
            }
    }
};
typedef EpiPleGate_T<false, true> EpiPleGate;
struct EpiInProj {
    static constexpr bool PERM = true, AFTER_DRAIN = false;
    bf16_t *qb, *kb, *vb, *rb; float* la; const float* ss; const float* b_a;;
    __device__ __forceinline__ void operator()(const f32x4 (&acc)[2][2][4][2], const Unit& u, int wr, int wc, int fr, int fq) const {
        const int ln = stg_lane(); const Stg sg = stg_ptr(wr, wc);
        float rs[2][4]; row_rstd8(ss, u, wr, fr, fq, rs);
        const int pn = u.pn; int mode, ld, colt; bf16_t* O;
        if (pn < 4) { mode = 0; O = qb; ld = 1024; colt = pn * BM; } else if (pn < 8) { mode = 1; O = kb; ld = 1024; colt = (pn - 4) * BM; }
        else if (pn < 16) { mode = 2; O = vb; ld = 2048; colt = (pn - 8) * BM; } else if (pn < 24) { mode = 3; O = rb; ld = 2048; colt = (pn - 16) * BM; }
        else { mode = 4; O = nullptr; ld = 1024; colt = (pn - 24) * BM; }
        const int colp = colt + wc * 32;
        f32x4 bv[2][2];
#pragma unroll
        for (int bj = 0; bj < 2; ++bj)
#pragma unroll
            for (int n = 0; n < 2; ++n) bv[bj][n] = (mode == 4) ? *(const f32x4*)(b_a + colp + 8 * fq + bj * HALF + 4 * n) : (f32x4){0.f, 0.f, 0.f, 0.f};
#pragma unroll
        for (int ai = 0; ai < 2; ++ai)
#pragma unroll
            for (int m = 0; m < 4; ++m) {
                const int row0 = u.pm * BM + ai * HALF + wr * 64 + m * 16; const float r = rs[ai][m];
#pragma unroll
                for (int bj = 0; bj < 2; ++bj) {
                    f32x4 v0 = acc[ai][bj][m][0] * r, v1 = acc[ai][bj][m][1] * r;
                    if (mode == 4) {
                        v0 = v0 + bv[bj][0]; v1 = v1 + bv[bj][1];
#pragma unroll
                        for (int i = 0; i < 4; ++i) {
                            v0[i] = (fminf(v0[i], 0.f) - __logf(1.0f + __expf(-fabsf(v0[i])))) * 0.0625f;
                            v1[i] = (fminf(v1[i], 0.f) - __logf(1.0f + __expf(-fabsf(v1[i])))) * 0.0625f; }
                        f32x4 t[2]; xp_f32_patch(sg, ln, fr, fq, v0, v1, t);
#pragma unroll
                        for (int hf = 0; hf < 2; ++hf) *(f32x4*)(la + (size_t)(row0 + (ln >> 3) + 8 * hf) * 1024 + colp + bj * HALF + 4 * (ln & 7)) = t[hf];
                    } else {
                        if (mode == 0) { v0 = v0 * 0.0625f; v1 = v1 * 0.0625f; }
                        if (mode == 3) {
#pragma unroll
                            for (int i = 0; i < 4; ++i) { v0[i] = v0[i] * sigmoid_f(v0[i]); v1[i] = v1[i] * sigmoid_f(v1[i]); } }
                        st_bf16_patch(sg, ln, fr, fq, pack8(v0, v1), O + (size_t)row0 * ld + colp + bj * HALF, ld);
                    }
                }
            }
    }
};
struct EpiHeadNorm {
    static constexpr bool PERM = true, AFTER_DRAIN = false;
    bf16_t* O0; bf16_t* O1; int ld; const float* ss; const float* g; float oscale; int norm_tiles;;
    __device__ __forceinline__ void operator()(const f32x4 (&acc)[2][2][4][2], const Unit& u, int wr, int wc, int fr, int fq) const {
        const int ln = stg_lane(); const Stg sg = stg_ptr(wr, wc);
        float rs[2][4]; row_rstd8(ss, u, wr, fr, fq, rs);
        const bool nrm = u.pn < norm_tiles; bf16_t* O = nrm ? O0 : O1; const int colp = (nrm ? u.pn : u.pn - norm_tiles) * BM + 64 * wc;
        f32x4 gv[2][2];
#pragma unroll
        for (int bj = 0; bj < 2; ++bj)
#pragma unroll
            for (int n = 0; n < 2; ++n) gv[bj][n] = *(const f32x4*)(g + 32 * bj + 8 * fq + 4 * n) * oscale;
#pragma unroll
        for (int ai = 0; ai < 2; ++ai)
#pragma unroll
            for (int m = 0; m < 4; ++m) {
                const int row0 = u.pm * BM + ai * HALF + wr * 64 + m * 16; const float r = rs[ai][m];
                f32x4 v[2][2]; float s = 0.f;
#pragma unroll
                for (int bj = 0; bj < 2; ++bj)
#pragma unroll
                    for (int n = 0; n < 2; ++n) { v[bj][n] = acc[ai][bj][m][n] * r; s += dot4(v[bj][n]); }
                s += __shfl_xor(s, 16); s += __shfl_xor(s, 32);
                const float hn = 1.0f / sqrtf(s * (1.0f / 64.0f) + RMS_EPS);
#pragma unroll
                for (int bj = 0; bj < 2; ++bj) {
                    f32x4 o0 = v[bj][0], o1 = v[bj][1];
                    if (nrm) { o0 = o0 * hn * gv[bj][0]; o1 = o1 * hn * gv[bj][1]; }
                    st_bf16_patch(sg, ln, fr, fq, pack8(o0, o1), O + (size_t)row0 * ld + colp + 32 * bj, ld);
                }
            }
    }
};
struct EpiPlainBf16 {
    static constexpr bool PERM = true, AFTER_DRAIN = false;
    bf16_t* O; int ld;;
    __device__ __forceinline__ void operator()(const f32x4 (&acc)[2][2][4][2], const Unit& u, int wr, int wc, int fr, int fq) const {
        const int ln = stg_lane(); const Stg sg = stg_ptr(wr, wc);
        const int colp = u.pn * BM + wc * 32;
#pragma unroll
        for (int ai = 0; ai < 2; ++ai)
#pragma unroll
            for (int m = 0; m < 4; ++m) {
                const int row0 = u.pm * BM + ai * HALF + wr * 64 + m * 16;
#pragma unroll
                for (int bj = 0; bj < 2; ++bj) { st_bf16_patch(sg, ln, fr, fq, pack8(acc[ai][bj][m][0], acc[ai][bj][m][1]), O + (size_t)row0 * ld + colp + bj * HALF, ld); asm volatile("" ::: "memory"); }
            }
    }
};
template <class Epi, class Sched, bool ALIGN_EPI = false, bool SP2 = false, int DIAG = 0  >
__device__ __forceinline__ void gemm_phase(PG8_LAS unsigned char* lds, const Gemm g, const Sched& S, const Epi& E) {
    int tid_l_ = threadIdx.x; asm volatile("" : "+v"(tid_l_));
    const int tid = tid_l_, wid = __builtin_amdgcn_readfirstlane(tid >> 6), lane = tid & 63, wr = wid >> 2, wc = wid & 3, fr = lane & 15, fq = lane >> 4;
    const int K = g.K, nt = K / BK, ld = g.ld;
    unsigned voffA[2], voffB[2];
#pragma unroll
    for (int i = 0; i < 2; ++i) { int R, C; stage_rc(tid * 16 + i * 8192, R, C); const int Rb = Epi::PERM ? ((R & ~31) + perm32(R & 31)) : R;
        voffA[i] = (unsigned)(R * ld + C) * 2u; voffB[i] = (unsigned)(Rb * ld + C) * 2u; }
    const size_t kstep = (size_t)(BK * 2);
    const size_t hstep = (size_t)HALF * ld * 2;
    const size_t tstep = 2 * hstep;
    const unsigned ldsw = (unsigned)wid * 1024u;
    const int aoff = lds_byte(wr * 64 + fr, fq * 8), boff = lds_byte(wc * 32 + fr, fq * 8);
#define PG8_SA(b, h) (((b) * 2 + (h)) * HTB)
#define PG8_SB(b, h) ((4 + (b) * 2 + (h)) * HTB)
#define PG8_STAGE(bufoff, gbase, voff) do { _Pragma("unroll") for (int _i = 0; _i < 2; ++_i) \
        __builtin_amdgcn_global_load_lds((const unsigned*)((const char*)(gbase) + (voff)[_i]), (PG8_LAS unsigned*)(lds + (bufoff) + ldsw + _i * 8192), 16, 0, 0); } while (0)
#define PG8_LDA(dst, b, h) do { _Pragma("unroll") for (int m = 0; m < 4; ++m) _Pragma("unroll") for (int k = 0; k < 2; ++k) dst[m][k] = *(const PG8_LAS bf16x8*)(lds + PG8_SA(b, h) + aoff + m * 2048 + k * 1024); } while (0)
#define PG8_LDB(dst, b, h) do { _Pragma("unroll") for (int n = 0; n < 2; ++n) _Pragma("unroll") for (int k = 0; k < 2; ++k) dst[n][k] = *(const PG8_LAS bf16x8*)(lds + PG8_SB(b, h) + boff + n * 2048 + k * 1024); } while (0)
#define PG8_MMA(ai, bj, At, Bt) do { if (DIAG == 1 && (ai) == 1) break; __builtin_amdgcn_s_setprio(1); _Pragma("unroll") for (int m = 0; m < 4; ++m) _Pragma("unroll") for (int n = 0; n < 2; ++n) _Pragma("unroll") for (int k = 0; k < 2; ++k) \
        acc[ai][bj][m][n] = __builtin_amdgcn_mfma_f32_16x16x32_bf16(Bt[n][k], At[m][k], acc[ai][bj][m][n], 0, 0, 0); __builtin_amdgcn_s_setprio(0); } while (0)
#define PG8_WAIT_V(n) asm volatile("s_waitcnt vmcnt(" #n ")" ::: "memory")
#define PG8_WAIT_L(n) asm volatile("s_waitcnt lgkmcnt(" #n ")" ::: "memory")
#define PG8_BAR __builtin_amdgcn_s_barrier()
#define PG8_SCHED __builtin_amdgcn_sched_barrier(0)
    Unit cur, nxt; int ui = 0;
    if (!S.next(0, cur)) return;
    f32x4 acc[2][2][4][2];
#pragma unroll
    for (int a = 0; a < 2; ++a)
#pragma unroll
        for (int b = 0; b < 2; ++b)
#pragma unroll
            for (int m = 0; m < 4; ++m)
#pragma unroll
                for (int n = 0; n < 2; ++n) acc[a][b][m][n] = (f32x4){0.f, 0.f, 0.f, 0.f};
    bf16x8 At[4][2], B0[2][2], B1[2][2];
    const char* cA = (const char*)g.A + (size_t)(cur.pm & g.pm_mask) * tstep; const char* cB = (const char*)g.Bt + (size_t)(cur.pn & g.pn_mask) * tstep;
    S.a_ready(cur);
    if constexpr (SP2) {
        PG8_STAGE(PG8_SB(0, 0), cB, voffB); PG8_STAGE(PG8_SB(0, 1), cB + hstep, voffB); PG8_STAGE(PG8_SA(0, 0), cA, voffA); PG8_STAGE(PG8_SA(0, 1), cA + hstep, voffA);
        if (wr == 1) PG8_BAR;
        PG8_WAIT_V(2); PG8_BAR;
        PG8_STAGE(PG8_SB(1, 0), cB + kstep, voffB); PG8_STAGE(PG8_SA(1, 0), cA + kstep, voffA); PG8_STAGE(PG8_SB(1, 1), cB + hstep + kstep, voffB);
        PG8_WAIT_V(6); PG8_BAR;
    } else {
        PG8_STAGE(PG8_SB(0, 0), cB, voffB); PG8_STAGE(PG8_SA(0, 0), cA, voffA); PG8_STAGE(PG8_SB(0, 1), cB + hstep, voffB); PG8_STAGE(PG8_SA(0, 1), cA + hstep, voffA);
        if (wr == 1) PG8_BAR;
        PG8_WAIT_V(4); PG8_BAR;
        PG8_STAGE(PG8_SB(1, 0), cB + kstep, voffB); PG8_STAGE(PG8_SA(1, 0), cA + kstep, voffA); PG8_STAGE(PG8_SB(1, 1), cB + hstep + kstep, voffB);
        PG8_WAIT_V(6); PG8_BAR;
    }
    for (;;) {
        const bool has_next = S.next(ui + 1, nxt);
        const char* nA = has_next ? (const char*)g.A + (size_t)(nxt.pm & g.pm_mask) * tstep : cA; const char* nB = has_next ? (const char*)g.Bt + (size_t)(nxt.pn & g.pn_mask) * tstep : cB;
        for (int t = 0; t < nt; t += 2) {
            const bool last = (t == nt - 2);
            const char* a1 = cA + (size_t)(t + 1) * kstep;
            const char* a2 = last ? nA : cA + (size_t)(t + 2) * kstep; const char* b2 = last ? nB : cB + (size_t)(t + 2) * kstep;
            const char* a3 = a2 + kstep; const char* b3 = b2 + kstep;
            if (last && has_next) S.a_ready(nxt);
            if constexpr (SP2) {
            PG8_LDB(B0, 0, 0); PG8_LDB(B1, 0, 1); PG8_SCHED; PG8_LDA(At, 0, 0); PG8_STAGE(PG8_SA(1, 1), a1 + hstep, voffA);
            PG8_WAIT_V(8); PG8_WAIT_L(0); PG8_BAR; PG8_MMA(0, 0, At, B0); PG8_MMA(0, 1, At, B1); PG8_BAR; PG8_SCHED;
            PG8_LDA(At, 0, 1); PG8_STAGE(PG8_SB(0, 0), b2, voffB); PG8_STAGE(PG8_SB(0, 1), b2 + hstep, voffB); PG8_STAGE(PG8_SA(0, 0), a2, voffA);
            PG8_WAIT_V(8); PG8_WAIT_L(0); PG8_BAR; PG8_MMA(1, 0, At, B0); PG8_MMA(1, 1, At, B1); PG8_BAR; PG8_SCHED;
            PG8_LDB(B0, 1, 0); PG8_LDB(B1, 1, 1); PG8_SCHED; PG8_LDA(At, 1, 0); PG8_STAGE(PG8_SA(0, 1), a2 + hstep, voffA);
            PG8_WAIT_V(8); PG8_WAIT_L(0); PG8_BAR; PG8_MMA(0, 0, At, B0); PG8_MMA(0, 1, At, B1); PG8_BAR; PG8_SCHED;
            PG8_LDA(At, 1, 1); PG8_STAGE(PG8_SB(1, 0), b3, voffB); PG8_STAGE(PG8_SB(1, 1), b3 + hstep, voffB); PG8_STAGE(PG8_SA(1, 0), a3, voffA);
            PG8_WAIT_V(8); PG8_WAIT_L(0); PG8_BAR; PG8_MMA(1, 0, At, B0); PG8_MMA(1, 1, At, B1); PG8_BAR; PG8_SCHED;
            } else {
            PG8_LDB(B0, 0, 0); PG8_SCHED; PG8_LDA(At, 0, 0); PG8_STAGE(PG8_SA(1, 1), a1 + hstep, voffA);
            PG8_WAIT_L(8); PG8_BAR; PG8_WAIT_L(0); PG8_MMA(0, 0, At, B0); PG8_BAR; PG8_SCHED;
            PG8_LDB(B1, 0, 1); PG8_STAGE(PG8_SB(0, 0), b2, voffB);
            PG8_BAR; PG8_WAIT_L(0); PG8_MMA(0, 1, At, B1); PG8_BAR;
            PG8_LDA(At, 0, 1); PG8_STAGE(PG8_SA(0, 0), a2, voffA);
            PG8_BAR; PG8_WAIT_L(0); PG8_MMA(1, 0, At, B0); PG8_BAR; PG8_SCHED;
            PG8_STAGE(PG8_SB(0, 1), b2 + hstep, voffB);
            PG8_WAIT_V(6); PG8_BAR; PG8_MMA(1, 1, At, B1); PG8_BAR;
            PG8_LDB(B0, 1, 0); PG8_SCHED; PG8_LDA(At, 1, 0); PG8_STAGE(PG8_SA(0, 1), a2 + hstep, voffA);
            PG8_WAIT_L(8); PG8_BAR; PG8_WAIT_L(0); PG8_MMA(0, 0, At, B0); PG8_BAR; PG8_SCHED;
            PG8_LDB(B1, 1, 1); PG8_STAGE(PG8_SB(1, 0), b3, voffB);
            PG8_BAR; PG8_WAIT_L(0); PG8_MMA(0, 1, At, B1); PG8_BAR;
            PG8_LDA(At, 1, 1); PG8_STAGE(PG8_SA(1, 0), a3, voffA);
            PG8_BAR; PG8_WAIT_L(0); PG8_MMA(1, 0, At, B0); PG8_BAR; PG8_SCHED;
            PG8_STAGE(PG8_SB(1, 1), b3 + hstep, voffB);
            PG8_WAIT_V(6); PG8_BAR; PG8_MMA(1, 1, At, B1); PG8_BAR;
            }
        }
        if constexpr (ALIGN_EPI) { if (wr == 0) PG8_BAR; }
        if constexpr (!Epi::AFTER_DRAIN) { E(acc, cur, wr, wc, fr, fq); S.done(cur); }
        if (!has_next) break;
#pragma unroll
        for (int a = 0; a < 2; ++a)
#pragma unroll
            for (int b = 0; b < 2; ++b)
#pragma unroll
                for (int m = 0; m < 4; ++m)
#pragma unroll
                    for (int n = 0; n < 2; ++n) acc[a][b][m][n] = (f32x4){0.f, 0.f, 0.f, 0.f};
        cur = nxt; cA = nA; cB = nB; ++ui;
        if constexpr (ALIGN_EPI) { if (wr == 1) PG8_BAR; }
    }
    PG8_WAIT_V(0);
    if constexpr (!ALIGN_EPI) { if (wr == 0) PG8_BAR; }
    PG8_BAR;
    if constexpr (Epi::AFTER_DRAIN) { E.fused(acc, cur, wr, wc, fr, fq, lds, wid, lane); S.done(cur); }
#undef PG8_SA
#undef PG8_SB
#undef PG8_STAGE
#undef PG8_LDA
#undef PG8_LDB
#undef PG8_MMA
#undef PG8_WAIT_V
#undef PG8_WAIT_L
#undef PG8_BAR
#undef PG8_SCHED
}
}

constexpr int NWAVES = 8;
constexpr int BATCH = 2, SEQ = 8192, M = BATCH * SEQ, D = 2048, FF = 5632, DEPTH = 4, PLE = 256;
constexpr int LDF = pg8::DFF;
constexpr int NUP = 2 * FF;
constexpr int GIN = 6160, NIN = 7168;
constexpr int NCHUNK = 128;
constexpr int NPH = 1 + 10 * DEPTH;

constexpr size_t MiB = 1u << 20;
constexpr size_t WS_CTL = 0, CTL_ZERO_BYTES = 1 * MiB;
constexpr size_t WS_WUP = 1 * MiB;
constexpr size_t WS_WDN = WS_WUP + 352 * MiB;
constexpr size_t WS_WGATE = WS_WDN + 184 * MiB;
constexpr size_t WS_WPLE = WS_WGATE + 32 * MiB;
constexpr size_t WS_WIN = WS_WPLE + 4 * MiB;
constexpr size_t WS_WGO = WS_WIN + 56 * MiB;
constexpr size_t WS_WKV = WS_WGO + 16 * MiB;
constexpr size_t WS_WQ = WS_WKV + 2 * MiB;
constexpr size_t WS_WSO = WS_WQ + 16 * MiB;
constexpr size_t WS_HB = WS_WSO + 16 * MiB;
constexpr size_t WS_SS = WS_HB + 128 * MiB;
constexpr size_t WS_PB = WS_SS + 4 * MiB;
constexpr size_t WS_PP = WS_PB + 32 * MiB;
constexpr size_t WS_KX = WS_PP + 64 * MiB;
constexpr size_t WS_VX = WS_KX + 8 * MiB;
constexpr size_t WS_SCR = WS_VX + 8 * MiB;
constexpr size_t WS_ACT = WS_SCR;
constexpr size_t WS_QB = WS_SCR, WS_KB = WS_SCR + 32 * MiB, WS_VB = WS_SCR + 64 * MiB, WS_RB = WS_SCR + 128 * MiB;
constexpr size_t WS_LA = WS_SCR + 192 * MiB;
constexpr size_t WS_QD = WS_SCR + 256 * MiB, WS_KDT = WS_SCR + 288 * MiB, WS_AT = WS_SCR + 320 * MiB, WS_DEC = WS_SCR + 328 * MiB;
constexpr size_t WS_OB = WS_SCR + 336 * MiB;
constexpr size_t WS_OG = WS_SCR;
constexpr size_t WS_QN = WS_SCR, WS_AO = WS_SCR + 64 * MiB;
constexpr size_t WS_END = WS_SCR + 464 * MiB;
constexpr int CW_TMO = 0, CW_CODE = 1, CW_BAR = 4096;

constexpr int RING_OFF = 0, RING_BYTES = 131072;
constexpr int LDSCTL_OFF = RING_BYTES, MISC_OFF = LDSCTL_OFF + 320;
constexpr int STG_OFF = pg8::STG_LDS_OFF; static_assert(STG_OFF == RING_BYTES + 1024, "staging tiles");
constexpr int LDS_BYTES = STG_OFF + 8 * pg8::STG_BYTES;

#define GAS __attribute__((address_space(1)))
#define LAS __attribute__((address_space(3)))
typedef unsigned short bf16;
typedef unsigned v4u __attribute__((ext_vector_type(4)));
typedef unsigned v2u __attribute__((ext_vector_type(2)));
typedef float f32x4 __attribute__((ext_vector_type(4)));
typedef short bf16x8 __attribute__((ext_vector_type(8)));
typedef GAS unsigned gu32;
#define RLX_AGENT __ATOMIC_RELAXED, __HIP_MEMORY_SCOPE_AGENT
#define LDS_WAIT() asm volatile("s_waitcnt lgkmcnt(0)" ::: "memory")
#define VM_WAIT() asm volatile("s_waitcnt vmcnt(0)" ::: "memory")
__device__ __forceinline__ unsigned pk2(float lo, float hi) { return pg8::cvt_pk_bf16(lo, hi); }
__device__ __forceinline__ float bf2f(unsigned short b) { return __uint_as_float((unsigned)b << 16); }
__device__ __forceinline__ unsigned short f2bf(float f) { return (unsigned short)(pg8::cvt_pk_bf16(f, 0.f) & 0xffffu); }
#define MFMA16(a, b, c) __builtin_amdgcn_mfma_f32_16x16x32_bf16((a), (b), (c), 0, 0, 0)

#define XB_TMO      128
#define XB_XCNT(j)  (256  + 64 * (j))
#define XB_XSUB(j)  (1280 + 64 * (j))
#define XB_XGEN(j)  (2304 + 64 * (j))
#define XB_TOP      3328
#define XB_TOPGEN   3392
#define XCD_BAR_WORDS 3456
#define XB_SPIN_CAP (1u << 18)

__device__ __forceinline__ unsigned xb_ld(unsigned* p)              { return __hip_atomic_load(p, __ATOMIC_RELAXED, __HIP_MEMORY_SCOPE_AGENT); }
__device__ __forceinline__ unsigned xb_add(unsigned* p, unsigned v) { return __hip_atomic_fetch_add(p, v, __ATOMIC_RELAXED, __HIP_MEMORY_SCOPE_AGENT); }
__device__ __forceinline__ unsigned xb_xcc_id() { return (unsigned)__builtin_amdgcn_s_getreg((3 << 11) | 20) & 0xFu; }
#define XB_SPIN(cond, bar) do { unsigned _sp = 0; while (cond) { __builtin_amdgcn_s_sleep(1); \
    if ((++_sp & 255u) == 0u) { if (xb_ld(&(bar)[XB_TMO])) break; if (_sp > XB_SPIN_CAP) { atomicAdd(&(bar)[XB_TMO], 1u); break; } } } } while (0)

struct XcdBarrier {
    unsigned* bar; unsigned x;
    volatile LAS unsigned* st;
};

__device__ __forceinline__ XcdBarrier xcd_barrier_post(unsigned* bar, volatile LAS unsigned* st) {
    XcdBarrier b; b.bar = bar; b.x = xb_xcc_id(); b.st = st;
    if (threadIdx.x == 0) (void)xb_add(&bar[XB_XCNT(b.x)], 1u);
    return b;
}
__device__ __forceinline__ void xcd_barrier_complete(unsigned* bar, unsigned x, unsigned& nloc, unsigned& nx) {
    const unsigned G = gridDim.x * gridDim.y * gridDim.z;
    unsigned sum, cnt, mine, sp = 0u;
    for (;;) {
        sum = 0u; cnt = 0u; mine = 0u;
#pragma unroll
        for (unsigned j = 0; j < 16; ++j) { const unsigned c = xb_ld(&bar[XB_XCNT(j)]); sum += c; cnt += (c > 0u) ? 1u : 0u; mine = (j == x) ? c : mine; }
        if (sum == G) break;
        __builtin_amdgcn_s_sleep(1);
        if ((++sp & 255u) == 0u) { if (xb_ld(&bar[XB_TMO])) break; if (sp > XB_SPIN_CAP) { atomicAdd(&bar[XB_TMO], 1u); break; } }
    }
    nloc = mine > 0u ? mine : 1u; nx = cnt > 0u ? cnt : 1u;
}

__device__ __forceinline__ void xcd_barrier(const XcdBarrier& b) {
    asm volatile("s_waitcnt vmcnt(0)" ::: "memory");
    __syncthreads();
    if (threadIdx.x == 0) {
        unsigned* bar = b.bar;
        __builtin_amdgcn_s_waitcnt(0);
        unsigned nloc = b.st[0], nx = b.st[1];
        if (nloc == 0u) { xcd_barrier_complete(bar, b.x, nloc, nx); b.st[0] = nloc; b.st[1] = nx; }
        const unsigned old = xb_add(&bar[XB_XSUB(b.x)], 1u);
        const unsigned gen = old / nloc;
        if (old + 1u == (gen + 1u) * nloc) {
            __builtin_amdgcn_fence(__ATOMIC_RELEASE, "agent");
            asm volatile("s_waitcnt vmcnt(0)" ::: "memory");
            const unsigned og = xb_add(&bar[XB_TOP], 1u);
            const unsigned tg = og / nx;
            if (og + 1u == (tg + 1u) * nx) xb_add(&bar[XB_TOPGEN], 1u);
            else XB_SPIN(xb_ld(&bar[XB_TOPGEN]) == tg, bar);
            __builtin_amdgcn_fence(__ATOMIC_ACQUIRE, "agent");
            xb_add(&bar[XB_XGEN(b.x)], 1u);
            asm volatile("s_waitcnt vmcnt(0)" ::: "memory");
        } else {
            XB_SPIN(xb_ld(&bar[XB_XGEN(b.x)]) == gen, bar);
            __builtin_amdgcn_fence(__ATOMIC_ACQUIRE, "agent");
            asm volatile("s_waitcnt vmcnt(0)" ::: "memory");
        }
    }
    __syncthreads();
}

struct Frame {
    LAS unsigned char* lds;
    volatile LAS unsigned* MISC;
    gu32* ctl;
    int tid, lane, wave;
    int vcu, G;
};
__device__ __forceinline__ float wave_sum(float v) {
#pragma unroll
    for (int o = 1; o < 64; o <<= 1) v += __shfl_xor(v, o);
    return v;
}

__device__ __forceinline__ void p0_store_item(LAS float* scr, bf16* WT, int K, int k0, int dst_row0, int lane) {
    LDS_WAIT(); asm volatile("" ::: "memory");
    const int c = lane & 7;
#pragma unroll
    for (int j = 0; j < 4; ++j) { const int n = (lane >> 3) + 8 * j; const LAS float* s = scr + (8 * c) * 33 + n;
        v4u o; o.x = pk2(s[0 * 33], s[1 * 33]); o.y = pk2(s[2 * 33], s[3 * 33]); o.z = pk2(s[4 * 33], s[5 * 33]); o.w = pk2(s[6 * 33], s[7 * 33]);
        *(GAS v4u*)(WT + (size_t)(dst_row0 + n) * K + k0 + 8 * c) = o; }
    LDS_WAIT(); asm volatile("" ::: "memory");
}
__device__ __forceinline__ void p0_item(const float* W, int N, int n0, int k0, const float* gain, int gmask, bf16* WT, int K, int dst_row0, LAS float* scr, int lane) {
    float v[32];
#pragma unroll
    for (int i = 0; i < 32; ++i) { const int k = k0 + 2 * i + (lane >> 5); v[i] = W[(size_t)k * N + n0 + (lane & 31)]; }
    if (gain) {
#pragma unroll
        for (int i = 0; i < 32; ++i) { const int k = k0 + 2 * i + (lane >> 5); v[i] *= gain[k & gmask]; } }
#pragma unroll
    for (int i = 0; i < 32; ++i) scr[(2 * i + (lane >> 5)) * 33 + (lane & 31)] = v[i];
    p0_store_item(scr, WT, K, k0, dst_row0, lane);
}
__device__ __forceinline__ void p0_item_gatefold(const float* win, const float* wa2, int n0, int k0, const float* gain, bf16* WT, LAS float* scr, int lane) {
    float a2[16];
#pragma unroll
    for (int r = 0; r < 16; ++r) a2[r] = wa2[r * 1024 + n0 + (lane & 31)];
#pragma unroll 2
    for (int i = 0; i < 32; ++i) { const int kk = 2 * i + (lane >> 5), k = k0 + kk; const f32x4* wr = (const f32x4*)(win + (size_t)k * GIN + 6144);
        float s = 0.f;
#pragma unroll
        for (int q = 0; q < 4; ++q) { const f32x4 w = wr[q]; s += w[0] * a2[4 * q] + w[1] * a2[4 * q + 1] + w[2] * a2[4 * q + 2] + w[3] * a2[4 * q + 3]; }
        scr[kk * 33 + (lane & 31)] = s * gain[k]; }
    p0_store_item(scr, WT, D, k0, 6144 + n0, lane);
}
struct In { const float *x, *p, *norm_g, *ffn_wg, *ffn_wu, *ffn_wd, *ple_w, *ple_gate_w, *gla_w_in, *gla_w_a2, *gla_b_a, *gla_norm_g, *gla_w_o, *kv_norm_g, *w_kv, *k_norm_g, *rel_bias, *swa_w_q, *q_norm_g, *sinks, *swa_w_o; };

__device__ __forceinline__ void p0_prologue(Frame& F, const In& I, unsigned char* ws) {
    LAS float* scr = (LAS float*)(F.lds + RING_OFF + F.wave * 16384);
    const int gw = F.vcu * NWAVES + F.wave, NGW = F.G * NWAVES, lane = F.lane;
    constexpr int IT_UP = 32 * 176, IT_DN = 88 * 64, IT_SQ = 32 * 64, IT_PLE = 4 * 64, IT_IN = 32 * 192, IT_GF = 32 * 32, IT_KV = 32 * 16;
    constexpr int C1 = 8 * IT_UP, C2 = C1 + 8 * IT_UP, C3 = C2 + 8 * IT_DN, C4 = C3 + 4 * IT_SQ, C5 = C4 + 4 * IT_PLE, C6 = C5 + 2 * IT_IN, C7 = C6 + 2 * IT_GF, C8 = C7 + 2 * IT_SQ, C9 = C8 + IT_KV, C10 = C9 + 2 * IT_SQ, C11 = C10 + 2 * IT_SQ;
    for (int it = gw; it < C11; it += NGW) {
        int r = it;
        if (r < C2) {
            const int isu = r >= C1; if (isu) r -= C1;
            const int j = r / IT_UP, q = r % IT_UP, kb = q / 176, nb = q % 176, n0 = 32 * nb, L = j >> 1, f = j & 1;
            const float* W = (isu ? I.ffn_wu : I.ffn_wg) + (size_t)j * D * FF;
            p0_item(W, FF, n0, 64 * kb, I.norm_g + (L * 4 + 2 * f) * D, 0x7fffffff, (bf16*)(ws + WS_WUP) + (size_t)j * NUP * D, D, (n0 >> 7) * 256 + (n0 & 127) + 128 * isu, scr, lane);
            continue; }
        r -= C2;
        if (r < 8 * IT_DN) { const int j = r / IT_DN, q = r % IT_DN, kb = q / 64, nb = q % 64;
            p0_item(I.ffn_wd + (size_t)j * FF * D, D, 32 * nb, 64 * kb, nullptr, 0, (bf16*)(ws + WS_WDN) + (size_t)j * D * LDF, LDF, 32 * nb, scr, lane); continue; }
        r -= 8 * IT_DN;
        if (r < 4 * IT_SQ) { const int j = r / IT_SQ, q = r % IT_SQ, kb = q / 64, nb = q % 64;
            p0_item(I.ple_gate_w + (size_t)j * D * D, D, 32 * nb, 64 * kb, I.norm_g + (j * 4 + 3) * D, 0x7fffffff, (bf16*)(ws + WS_WGATE) + (size_t)j * D * D, D, 32 * nb, scr, lane); continue; }
        r -= 4 * IT_SQ;
        if (r < 4 * IT_PLE) { const int j = r / IT_PLE, q = r % IT_PLE, kb = q / 64, nb = q % 64;
            p0_item(I.ple_w + (size_t)j * PLE * D, D, 32 * nb, 64 * kb, nullptr, 0, (bf16*)(ws + WS_WPLE) + (size_t)j * D * PLE, PLE, 32 * nb, scr, lane); continue; }
        r -= 4 * IT_PLE;
        if (r < 2 * IT_IN) { const int j = r / IT_IN, q = r % IT_IN, kb = q / 192, nb = q % 192;
            p0_item(I.gla_w_in + (size_t)j * D * GIN, GIN, 32 * nb, 64 * kb, I.norm_g + (j * 4 + 1) * D, 0x7fffffff, (bf16*)(ws + WS_WIN) + (size_t)j * NIN * D, D, 32 * nb, scr, lane); continue; }
        r -= 2 * IT_IN;
        if (r < 2 * IT_GF) { const int j = r / IT_GF, q = r % IT_GF, kb = q / 32, nb = q % 32;
            p0_item_gatefold(I.gla_w_in + (size_t)j * D * GIN, I.gla_w_a2 + (size_t)j * 16 * 1024, 32 * nb, 64 * kb, I.norm_g + (j * 4 + 1) * D, (bf16*)(ws + WS_WIN) + (size_t)j * NIN * D, scr, lane); continue; }
        r -= 2 * IT_GF;
        if (r < 2 * IT_SQ) { const int j = r / IT_SQ, q = r % IT_SQ, kb = q / 64, nb = q % 64;
            p0_item(I.gla_w_o + (size_t)j * D * D, D, 32 * nb, 64 * kb, I.gla_norm_g + j * 512, 511, (bf16*)(ws + WS_WGO) + (size_t)j * D * D, D, 32 * nb, scr, lane); continue; }
        r -= 2 * IT_SQ;
        if (r < IT_KV) { const int kb = r / 16, nb = r % 16, n0 = 32 * nb;
            p0_item(I.w_kv, 512, n0, 64 * kb, I.kv_norm_g, 0x7fffffff, (bf16*)(ws + WS_WKV), D, (n0 & ~255) + 128 * ((n0 >> 5) & 1) + 32 * ((n0 >> 6) & 3), scr, lane); continue; }
        r -= IT_KV;
        if (r < 2 * IT_SQ) { const int j = r / IT_SQ, q = r % IT_SQ, kb = q / 64, nb = q % 64, n0 = 32 * nb;
            p0_item(I.swa_w_q + (size_t)j * D * D, D, n0, 64 * kb, I.norm_g + ((2 + j) * 4 + 1) * D, 0x7fffffff, (bf16*)(ws + WS_WQ) + (size_t)j * D * D, D, (n0 & ~255) + 128 * ((n0 >> 5) & 1) + 32 * ((n0 >> 6) & 3), scr, lane); continue; }
        r -= 2 * IT_SQ;
        { const int j = r / IT_SQ, q = r % IT_SQ, kb = q / 64, nb = q % 64;
            p0_item(I.swa_w_o + (size_t)j * D * D, D, 32 * nb, 64 * kb, nullptr, 0, (bf16*)(ws + WS_WSO) + (size_t)j * D * D, D, 32 * nb, scr, lane); }
    }
    { const size_t n8 = (size_t)DEPTH * M * PLE / 8; GAS v4u* o = (GAS v4u*)(ws + WS_PB);
        for (size_t i = (size_t)gw * 64 + lane; i < n8; i += (size_t)NGW * 64) { const f32x4 a = ((const GAS f32x4*)I.p)[2 * i], b = ((const GAS f32x4*)I.p)[2 * i + 1];
            v4u w; w.x = pk2(a[0], a[1]); w.y = pk2(a[2], a[3]); w.z = pk2(b[0], b[1]); w.w = pk2(b[2], b[3]); o[i] = w; } }
    { bf16* hb0 = (bf16*)(ws + WS_HB); float* ss0 = (float*)(ws + WS_SS);
        for (int m = gw; m < M; m += NGW) { const GAS f32x4* xr = (const GAS f32x4*)(I.x + (size_t)m * D); float s = 0.f;
#pragma unroll
            for (int j = 0; j < 4; ++j) { const f32x4 a = xr[128 * j + 2 * lane], b = xr[128 * j + 2 * lane + 1]; s += pg8::dot4(a) + pg8::dot4(b);
                v4u w; w.x = pk2(a[0], a[1]); w.y = pk2(a[2], a[3]); w.z = pk2(b[0], b[1]); w.w = pk2(b[2], b[3]); *(GAS v4u*)(hb0 + (size_t)m * D + 512 * j + 8 * lane) = w; }
            s = wave_sum(s);
            if (lane < 32) ss0[(size_t)m * 32 + lane] = (lane == 0) ? s : 0.f; } }
}

typedef float f32x2v __attribute__((ext_vector_type(2)));
struct G1Regs { f32x2v la[16]; unsigned q[16], k[16]; };
__device__ __forceinline__ void g1_load(G1Regs& R, int u, const bf16* qb, const bf16* kb, const float* la, int c2, int tq) {
    const int bh = u >> 7, n = u & 127, b = bh >> 2, h = bh & 3;
    const size_t row0 = (size_t)b * SEQ + 64 * n + 16 * tq; const int cc = h * 256 + 2 * c2;
#pragma unroll
    for (int i = 0; i < 16; ++i) { R.la[i] = *(const GAS f32x2v*)(la + (row0 + i) * 1024 + cc); R.q[i] = *(const GAS unsigned*)(qb + (row0 + i) * 1024 + cc); R.k[i] = *(const GAS unsigned*)(kb + (row0 + i) * 1024 + cc); }
}
__device__ __forceinline__ void gla_g1(Frame& F, const bf16* qb, const bf16* kb, const float* la, bf16* qd, bf16* kdT, bf16* at, float* dec) {
    LAS bf16* QD = (LAS bf16*)(F.lds);
    LAS bf16* KI = (LAS bf16*)(F.lds + 33792);
    LAS bf16* KT = (LAS bf16*)(F.lds + 67584);
    LAS f32x2v* TOT = (LAS f32x2v*)(F.lds + 104448);
    const int tid = F.tid, c2 = tid & 127, tq = tid >> 7, lane = F.lane, w = F.wave, r16 = lane & 15, quad = lane >> 4;
    const int per = (1024 + F.G - 1) / F.G;
    G1Regs R; const int u0 = F.vcu * per;
    if (u0 < 1024) g1_load(R, u0, qb, kb, la, c2, tq);
    for (int i0 = 0; i0 < per; ++i0) {
        const int u = u0 + i0; if (u >= 1024) break;
        f32x2v bs[16];
        { f32x2v run = {0.f, 0.f};
#pragma unroll
            for (int i = 0; i < 16; ++i) { run.x += R.la[i].x; run.y += R.la[i].y; bs[i] = run; } }
        unsigned qv[16], kv[16];
#pragma unroll
        for (int i = 0; i < 16; ++i) { qv[i] = R.q[i]; kv[i] = R.k[i]; }
        TOT[tq * 128 + c2] = bs[15];
        if (i0 + 1 < per && u + 1 < 1024) g1_load(R, u + 1, qb, kb, la, c2, tq);
        __syncthreads();
        f32x2v pre = {0.f, 0.f}, tot = {0.f, 0.f};
#pragma unroll
        for (int t = 0; t < 4; ++t) { const f32x2v v = TOT[t * 128 + c2]; if (t < tq) { pre.x += v.x; pre.y += v.y; } tot.x += v.x; tot.y += v.y; }
        float kdx[16], kdy[16];
#pragma unroll
        for (int i = 0; i < 16; ++i) { const float bx = bs[i].x + pre.x, by = bs[i].y + pre.y;
            const float qx = __uint_as_float(qv[i] << 16), qy = __uint_as_float(qv[i] & 0xffff0000u), kx_ = __uint_as_float(kv[i] << 16), ky_ = __uint_as_float(kv[i] & 0xffff0000u);
            *(LAS unsigned*)(QD + (16 * tq + i) * 264 + 2 * c2) = pk2(qx * __expf(bx), qy * __expf(by));
            *(LAS unsigned*)(KI + (16 * tq + i) * 264 + 2 * c2) = pk2(kx_ * __expf(-bx), ky_ * __expf(-by));
            kdx[i] = kx_ * __expf(tot.x - bx); kdy[i] = ky_ * __expf(tot.y - by); }
#pragma unroll
        for (int e = 0; e < 2; ++e) { v4u wx, wy;
            wx.x = pk2(kdx[8 * e], kdx[8 * e + 1]); wx.y = pk2(kdx[8 * e + 2], kdx[8 * e + 3]); wx.z = pk2(kdx[8 * e + 4], kdx[8 * e + 5]); wx.w = pk2(kdx[8 * e + 6], kdx[8 * e + 7]);
            wy.x = pk2(kdy[8 * e], kdy[8 * e + 1]); wy.y = pk2(kdy[8 * e + 2], kdy[8 * e + 3]); wy.z = pk2(kdy[8 * e + 4], kdy[8 * e + 5]); wy.w = pk2(kdy[8 * e + 6], kdy[8 * e + 7]);
            *(LAS v4u*)(KT + (2 * c2) * 72 + 16 * tq + 8 * e) = wx; *(LAS v4u*)(KT + (2 * c2 + 1) * 72 + 16 * tq + 8 * e) = wy; }
        if (tq == 0) *(GAS f32x2v*)(dec + (size_t)u * 256 + 2 * c2) = (f32x2v){__expf(tot.x), __expf(tot.y)};
        __syncthreads();
        { const int ti = w >> 1;
#pragma unroll
            for (int tt = 0; tt < 2; ++tt) { const int tj = (w & 1) * 2 + tt; f32x4 a4 = {0.f, 0.f, 0.f, 0.f};
                if (tj <= ti) {
#pragma unroll
                    for (int ks = 0; ks < 8; ++ks) { const bf16x8 A = *(const LAS bf16x8*)(QD + (16 * ti + r16) * 264 + 32 * ks + 8 * quad), B = *(const LAS bf16x8*)(KI + (16 * tj + r16) * 264 + 32 * ks + 8 * quad); a4 = MFMA16(A, B, a4); } }
#pragma unroll
                for (int j = 0; j < 4; ++j) { const int ii = 16 * ti + 4 * quad + j, jj = 16 * tj + r16; at[(size_t)u * 4096 + (((ii >> 4) * 2 + (jj >> 5)) * 64 + ((jj & 31) >> 3) * 16 + (ii & 15)) * 8 + (jj & 7)] = f2bf(jj <= ii ? a4[j] : 0.f); } } }
#pragma unroll
        for (int e = 0; e < 4; ++e) { const int d = tid + 512 * e, blk = d >> 6, ln = d & 63, row = 16 * (blk >> 3) + (ln & 15), ch = 4 * (blk & 7) + (ln >> 4);
            *(GAS v4u*)(qd + (size_t)u * 16384 + d * 8) = *(const LAS v4u*)(QD + row * 264 + ch * 8); }
#pragma unroll
        for (int e = 0; e < 4; ++e) { const int d = tid + 512 * e, blk = d >> 6, ln = d & 63, row = 16 * (blk >> 1) + (ln & 15), ch = 4 * (blk & 1) + (ln >> 4);
            *(GAS v4u*)(kdT + (size_t)u * 16384 + d * 8) = *(const LAS v4u*)(KT + row * 72 + ch * 8); }
        __syncthreads();
    }
}
struct ScanBig { bf16x8 q[4]; bf16x8 k0[2], k1[2]; v4u v; };
struct ScanSmall { bf16x8 a; f32x4 d0, d1; };
struct ScanOff { unsigned q, a, k, d, v; };
__device__ __forceinline__ void scan_load_big(ScanBig& R, int n, int bh, const bf16* qd, const bf16* kdT, const bf16* vrow, const ScanOff& O, int tid) {
    const size_t u = (size_t)(bh * NCHUNK + n);
    if (tid < 128) R.v = *(const GAS v4u*)((const GAS char*)vrow + (size_t)n * (64 * 4096) + O.v);
    const GAS char* qp = (const GAS char*)qd + u * 32768 + O.q;
#pragma unroll
    for (int ks = 0; ks < 4; ++ks) R.q[ks] = *(const GAS bf16x8*)(qp + 1024 * ks);
    const GAS char* kp = (const GAS char*)kdT + u * 32768 + O.k;
#pragma unroll
    for (int ks = 0; ks < 2; ++ks) { R.k0[ks] = *(const GAS bf16x8*)(kp + 1024 * ks); R.k1[ks] = *(const GAS bf16x8*)(kp + 2048 + 1024 * ks); }
}
__device__ __forceinline__ void scan_load_small(ScanSmall& R, int n, int bh, const bf16* at, const float* dec, const bf16* vrow, const ScanOff& O, int tid) {
    const size_t u = (size_t)(bh * NCHUNK + n);
    R.a = *(const GAS bf16x8*)((const GAS char*)at + u * 8192 + O.a);
    const GAS char* dp = (const GAS char*)dec + u * 1024 + O.d;
    R.d0 = *(const GAS f32x4*)dp; R.d1 = *(const GAS f32x4*)(dp + 64);
}
__device__ __forceinline__ void gla_scan(Frame& F, const bf16* qd, const bf16* kdT, const bf16* at, const float* dec, const bf16* vb, float* ob) {
    LAS bf16* ST = (LAS bf16*)(F.lds);
    LAS bf16* VT = (LAS bf16*)(F.lds + 16896);
    LAS f32x4* OP = (LAS f32x4*)(F.lds + 21504);
    const int tid = F.tid, lane = F.lane, w = F.wave, r16 = lane & 15, quad = lane >> 4, rt = w & 3, kh = w >> 2;
#define SCAN_BAR() do { asm volatile("s_waitcnt lgkmcnt(0)" ::: "memory"); __builtin_amdgcn_s_barrier(); asm volatile("" ::: "memory"); } while (0)
#ifdef PROBE_SCANHALF
    for (int item = F.vcu; item < ((F.vcu & 1) ? 0 : F.vcu + 2); ++item) {
#else
    for (int item = F.vcu; item < 256; item += F.G) {
#endif
        const int bh = item >> 5, sl = item & 31, b = bh >> 2, h = bh & 3;
        const size_t tok0 = (size_t)b * SEQ; const int vcol = h * 512 + 16 * sl;
        const bf16* vrow = vb + tok0 * 2048 + vcol; float* ob_item = ob + tok0 * 2048 + vcol; const unsigned ooff = (unsigned)(((16 * rt + 4 * quad) * 2048 + r16) * 4);
        f32x4 S0 = {0.f, 0.f, 0.f, 0.f}, S1 = {0.f, 0.f, 0.f, 0.f}, oprev = {0.f, 0.f, 0.f, 0.f};
        ScanBig B0, B1, B2, B3; ScanSmall T0, T1;
        ScanOff O; O.q = (unsigned)(((rt * 8 + 4 * kh) * 64 + lane) * 16); O.a = (unsigned)(((rt * 2 + kh) * 64 + lane) * 16); O.k = (unsigned)(((4 * w) * 64 + lane) * 16);
        O.d = (unsigned)((32 * w + 4 * quad) * 4); O.v = (unsigned)((tid >> 1) * 4096 + 16 * (tid & 1));
        scan_load_big(B0, 0, bh, qd, kdT, vrow, O, tid); scan_load_small(T0, 0, bh, at, dec, vrow, O, tid);
        scan_load_big(B1, 1, bh, qd, kdT, vrow, O, tid); scan_load_big(B2, 2, bh, qd, kdT, vrow, O, tid);
#define SCAN_STEP(n_, BC, BN, TC, TN) do { const int n = (n_); const int buf = n & 1; \
            scan_load_small(TN, (n + 1 < NCHUNK) ? n + 1 : NCHUNK - 1, bh, at, dec, vrow, O, tid); \
            scan_load_big(BN, (n + 3 < NCHUNK) ? n + 3 : NCHUNK - 1, bh, qd, kdT, vrow, O, tid); \
            LAS bf16* st = ST + buf * (16 * 264); LAS bf16* vt = VT + buf * (16 * 72); \
            if (tid < 128) { const int tok = tid >> 1, hh = tid & 1; const v4u v = BC.v; \
                vt[(8 * hh + 0) * 72 + tok] = (bf16)(v.x & 0xffffu); vt[(8 * hh + 1) * 72 + tok] = (bf16)(v.x >> 16); vt[(8 * hh + 2) * 72 + tok] = (bf16)(v.y & 0xffffu); vt[(8 * hh + 3) * 72 + tok] = (bf16)(v.y >> 16); \
                vt[(8 * hh + 4) * 72 + tok] = (bf16)(v.z & 0xffffu); vt[(8 * hh + 5) * 72 + tok] = (bf16)(v.z >> 16); vt[(8 * hh + 6) * 72 + tok] = (bf16)(v.w & 0xffffu); vt[(8 * hh + 7) * 72 + tok] = (bf16)(v.w >> 16); } \
            { v2u p0, p1; p0.x = pk2(S0[0], S0[1]); p0.y = pk2(S0[2], S0[3]); p1.x = pk2(S1[0], S1[1]); p1.y = pk2(S1[2], S1[3]); \
                *(LAS v2u*)(st + r16 * 264 + 32 * w + 4 * quad) = p0; *(LAS v2u*)(st + r16 * 264 + 32 * w + 16 + 4 * quad) = p1; } \
            SCAN_BAR(); \
            if (kh == 0 && n > 0) { const f32x4 po = OP[((n - 1) & 1) * 256 + rt * 64 + lane]; const f32x4 of = oprev + po; GAS float* op_ = (GAS float*)((GAS char*)ob_item + (size_t)(n - 1) * (64 * 8192) + ooff); \
                op_[0] = of[0]; op_[2048] = of[1]; op_[4096] = of[2]; op_[6144] = of[3]; } \
            { f32x4 c0 = S0 * TC.d0, c1 = S1 * TC.d1; \
                _Pragma("unroll") for (int ks = 0; ks < 2; ++ks) { const bf16x8 B = *(const LAS bf16x8*)(vt + r16 * 72 + 32 * ks + 8 * quad); c0 = MFMA16(BC.k0[ks], B, c0); c1 = MFMA16(BC.k1[ks], B, c1); } \
                S0 = c0; S1 = c1; } \
            { f32x4 o = {0.f, 0.f, 0.f, 0.f}; \
                _Pragma("unroll") for (int ks = 0; ks < 4; ++ks) o = MFMA16(BC.q[ks], *(const LAS bf16x8*)(st + r16 * 264 + 128 * kh + 32 * ks + 8 * quad), o); \
                o = MFMA16(TC.a, *(const LAS bf16x8*)(vt + r16 * 72 + 32 * kh + 8 * quad), o); \
                if (kh) OP[buf * 256 + rt * 64 + lane] = o; else oprev = o; } \
        } while (0)
        for (int n4 = 0; n4 < NCHUNK; n4 += 4) { SCAN_STEP(n4, B0, B3, T0, T1); SCAN_STEP(n4 + 1, B1, B0, T1, T0); SCAN_STEP(n4 + 2, B2, B1, T0, T1); SCAN_STEP(n4 + 3, B3, B2, T1, T0); }
        SCAN_BAR();
        if (kh == 0) { const f32x4 po = OP[(127 & 1) * 256 + rt * 64 + lane]; const f32x4 of = oprev + po; GAS float* op_ = (GAS float*)((GAS char*)ob_item + (size_t)127 * (64 * 8192) + ooff);
            op_[0] = of[0]; op_[2048] = of[1]; op_[4096] = of[2]; op_[6144] = of[3]; }
        SCAN_BAR();
    }
#undef SCAN_STEP
#undef SCAN_BAR
}
__device__ __forceinline__ void gla_g3(Frame& F, const float* ob, const bf16* rb, bf16* og) {
    const int gw = F.vcu * NWAVES + F.wave, NGW = F.G * NWAVES, lane = F.lane;
    for (int it = gw; it < M * 4; it += NGW) { const size_t off = (size_t)(it >> 2) * 2048 + (it & 3) * 512 + lane * 8;
        const f32x4 a = *(const GAS f32x4*)(ob + off), b = *(const GAS f32x4*)(ob + off + 4);
        const float s = wave_sum(pg8::dot4(a) + pg8::dot4(b)); const float rstd = 1.0f / sqrtf(s * (1.0f / 512.0f) + pg8::RMS_EPS);
        const v4u rw = *(const GAS v4u*)(rb + off); f32x4 r0, r1; pg8::unpack8(rw, r0, r1);
        *(GAS v4u*)(og + off) = pg8::pack8(a * rstd * r0, b * rstd * r1); }
}

__device__ __forceinline__ int t5_bucket(int d) { if (d < 16) return d; const int l = 16 + (int)(logf((float)d / 16.0f) / logf(8.0f) * 16.0f); return l < 31 ? l : 31; }
__device__ __forceinline__ void swa_attn(Frame& F, const bf16* qn, const bf16* kx, const bf16* vx, const float* rel_bias, const float* sinks, bf16* ao) {
    LAS bf16* KS = (LAS bf16*)(F.lds);
    LAS bf16* VT = (LAS bf16*)(F.lds + 36864);
    LAS float* BI = (LAS float*)(F.lds + 70656);
    const int tid = F.tid, lane = F.lane, g = F.wave, r16 = lane & 15, quad = lane >> 4;
    const int per = (512 + F.G - 1) / F.G;
    for (int i0 = 0; i0 < per; ++i0) {
        const int u = F.vcu * per + i0; if (u >= 512) break;
        const int b = u >> 8, kvh = (u >> 6) & 3, nb = u & 63;
        const int hq = kvh * 8 + g;
        const bf16* qp = qn + ((size_t)b * SEQ + 128 * nb + r16) * 2048 + hq * 64 + 8 * quad;
        bf16x8 Q0 = *(const GAS bf16x8*)qp, Q1 = *(const GAS bf16x8*)(qp + 32);
        { const int key = tid >> 1, hh = tid & 1, kpos = 128 * (nb - 1) + key;
            v4u kv[4], vv[4];
            if (kpos >= 0) { const GAS v4u* kp = (const GAS v4u*)(kx + ((size_t)b * SEQ + kpos) * 256 + kvh * 64 + 32 * hh); const GAS v4u* vp = (const GAS v4u*)(vx + ((size_t)b * SEQ + kpos) * 256 + kvh * 64 + 32 * hh);
#pragma unroll
                for (int e = 0; e < 4; ++e) { kv[e] = kp[e]; vv[e] = vp[e]; } }
            else {
#pragma unroll
                for (int e = 0; e < 4; ++e) { kv[e] = (v4u){0u, 0u, 0u, 0u}; vv[e] = (v4u){0u, 0u, 0u, 0u}; } }
#pragma unroll
            for (int e = 0; e < 4; ++e) { *(LAS v4u*)(KS + key * 72 + 32 * hh + 8 * e) = kv[e];
                LAS bf16* vtp = VT + (32 * hh + 8 * e) * 264 + key;
                vtp[0 * 264] = (bf16)(vv[e].x & 0xffffu); vtp[1 * 264] = (bf16)(vv[e].x >> 16); vtp[2 * 264] = (bf16)(vv[e].y & 0xffffu); vtp[3 * 264] = (bf16)(vv[e].y >> 16);
                vtp[4 * 264] = (bf16)(vv[e].z & 0xffffu); vtp[5 * 264] = (bf16)(vv[e].z >> 16); vtp[6 * 264] = (bf16)(vv[e].w & 0xffffu); vtp[7 * 264] = (bf16)(vv[e].w >> 16); } }
#pragma unroll
        for (int e = 0; e < 2; ++e) { const int idx = tid + 512 * e, gg = idx >> 7, dist = idx & 127; BI[idx] = rel_bias[t5_bucket(dist) * 32 + kvh * 8 + gg]; }
        const float sink = sinks[hq];
        __syncthreads();
        float bm[9][4];
#pragma unroll
        for (int t9 = 0; t9 < 9; ++t9)
#pragma unroll
            for (int j = 0; j < 4; ++j) { const int dist = r16 + 128 - 16 * t9 - 4 * quad - j; bm[t9][j] = (dist >= 0 && dist < 128) ? BI[g * 128 + (dist & 127)] : -INFINITY; }
        for (int qt = 0; qt < 8; ++qt) {
            bf16x8 Q0n = Q0, Q1n = Q1;
            if (qt < 7) { Q0n = *(const GAS bf16x8*)(qp + (size_t)(16 * (qt + 1)) * 2048); Q1n = *(const GAS bf16x8*)(qp + (size_t)(16 * (qt + 1)) * 2048 + 32); }
            f32x4 S[9];
#pragma unroll
            for (int t9 = 0; t9 < 9; ++t9) { const LAS bf16* kp = KS + (16 * (qt + t9) + r16) * 72 + 8 * quad;
                f32x4 z = {0.f, 0.f, 0.f, 0.f}; z = MFMA16(*(const LAS bf16x8*)kp, Q0, z); S[t9] = MFMA16(*(const LAS bf16x8*)(kp + 32), Q1, z); }
            float mx = sink;
            if (nb > 0) {
#pragma unroll
                for (int t9 = 0; t9 < 9; ++t9)
#pragma unroll
                    for (int j = 0; j < 4; ++j) { const float s = S[t9][j] + bm[t9][j]; S[t9][j] = s; mx = fmaxf(mx, s); }
            } else {
#pragma unroll
                for (int t9 = 0; t9 < 9; ++t9)
#pragma unroll
                    for (int j = 0; j < 4; ++j) { const int sj = 16 * (qt + t9) + 4 * quad + j; const float s = (sj >= 128) ? S[t9][j] + bm[t9][j] : -INFINITY; S[t9][j] = s; mx = fmaxf(mx, s); }
            }
            mx = fmaxf(mx, __shfl_xor(mx, 16)); mx = fmaxf(mx, __shfl_xor(mx, 32));
            float l = 0.f;
#pragma unroll
            for (int t9 = 0; t9 < 9; ++t9)
#pragma unroll
                for (int j = 0; j < 4; ++j) { const float p = __expf(S[t9][j] - mx); S[t9][j] = p; l += p; }
            l += __shfl_xor(l, 16); l += __shfl_xor(l, 32); l += __expf(sink - mx);
            const float inv = 1.0f / l;
            f32x4 O[4];
#pragma unroll
            for (int dt = 0; dt < 4; ++dt) O[dt] = (f32x4){0.f, 0.f, 0.f, 0.f};
#pragma unroll
            for (int kp5 = 0; kp5 < 5; ++kp5) { const int ta = 2 * kp5, tb = (2 * kp5 + 1 < 9) ? 2 * kp5 + 1 : 8;
                v4u pw; pw.x = pk2(S[ta][0] * inv, S[ta][1] * inv); pw.y = pk2(S[ta][2] * inv, S[ta][3] * inv);
                if (2 * kp5 + 1 < 9) { pw.z = pk2(S[tb][0] * inv, S[tb][1] * inv); pw.w = pk2(S[tb][2] * inv, S[tb][3] * inv); } else { pw.z = 0u; pw.w = 0u; }
                const bf16x8 P = __builtin_bit_cast(bf16x8, pw);
                const int kta = qt + ta, ktb = (qt + 2 * kp5 + 1) < 15 ? (qt + 2 * kp5 + 1) : 15;
#pragma unroll
                for (int dt = 0; dt < 4; ++dt) { const v2u lo = *(const LAS v2u*)(VT + (16 * dt + r16) * 264 + 16 * kta + 4 * quad), hi = *(const LAS v2u*)(VT + (16 * dt + r16) * 264 + 16 * ktb + 4 * quad);
                    v4u bw; bw.x = lo.x; bw.y = lo.y; bw.z = hi.x; bw.w = hi.y; O[dt] = MFMA16(__builtin_bit_cast(bf16x8, bw), P, O[dt]); } }
            bf16* op = ao + ((size_t)b * SEQ + 128 * nb + 16 * qt + r16) * 2048 + hq * 64 + 4 * quad;
#pragma unroll
            for (int dt = 0; dt < 4; ++dt) { v2u w2; w2.x = pk2(O[dt][0], O[dt][1]); w2.y = pk2(O[dt][2], O[dt][3]); *(GAS v2u*)(op + 16 * dt) = w2; }
            Q0 = Q0n; Q1 = Q1n;
        }
        __syncthreads();
    }
}

#ifndef MK_ONE_LAUNCH
#define MK_ONE_LAUNCH 1
#endif
#ifndef STREAM_BF16
#define STREAM_BF16 0
#endif
__device__ __forceinline__ bool wg_leader(int wave_s) { int l; asm volatile("v_mbcnt_lo_u32_b32 %0, -1, 0\n\tv_mbcnt_hi_u32_b32 %0, -1, %0" : "=v"(l)); return wave_s == 0 && l == 0; }
template <class T> __device__ __forceinline__ T* opq(T* p) { asm volatile("" : "+s"(p)); return p; }
__device__ __forceinline__ int opqi(int v) { asm volatile("" : "+s"(v)); return v; }
struct Args { const float* in[21]; float* out; unsigned char* ws; int ph_lo, ph_hi; };
#define HB0_ ((bf16*)(ws + WS_HB))
#define HB1_ ((bf16*)(ws + WS_HB) + (size_t)M * D)
#define SS0_ ((float*)(ws + WS_SS))
#define SS1_ ((float*)(ws + WS_SS) + (size_t)M * 32)
typedef const __attribute__((address_space(4))) Args* KArgs;
__device__ __forceinline__ KArgs kargs() { KArgs p = (KArgs)__builtin_amdgcn_kernarg_segment_ptr(); asm volatile("" : "+s"(p)); return p; }
#if MK_ONE_LAUNCH
#define SEAM(p) do { if ((p) + 1 < hi) { XcdBarrier bar_; bar_.bar = (unsigned*)((gu32*)(kargs()->ws + WS_CTL) + CW_BAR); bar_.x = xb_xcc_id(); bar_.st = (volatile LAS unsigned*)((LAS unsigned char*)lds + MISC_OFF) + 8; xcd_barrier(bar_); } } while (0)
#else
#define SEAM(p) do { } while (0)
#endif
#define IN(k) (lo <= (k) && (k) < hi)
#define PH_LOCALS const KArgs ap = kargs(); unsigned char* const ws = ap->ws; float* const out = ap->out; const int G_ = opqi((int)gridDim.x); const int bx_ = opqi((int)blockIdx.x); (void)out; (void)G_; (void)bx_; \
    Frame Fp; { int t_ = threadIdx.x; asm volatile("" : "+v"(t_)); Fp.lds = (LAS unsigned char*)lds; Fp.MISC = nullptr; Fp.ctl = nullptr; Fp.tid = t_; Fp.lane = t_ & 63; Fp.wave = __builtin_amdgcn_readfirstlane(t_ >> 6); Fp.G = G_; Fp.vcu = (G_ % 8 == 0) ? (bx_ % 8) * (G_ / 8) + bx_ / 8 : bx_; } \
    const pg8::Stg SG_ = (LAS unsigned*)((LAS unsigned char*)lds + STG_OFF + Fp.wave * pg8::STG_BYTES); (void)SG_

template <int L, bool RR = false> __device__ __forceinline__ void layer_body(const int lo, const int hi) {
    extern __shared__ __attribute__((aligned(16))) unsigned char lds[];
    constexpr bool AL = true, SP = true;
        const int p0 = 1 + 10 * L;
        if (IN(p0 + 0)) { PH_LOCALS;
            { pg8::Gemm g{HB0_, (const bf16*)(ws + WS_WUP) + (size_t)(2 * L) * NUP * D, M, NUP, D, D}; pg8::StaticOrder S; S.init(M, NUP, G_, bx_);
              pg8::EpiSwiGLU E{(bf16*)(ws + WS_ACT), SS0_};
              pg8::gemm_phase<pg8::EpiSwiGLU, pg8::StaticOrder, AL, SP>(Fp.lds + RING_OFF, g, S, E); }
            if (L == 2) { pg8::Gemm g{HB0_, (const bf16*)(ws + WS_WKV), M, 512, D, D}; pg8::StaticOrder S; S.init(M, 512, G_, bx_);
              pg8::EpiHeadNorm E{(bf16*)(ws + WS_KX), (bf16*)(ws + WS_VX), 256, SS0_, (ap->in[15]), 1.0f, 1};
              pg8::gemm_phase<pg8::EpiHeadNorm, pg8::StaticOrder, AL, SP>(Fp.lds + RING_OFF, g, S, E); }
            SEAM(p0 + 0);
        }
        if (IN(p0 + 1)) { PH_LOCALS;
            pg8::Gemm g{(const bf16*)(ws + WS_ACT), (const bf16*)(ws + WS_WDN) + (size_t)(2 * L) * D * LDF, M, D, FF, LDF}; pg8::StaticOrder S; S.init(M, D, G_, bx_, 4);
#ifdef PROBE_AMASK
            if (RR) { g.pm_mask = PROBE_AMASK; g.pn_mask = PROBE_BMASK; }
#endif
#if STREAM_BF16
            typedef pg8::EpiResid_T<(L > 0) || RR, false> EpiD1;
#else
            typedef pg8::EpiResid EpiD1;
#endif
            EpiD1 E{(L == 0 && !RR) ? (ap->in[0]) : out, out, HB1_, SS1_, RR ? 0.f : 0.5f, HB0_};
            pg8::gemm_phase<EpiD1, pg8::StaticOrder, AL, SP>(Fp.lds + RING_OFF, g, S, E);
            SEAM(p0 + 1);
        }
        if (L < 2) {
            if (IN(p0 + 2)) { PH_LOCALS;
                pg8::Gemm g{HB1_, (const bf16*)(ws + WS_WIN) + (size_t)L * NIN * D, M, NIN, D, D}; pg8::StaticOrder S; S.init(M, NIN, G_, bx_);
                pg8::EpiInProj E{(bf16*)(ws + WS_QB), (bf16*)(ws + WS_KB), (bf16*)(ws + WS_VB), (bf16*)(ws + WS_RB), (float*)(ws + WS_LA), SS1_, (ap->in[10]) + L * 1024};
                pg8::gemm_phase<pg8::EpiInProj, pg8::StaticOrder, AL, SP>(Fp.lds + RING_OFF, g, S, E);
                SEAM(p0 + 2);
            }
            if (IN(p0 + 3)) { PH_LOCALS; gla_g1(Fp, (const bf16*)(ws + WS_QB), (const bf16*)(ws + WS_KB), (const float*)(ws + WS_LA), (bf16*)(ws + WS_QD), (bf16*)(ws + WS_KDT), (bf16*)(ws + WS_AT), (float*)(ws + WS_DEC)); SEAM(p0 + 3); }
            if (IN(p0 + 4)) { PH_LOCALS; gla_scan(Fp, (const bf16*)(ws + WS_QD), (const bf16*)(ws + WS_KDT), (const bf16*)(ws + WS_AT), (const float*)(ws + WS_DEC), (const bf16*)(ws + WS_VB), (float*)(ws + WS_OB)); SEAM(p0 + 4); }
            if (IN(p0 + 5)) { PH_LOCALS; gla_g3(Fp, (const float*)(ws + WS_OB), (const bf16*)(ws + WS_RB), (bf16*)(ws + WS_OG)); SEAM(p0 + 5); }
        } else {
            if (IN(p0 + 2)) { PH_LOCALS;
                pg8::Gemm g{HB1_, (const bf16*)(ws + WS_WQ) + (size_t)(L - 2) * D * D, M, D, D, D}; pg8::StaticOrder S; S.init(M, D, G_, bx_);
                pg8::EpiHeadNorm E{(bf16*)(ws + WS_QN), nullptr, 2048, SS1_, (ap->in[18]) + (L - 2) * 64, 0.125f, 8};
                pg8::gemm_phase<pg8::EpiHeadNorm, pg8::StaticOrder, AL, SP>(Fp.lds + RING_OFF, g, S, E);
                SEAM(p0 + 2);
            }
            if (IN(p0 + 3)) { PH_LOCALS; swa_attn(Fp, (const bf16*)(ws + WS_QN), (const bf16*)(ws + WS_KX), (const bf16*)(ws + WS_VX), (ap->in[16]), (ap->in[19]) + (L - 2) * 32, (bf16*)(ws + WS_AO)); SEAM(p0 + 3); }
        }
        if (IN(p0 + 6)) { PH_LOCALS;
            pg8::Gemm g{L < 2 ? (const bf16*)(ws + WS_OG) : (const bf16*)(ws + WS_AO), L < 2 ? (const bf16*)(ws + WS_WGO) + (size_t)L * D * D : (const bf16*)(ws + WS_WSO) + (size_t)(L - 2) * D * D, M, D, D, D};
            pg8::StaticOrder S; S.init(M, D, G_, bx_);
#if STREAM_BF16
            typedef pg8::EpiResid_T<true, false> EpiO;
#else
            typedef pg8::EpiResid EpiO;
#endif
            EpiO E{out, out, HB0_, SS0_, RR ? 0.f : 1.0f, HB1_};
            pg8::gemm_phase<EpiO, pg8::StaticOrder, AL, SP>(Fp.lds + RING_OFF, g, S, E);
            SEAM(p0 + 6);
        }
        if (IN(p0 + 7)) { PH_LOCALS;
            pg8::Gemm g{HB0_, (const bf16*)(ws + WS_WUP) + (size_t)(2 * L + 1) * NUP * D, M, NUP, D, D}; pg8::StaticOrder S; S.init(M, NUP, G_, bx_);
#ifdef PROBE_NOEPI
            typedef pg8::EpiSwiGLU_T<RR> EpiUp2;
#else
            typedef pg8::EpiSwiGLU EpiUp2;
#endif
            EpiUp2 E{(bf16*)(ws + WS_ACT), SS0_};
#ifdef PROBE_DIAG
            pg8::gemm_phase<EpiUp2, pg8::StaticOrder, AL, SP, RR ? PROBE_DIAG : 0>(Fp.lds + RING_OFF, g, S, E);
#else
            pg8::gemm_phase<EpiUp2, pg8::StaticOrder, AL, SP>(Fp.lds + RING_OFF, g, S, E);
#endif
            SEAM(p0 + 7);
        }
        if (IN(p0 + 8)) {
            { PH_LOCALS; pg8::Gemm g{(const bf16*)(ws + WS_ACT), (const bf16*)(ws + WS_WDN) + (size_t)(2 * L + 1) * D * LDF, M, D, FF, LDF}; pg8::StaticOrder S; S.init(M, D, G_, bx_, 4);
#if STREAM_BF16
              typedef pg8::EpiResid_T<true, false> EpiD2;
#else
              typedef pg8::EpiResid EpiD2;
#endif
              EpiD2 E{out, out, HB1_, SS1_, RR ? 0.f : 0.5f, HB0_};
              pg8::gemm_phase<EpiD2, pg8::StaticOrder, AL, SP>(Fp.lds + RING_OFF, g, S, E); }
            SEAM(p0 + 8);
        }
        if (IN(p0 + 9)) {
            { PH_LOCALS; pg8::Gemm g{(const bf16*)(ws + WS_PB) + (size_t)L * M * PLE, (const bf16*)(ws + WS_WPLE) + (size_t)L * D * PLE, M, D, opqi(PLE), PLE}; pg8::StaticOrder S; S.init(M, D, G_, bx_);
              pg8::EpiPlainBf16 E{(bf16*)(ws + WS_PP), D};
              pg8::gemm_phase<pg8::EpiPlainBf16, pg8::StaticOrder, AL, SP>(Fp.lds + RING_OFF, g, S, E); }
          { PH_LOCALS;
            pg8::Gemm g{HB1_, (const bf16*)(ws + WS_WGATE) + (size_t)L * D * D, M, D, D, D}; pg8::StaticOrder S; S.init(M, D, G_, bx_);
#if STREAM_BF16
            typedef pg8::EpiPleGate_T<true, L == DEPTH - 1> EpiG;
#else
            typedef pg8::EpiPleGate EpiG;
#endif
            EpiG E{out, HB0_, SS1_, SS0_, (const bf16*)(ws + WS_PP), HB1_};
            pg8::gemm_phase<EpiG, pg8::StaticOrder, AL, SP>(Fp.lds + RING_OFF, g, S, E); }
            SEAM(p0 + 9);
        }
    }

__global__ void __launch_bounds__(NWAVES * 64, 2) yoco_fwd(Args args_unused_) {
    extern __shared__ __attribute__((aligned(16))) unsigned char lds[];
    Frame F;
    F.lds = (LAS unsigned char*)lds;
    F.MISC = (volatile LAS unsigned*)(F.lds + MISC_OFF);
    F.tid = threadIdx.x; F.lane = F.tid & 63; F.wave = __builtin_amdgcn_readfirstlane(F.tid >> 6);
    F.G = gridDim.x; { const int bx = blockIdx.x; F.vcu = (F.G % 8 == 0) ? (bx % 8) * (F.G / 8) + bx / 8 : bx; }
    F.ctl = nullptr;
    for (int u = F.tid; u < (LDS_BYTES - LDSCTL_OFF) / 4; u += NWAVES * 64) ((LAS unsigned*)(F.lds + LDSCTL_OFF))[u] = 0u;
    __syncthreads();
    const int lo = kargs()->ph_lo, hi = kargs()->ph_hi;
#if MK_ONE_LAUNCH
    { unsigned char* ws0 = kargs()->ws; (void)xcd_barrier_post((unsigned*)((gu32*)(ws0 + WS_CTL) + CW_BAR), (volatile LAS unsigned*)((LAS unsigned char*)lds + MISC_OFF) + 8); }
#endif
    constexpr bool AL = true, SP = true;

    if (IN(0)) { PH_LOCALS;
        In I; I.x = ap->in[0]; I.p = ap->in[1]; I.norm_g = ap->in[2]; I.ffn_wg = ap->in[3]; I.ffn_wu = ap->in[4]; I.ffn_wd = ap->in[5]; I.ple_w = ap->in[6]; I.ple_gate_w = ap->in[7];
        I.gla_w_in = ap->in[8]; I.gla_w_a2 = ap->in[9]; I.gla_b_a = ap->in[10]; I.gla_norm_g = ap->in[11]; I.gla_w_o = ap->in[12]; I.kv_norm_g = ap->in[13]; I.w_kv = ap->in[14]; I.k_norm_g = ap->in[15];
        I.rel_bias = ap->in[16]; I.swa_w_q = ap->in[17]; I.q_norm_g = ap->in[18]; I.sinks = ap->in[19]; I.swa_w_o = ap->in[20];
        p0_prologue(Fp, I, ws); SEAM(0); }

#ifndef PROBE_SLOT
#define PROBE_SLOT (-1)
#endif
#ifndef PROBE_LAYERS
#define PROBE_LAYERS 0
#endif
#ifndef PROBE_PROLOGUE
#define PROBE_PROLOGUE 0
#endif
#define FORCE_BAR() do { XcdBarrier bar_; bar_.bar = (unsigned*)((gu32*)(kargs()->ws + WS_CTL) + CW_BAR); bar_.x = xb_xcc_id(); bar_.st = (volatile LAS unsigned*)((LAS unsigned char*)lds + MISC_OFF) + 8; xcd_barrier(bar_); } while (0)
#define LAYER(L_) do { layer_body<L_>(lo, hi); \
    if (PROBE_SLOT >= 0 && ((PROBE_LAYERS >> L_) & 1)) { FORCE_BAR(); layer_body<L_, true>(1 + 10 * L_ + PROBE_SLOT, 1 + 10 * L_ + PROBE_SLOT + 1); FORCE_BAR(); } } while (0)
    if (PROBE_PROLOGUE) { PH_LOCALS;
        In I; I.x = ap->in[0]; I.p = ap->in[1]; I.norm_g = ap->in[2]; I.ffn_wg = ap->in[3]; I.ffn_wu = ap->in[4]; I.ffn_wd = ap->in[5]; I.ple_w = ap->in[6]; I.ple_gate_w = ap->in[7];
        I.gla_w_in = ap->in[8]; I.gla_w_a2 = ap->in[9]; I.gla_b_a = ap->in[10]; I.gla_norm_g = ap->in[11]; I.gla_w_o = ap->in[12]; I.kv_norm_g = ap->in[13]; I.w_kv = ap->in[14]; I.k_norm_g = ap->in[15];
        I.rel_bias = ap->in[16]; I.swa_w_q = ap->in[17]; I.q_norm_g = ap->in[18]; I.sinks = ap->in[19]; I.swa_w_o = ap->in[20];
        p0_prologue(Fp, I, ws); FORCE_BAR(); }
    LAYER(0); LAYER(1); LAYER(2); LAYER(3);
#undef IN
#undef SEAM
}

extern "C" void kernel_launch(void* const* d_in, const int* in_sizes, int n_in, void* d_out, int out_size, void* d_ws, size_t ws_size, hipStream_t stream) {
    static int grid = 0;
    if (grid == 0) {
        if (n_in != 21 || in_sizes[0] != M * D || out_size != M * D || ws_size < WS_END) { fprintf(stderr, "kernel_launch: unexpected shapes (n_in %d, in0 %d, out %d, ws %zu < %zu); nothing launched\n", n_in, n_in > 0 ? in_sizes[0] : -1, out_size, ws_size, (size_t)WS_END); grid = -1; return; }
        int dev = 0, cus = 0, per_cu = 0;
        if (hipGetDevice(&dev) != hipSuccess || hipDeviceGetAttribute(&cus, hipDeviceAttributeMultiprocessorCount, dev) != hipSuccess) { grid = -1; return; }
        if (hipFuncSetAttribute((const void*)yoco_fwd, hipFuncAttributeMaxDynamicSharedMemorySize, LDS_BYTES) != hipSuccess) { fprintf(stderr, "kernel_launch: hipFuncSetAttribute failed\n"); grid = -1; return; }
        if (hipOccupancyMaxActiveBlocksPerMultiprocessor(&per_cu, (const void*)yoco_fwd, NWAVES * 64, LDS_BYTES) != hipSuccess || per_cu < 1) fprintf(stderr, "kernel_launch: occupancy query reports %d blocks per CU\n", per_cu);
        (void)hipGetLastError();
        grid = cus;
    }
    if (grid < 0) return;
    if (hipMemsetAsync((char*)d_ws + WS_CTL, 0, CTL_ZERO_BYTES, stream) != hipSuccess) return;
    Args a{};
    for (int i = 0; i < 21; ++i) a.in[i] = (const float*)d_in[i];
    a.out = (float*)d_out; a.ws = (unsigned char*)d_ws;
#if MK_ONE_LAUNCH
    a.ph_lo = 0; a.ph_hi = NPH;
    hipLaunchKernelGGL(yoco_fwd, dim3(grid), dim3(NWAVES * 64), LDS_BYTES, stream, a);
#else
    for (int ph = 0; ph < NPH; ++ph) {
        const int k = (ph - 1) % 10, L = (ph - 1) / 10;
        if (ph > 0 && L >= 2 && (k == 4 || k == 5)) continue;
        a.ph_lo = ph; a.ph_hi = ph + 1;
        hipLaunchKernelGGL(yoco_fwd, dim3(grid), dim3(NWAVES * 64), LDS_BYTES, stream, a);
    }
#endif
}
```

```cpp
#include <hip/hip_runtime.h>
#include <cstdio>
#include <cstdint>
#ifndef MK_PRIO
#define MK_PRIO 1
#endif
#ifndef MK_FULLLINE
#define MK_FULLLINE 0
#endif
#ifndef MK_KOUTER
#define MK_KOUTER 1
#endif
#ifndef MK_SP4
#define MK_SP4 0
#endif
#ifndef MK_EARLY
#define MK_EARLY 0
#endif
#ifndef MK_KSR
#define MK_KSR 0
#endif
#ifndef MK_LPRIO
#define MK_LPRIO 0
#endif
#define MK_ONE_LAUNCH 1
#define STREAM_BF16 1
#define MK_HOOK_IN 1
namespace pg8 {
#define PG8_LAS __attribute__((address_space(3)))
typedef unsigned short bf16_t;
typedef short bf16x8 __attribute__((ext_vector_type(8)));
typedef float f32x4 __attribute__((ext_vector_type(4)));
typedef unsigned u32x4 __attribute__((ext_vector_type(4)));
constexpr int BM = 256, BK = 64, HALF = 128, HTB = HALF * BK * 2  , STAGE_BYTES = 8 * HTB, NXCD = 8, WGM = 8;

__host__ __device__ __forceinline__ int lds_byte(int r, int c) { const int st = (r >> 4) * 2 + (c >> 5), rr = r & 15, cc = c & 31, ob = rr * 64 + cc * 2; return st * 1024 + (ob ^ (((ob >> 9) & 1) << 5)); }
__host__ __device__ __forceinline__ void stage_rc(int b, int& R, int& C) { const int st = b / 1024, sb = b % 1024, swz = sb ^ (((sb >> 9) & 1) << 5); R = (st >> 1) * 16 + swz / 64; C = (st & 1) * 32 + (swz % 64) / 2; }
__host__ __device__ __forceinline__ int perm32(int rho) { const int n = rho >> 4, i = rho & 15; return 8 * (i >> 2) + 4 * n + (i & 3); }

struct Unit { int pm, pn; };
struct Gemm { const bf16_t* A; const bf16_t* Bt; int M, N, K, ld; int pm_mask = -1, pn_mask = -1; };

struct StaticOrder {
    int nM, nN, nwg, G, c, wgm;
    __host__ __device__ void init(int M, int N, int G_, int c_, int wgm_ = WGM) { nM = M / BM; nN = N / BM; nwg = nM * nN; G = G_; c = c_; wgm = wgm_; }
    __host__ __device__ bool next(int i, Unit& u) const {
        const long L = (long)i * G + c; if (L >= nwg) return false;
        int wgid = (int)L; { const int q = nwg / NXCD, r = nwg % NXCD, xcd = wgid % NXCD, off = wgid / NXCD; wgid = (xcd < r ? xcd * (q + 1) : r * (q + 1) + (xcd - r) * q) + off; }
        const int nig = wgm * nN, gid = wgid / nig, fm = gid * wgm, gsz = (nM - fm) < wgm ? (nM - fm) : wgm;
        u.pm = fm + ((wgid % nig) % gsz); u.pn = (wgid % nig) / gsz; return true;
    }
    __device__ __forceinline__ void a_ready(const Unit&) const {}
    __device__ __forceinline__ void done(const Unit&) const {}
};
typedef float cvt_f32x2_t __attribute__((ext_vector_type(2))); typedef __bf16 cvt_bf16x2_t __attribute__((ext_vector_type(2)));
__device__ __forceinline__ unsigned cvt_pk_bf16(float lo, float hi) { cvt_f32x2_t v = {lo, hi}; cvt_bf16x2_t b = __builtin_convertvector(v, cvt_bf16x2_t); return __builtin_bit_cast(unsigned, b); }
typedef float f32x2 __attribute__((ext_vector_type(2)));
struct OffsetOrder : StaticOrder { int off, cnt; __host__ __device__ bool next(int i, Unit& u) const { if (i >= cnt) return false; return StaticOrder::next(i + off, u); } };
constexpr float RMS_EPS = 1e-6f;
constexpr int DM = 2048, DFF = 5632 + 64;
typedef unsigned u32x2 __attribute__((ext_vector_type(2)));
__device__ __forceinline__ float bf2f(unsigned short b) { return __uint_as_float((unsigned)b << 16); }
__device__ __forceinline__ float sigmoid_f(float x) { return __builtin_amdgcn_rcpf(1.0f + __builtin_amdgcn_exp2f(-1.4426950408889634f * x)); }
__device__ __forceinline__ u32x4 pack8(const f32x4& a, const f32x4& b) { u32x4 w; w.x = cvt_pk_bf16(a[0], a[1]); w.y = cvt_pk_bf16(a[2], a[3]); w.z = cvt_pk_bf16(b[0], b[1]); w.w = cvt_pk_bf16(b[2], b[3]); return w; }
__device__ __forceinline__ void unpack8(const u32x4& w, f32x4& a, f32x4& b) {
    a[0] = __uint_as_float(w.x << 16); a[1] = __uint_as_float(w.x & 0xffff0000u); a[2] = __uint_as_float(w.y << 16); a[3] = __uint_as_float(w.y & 0xffff0000u);
    b[0] = __uint_as_float(w.z << 16); b[1] = __uint_as_float(w.z & 0xffff0000u); b[2] = __uint_as_float(w.w << 16); b[3] = __uint_as_float(w.w & 0xffff0000u); }
__device__ __forceinline__ float dot4(const f32x4& a) { return (a[0] * a[0] + a[1] * a[1]) + (a[2] * a[2] + a[3] * a[3]); }
__device__ __forceinline__ void row_rstd8(const float* ss, const Unit& u, int wr, int fr, int fq, float (&rs)[2][4]) {
#pragma unroll
    for (int ai = 0; ai < 2; ++ai)
#pragma unroll
        for (int m = 0; m < 4; ++m) {
            const int row = u.pm * BM + ai * HALF + wr * 64 + m * 16 + fr;
            const f32x4* p = (const f32x4*)(ss + (size_t)row * 32 + fq * 8);
            const f32x4 a = p[0], b = p[1];
            float s = ((a[0] + a[1]) + (a[2] + a[3])) + ((b[0] + b[1]) + (b[2] + b[3]));
            s += __shfl_xor(s, 16); s += __shfl_xor(s, 32);
            rs[ai][m] = 1.0f / sqrtf(s * (1.0f / (float)DM) + RMS_EPS);
        }
}
constexpr int STG_PITCH_B = 20, STG_PITCH_F = 36, STG_BYTES = 16 * STG_PITCH_F * 4;
typedef PG8_LAS unsigned* Stg;
constexpr int RSTD_LDS_OFF = STAGE_BYTES + 1024;
constexpr int RSTD_TAG_OFF = STAGE_BYTES + 448;
constexpr int HSC_LDS_OFF = STAGE_BYTES + 2048 + 8 * 2304;
constexpr int STG_LDS_OFF = STAGE_BYTES + 2048;
__device__ __forceinline__ Stg stg_ptr(int wr, int wc) { extern __shared__ __attribute__((aligned(16))) unsigned char pg8_dyn_lds[]; return (Stg)((PG8_LAS unsigned char*)pg8_dyn_lds + STG_LDS_OFF + (wr * 4 + wc) * (16 * 36 * 4)); }
__device__ __forceinline__ int stg_lane() { int l; asm volatile("v_mbcnt_lo_u32_b32 %0, -1, 0\n\tv_mbcnt_hi_u32_b32 %0, -1, %0" : "=v"(l)); return l; }
__device__ __forceinline__ void st_bf16_patch(const Stg S, int ln, int fr, int fq, const u32x4& w, bf16_t* dst, int ld) {
    *(PG8_LAS u32x4*)(S + fr * STG_PITCH_B + 4 * fq) = w;
    const u32x4 t = *(const PG8_LAS u32x4*)(S + (ln >> 2) * STG_PITCH_B + 4 * (ln & 3));
    *(u32x4*)(dst + (size_t)(ln >> 2) * ld + 8 * (ln & 3)) = t;
}
__device__ __forceinline__ void xp_f32_patch(const Stg S, int ln, int fr, int fq, const f32x4& v0, const f32x4& v1, f32x4 (&t)[2]) {
    PG8_LAS float* f = (PG8_LAS float*)S;
    *(PG8_LAS f32x4*)(f + fr * STG_PITCH_F + 8 * fq) = v0; *(PG8_LAS f32x4*)(f + fr * STG_PITCH_F + 8 * fq + 4) = v1;
#pragma unroll
    for (int hf = 0; hf < 2; ++hf) t[hf] = *(const PG8_LAS f32x4*)(f + ((ln >> 3) + 8 * hf) * STG_PITCH_F + 4 * (ln & 7));
}
__device__ __forceinline__ void row_rstd8_cached(const float* ss, const Unit& u, int wr, int fr, int fq, float (&rs)[2][4]) {
    extern __shared__ __attribute__((aligned(16))) unsigned char pg8_dyn_lds2[];
    const PG8_LAS float* tab = (const PG8_LAS float*)((PG8_LAS unsigned char*)pg8_dyn_lds2 + RSTD_LDS_OFF);
    const int tag = *(const PG8_LAS int*)((PG8_LAS unsigned char*)pg8_dyn_lds2 + RSTD_TAG_OFF);
    if (tag == u.pm + 1) {
#pragma unroll
        for (int ai = 0; ai < 2; ++ai)
#pragma unroll
            for (int m = 0; m < 4; ++m) rs[ai][m] = tab[ai * HALF + wr * 64 + m * 16 + fr];
    } else row_rstd8(ss, u, wr, fr, fq, rs);
}
template <bool NOEPI = false> struct EpiSwiGLU_T {
    static constexpr bool PERM = true, AFTER_DRAIN = false, KHOOK = false;
    bf16_t* O; const float* ss;;
    __device__ __forceinline__ void operator()(const f32x4 (&acc)[2][2][4][2], const Unit& u, int wr, int wc, int fr, int fq) const {
        if (NOEPI) {
            f32x4 t = {0.f, 0.f, 0.f, 0.f};
#pragma unroll
            for (int ai = 0; ai < 2; ++ai)
#pragma unroll
                for (int bj = 0; bj < 2; ++bj)
#pragma unroll
                    for (int m = 0; m < 4; ++m) { t += acc[ai][bj][m][0]; t += acc[ai][bj][m][1]; }
            if (t[0] + t[1] + t[2] + t[3] == 12345.678f) O[0] = 1;
            return; }
        const int ln = stg_lane(); const Stg sg = stg_ptr(wr, wc);
        float rs[2][4]; row_rstd8_cached(ss, u, wr, fr, fq, rs);
        const int col0 = u.pn * HALF + wc * 32;
#pragma unroll
        for (int ai = 0; ai < 2; ++ai)
#pragma unroll
            for (int m = 0; m < 4; ++m) {
                const int row0 = u.pm * BM + ai * HALF + wr * 64 + m * 16; const float r = rs[ai][m];
                f32x4 o[2];
#pragma unroll
                for (int n = 0; n < 2; ++n) { const f32x4 g = acc[ai][0][m][n] * r, uu = acc[ai][1][m][n] * r;
#pragma unroll
                    for (int i = 0; i < 4; ++i) o[n][i] = g[i] * sigmoid_f(g[i]) * uu[i]; }
                st_bf16_patch(sg, ln, fr, fq, pack8(o[0], o[1]), O + (size_t)row0 * DFF + col0, DFF);
            }
    }
};
typedef EpiSwiGLU_T<false> EpiSwiGLU;
template <bool BASE16 = false, bool OUT32 = true, bool HSC = false> struct EpiResid_T {
    static constexpr bool PERM = true, AFTER_DRAIN = false, KHOOK = HSC;
    const float* base; float* out; bf16_t* hb; float* sso; const bf16_t* hbi; float scale; int pad_;
    static __device__ __forceinline__ void khook(f32x4 (&acc)[2][2][4][2], int ui, int hidx, int wr) {
        extern __shared__ __attribute__((aligned(16))) unsigned char pg8_dyn_lds3[];
        const int fr = stg_lane() & 15;
        const PG8_LAS float* tab = (const PG8_LAS float*)((PG8_LAS unsigned char*)pg8_dyn_lds3 + HSC_LDS_OFF) + (ui & 1) * 1024 + (hidx - 1);
        __builtin_amdgcn_sched_barrier(0);
#pragma unroll
        for (int ai = 0; ai < 2; ++ai)
#pragma unroll
            for (int mh = 0; mh < 2; ++mh) {
                const float f0 = tab[(ai * HALF + wr * 64 + (2 * mh) * 16 + fr) * 4], f1 = tab[(ai * HALF + wr * 64 + (2 * mh + 1) * 16 + fr) * 4];
#pragma unroll
                for (int bj = 0; bj < 2; ++bj)
#pragma unroll
                    for (int n = 0; n < 2; ++n) { acc[ai][bj][2 * mh][n] *= f0; acc[ai][bj][2 * mh + 1][n] *= f1; }
                __builtin_amdgcn_sched_barrier(0);
            }
    }
    __device__ __forceinline__ void operator()(const f32x4 (&acc)[2][2][4][2], const Unit& u, int wr, int wc, int fr, int fq) const {
        const int ln = stg_lane(); const Stg sg = stg_ptr(wr, wc);
        const int colw = u.pn * BM + wc * 32 + 4 * (ln & 7);
        if (BASE16) {
#pragma unroll
            for (int ai = 0; ai < 2; ++ai) {
                const int rowa = u.pm * BM + ai * HALF + wr * 64 + (ln >> 3);
                u32x2 braw[4][2][2];
#pragma unroll
                for (int m = 0; m < 4; ++m)
#pragma unroll
                    for (int bj = 0; bj < 2; ++bj)
#pragma unroll
                        for (int hf = 0; hf < 2; ++hf) braw[m][bj][hf] = *(const u32x2*)(hbi + (size_t)(rowa + m * 16 + 8 * hf) * DM + colw + bj * HALF);
#pragma unroll
                for (int m = 0; m < 4; ++m) { const int row0 = rowa + m * 16; float s[2] = {0.f, 0.f};
#pragma unroll
                    for (int bj = 0; bj < 2; ++bj) {
                        f32x4 t[2]; xp_f32_patch(sg, ln, fr, fq, acc[ai][bj][m][0] * scale, acc[ai][bj][m][1] * scale, t);
#pragma unroll
                        for (int hf = 0; hf < 2; ++hf) { const size_t off = (size_t)(row0 + 8 * hf) * DM + colw + bj * HALF; const u32x2 bw = braw[m][bj][hf];
                            const f32x4 h = (f32x4){__uint_as_float(bw.x << 16), __uint_as_float(bw.x & 0xffff0000u), __uint_as_float(bw.y << 16), __uint_as_float(bw.y & 0xffff0000u)} + t[hf];
                            if (OUT32) *(f32x4*)(out + off) = h; u32x2 w; w.x = cvt_pk_bf16(h[0], h[1]); w.y = cvt_pk_bf16(h[2], h[3]); *(u32x2*)(hb + off) = w;
                            s[hf] += dot4(h); }
                    }
#pragma unroll
                    for (int hf = 0; hf < 2; ++hf) { float q = s[hf]; q += __shfl_xor(q, 1); q += __shfl_xor(q, 2); q += __shfl_xor(q, 4);
                        if ((ln & 7) == 0) sso[(size_t)(row0 + 8 * hf) * 32 + u.pn * 4 + wc] = q; }
                }
                asm volatile("" ::: "memory");
            }
            return;
        }
#pragma unroll
        for (int ai = 0; ai < 2; ++ai)
#pragma unroll
            for (int mh = 0; mh < 2; ++mh) {
                const int rowa = u.pm * BM + ai * HALF + wr * 64 + (ln >> 3);
                f32x4 bs[2][2][2];
#pragma unroll
                for (int mm = 0; mm < 2; ++mm)
#pragma unroll
                    for (int bj = 0; bj < 2; ++bj)
#pragma unroll
                        for (int hf = 0; hf < 2; ++hf) bs[mm][bj][hf] = *(const f32x4*)(base + (size_t)(rowa + (2 * mh + mm) * 16 + 8 * hf) * DM + colw + bj * HALF);
#pragma unroll
                for (int mm = 0; mm < 2; ++mm) { const int m = 2 * mh + mm;
                    const int row0 = rowa + m * 16; float s[2] = {0.f, 0.f};
#pragma unroll
                    for (int bj = 0; bj < 2; ++bj) {
                        f32x4 t[2]; xp_f32_patch(sg, ln, fr, fq, acc[ai][bj][m][0] * scale, acc[ai][bj][m][1] * scale, t);
#pragma unroll
                        for (int hf = 0; hf < 2; ++hf) { const size_t off = (size_t)(row0 + 8 * hf) * DM + colw + bj * HALF;
                            const f32x4 h = bs[mm][bj][hf] + t[hf];
                            if (OUT32) *(f32x4*)(out + off) = h; u32x2 w; w.x = cvt_pk_bf16(h[0], h[1]); w.y = cvt_pk_bf16(h[2], h[3]); *(u32x2*)(hb + off) = w;
                            s[hf] += dot4(h); }
                    }
#pragma unroll
                    for (int hf = 0; hf < 2; ++hf) { float q = s[hf]; q += __shfl_xor(q, 1); q += __shfl_xor(q, 2); q += __shfl_xor(q, 4);
                        if ((ln & 7) == 0) sso[(size_t)(row0 + 8 * hf) * 32 + u.pn * 4 + wc] = q; }
                }
                asm volatile("" ::: "memory");
            }
    }
};
typedef EpiResid_T<false, true> EpiResid;
template <bool BASE16 = false, bool OUT32 = true> struct EpiPleGate_T {
    static constexpr bool PERM = true, AFTER_DRAIN = false, KHOOK = false;
    float* h; bf16_t* hb; const float* ssi; float* sso; const bf16_t* pp; const bf16_t* hbi;
    __device__ __forceinline__ void operator()(const f32x4 (&acc)[2][2][4][2], const Unit& u, int wr, int wc, int fr, int fq) const {
        const int ln = stg_lane(); const Stg sg = stg_ptr(wr, wc);
        float rs[2][4]; row_rstd8_cached(ssi, u, wr, fr, fq, rs);
        const int colw = u.pn * BM + wc * 32 + 4 * (ln & 7);
        if (BASE16) {
#pragma unroll
            for (int ai = 0; ai < 2; ++ai)
#pragma unroll
                for (int mh = 0; mh < 2; ++mh) {
                const int rowa = u.pm * BM + ai * HALF + wr * 64 + (ln >> 3);
                u32x2 braw[2][2][2], praw[2][2][2];
#pragma unroll
                for (int mm = 0; mm < 2; ++mm)
#pragma unroll
                    for (int bj = 0; bj < 2; ++bj)
#pragma unroll
                        for (int hf = 0; hf < 2; ++hf) { const size_t off = (size_t)(rowa + (2 * mh + mm) * 16 + 8 * hf) * DM + colw + bj * HALF; braw[mm][bj][hf] = *(const u32x2*)(hbi + off); praw[mm][bj][hf] = *(const u32x2*)(pp + off); }
#pragma unroll
                for (int mm = 0; mm < 2; ++mm) { const int m = 2 * mh + mm; const int row0 = rowa + m * 16; const float r = rs[ai][m]; float s[2] = {0.f, 0.f};
#pragma unroll
                    for (int bj = 0; bj < 2; ++bj) {
                        f32x4 g0, g1;
#pragma unroll
                        for (int i = 0; i < 4; ++i) { g0[i] = sigmoid_f(acc[ai][bj][m][0][i] * r); g1[i] = sigmoid_f(acc[ai][bj][m][1][i] * r); }
                        f32x4 t[2]; xp_f32_patch(sg, ln, fr, fq, g0, g1, t);
#pragma unroll
                        for (int hf = 0; hf < 2; ++hf) { const size_t off = (size_t)(row0 + 8 * hf) * DM + colw + bj * HALF; const u32x2 bw = braw[mm][bj][hf], pw = praw[mm][bj][hf];
                            const f32x4 bv = {__uint_as_float(bw.x << 16), __uint_as_float(bw.x & 0xffff0000u), __uint_as_float(bw.y << 16), __uint_as_float(bw.y & 0xffff0000u)};
                            const f32x4 pv = {__uint_as_float(pw.x << 16), __uint_as_float(pw.x & 0xffff0000u), __uint_as_float(pw.y << 16), __uint_as_float(pw.y & 0xffff0000u)};
                            const f32x4 hn = bv + t[hf] * pv;
                            if (OUT32) *(f32x4*)(h + off) = hn; u32x2 w; w.x = cvt_pk_bf16(hn[0], hn[1]); w.y = cvt_pk_bf16(hn[2], hn[3]); *(u32x2*)(hb + off) = w;
                            s[hf] += dot4(hn); }
                    }
#pragma unroll
                    for (int hf = 0; hf < 2; ++hf) { float q = s[hf]; q += __shfl_xor(q, 1); q += __shfl_xor(q, 2); q += __shfl_xor(q, 4);
                        if ((ln & 7) == 0) sso[(size_t)(row0 + 8 * hf) * 32 + u.pn * 4 + wc] = q; }
                }
                asm volatile("" ::: "memory");
            }
            return;
        }
#pragma unroll
        for (int ai = 0; ai < 2; ++ai)
#pragma unroll
            for (int m = 0; m < 4; ++m) {
                const int row0 = u.pm * BM + ai * HALF + wr * 64 + m * 16 + (ln >> 3); const float r = rs[ai][m]; float s[2] = {0.f, 0.f};
                f32x4 bs[2][2]; u32x2 pq[2][2];
#pragma unroll
                for (int bj = 0; bj < 2; ++bj)
#pragma unroll
                    for (int hf = 0; hf < 2; ++hf) { const size_t off = (size_t)(row0 + 8 * hf) * DM + colw + bj * HALF; pq[bj][hf] = *(const u32x2*)(pp + off);
                        if (BASE16) { const u32x2 w = *(const u32x2*)(hbi + off); bs[bj][hf] = (f32x4){__uint_as_float(w.x << 16), __uint_as_float(w.x & 0xffff0000u), __uint_as_float(w.y << 16), __uint_as_float(w.y & 0xffff0000u)}; }
                        else bs[bj][hf] = *(const f32x4*)(h + off); }
#pragma unroll
                for (int bj = 0; bj < 2; ++bj) {
                    f32x4 g0, g1;
#pragma unroll
                    for (int i = 0; i < 4; ++i) { g0[i] = sigmoid_f(acc[ai][bj][m][0][i] * r); g1[i] = sigmoid_f(acc[ai][bj][m][1][i] * r); }
                    f32x4 t[2]; xp_f32_patch(sg, ln, fr, fq, g0, g1, t);
#pragma unroll
                    for (int hf = 0; hf < 2; ++hf) { const size_t off = (size_t)(row0 + 8 * hf) * DM + colw + bj * HALF;
                        const u32x2 pw = pq[bj][hf]; f32x4 pv; pv[0] = __uint_as_float(pw.x << 16); pv[1] = __uint_as_float(pw.x & 0xffff0000u); pv[2] = __uint_as_float(pw.y << 16); pv[3] = __uint_as_float(pw.y & 0xffff0000u);
                        const f32x4 hn = bs[bj][hf] + t[hf] * pv;
                        if (OUT32) *(f32x4*)(h + off) = hn; u32x2 w; w.x = cvt_pk_bf16(hn[0], hn[1]); w.y = cvt_pk_bf16(hn[2], hn[3]); *(u32x2*)(hb + off) = w;
                        s[hf] += dot4(hn); }
                }
#pragma unroll
                for (int hf = 0; hf < 2; ++hf) { float q = s[hf]; q += __shfl_xor(q, 1); q += __shfl_xor(q, 2); q += __shfl_xor(q, 4);
                    if ((ln & 7) == 0) sso[(size_t)(row0 + 8 * hf) * 32 + u.pn * 4 + wc] = q; }
                asm volatile("" ::: "memory");
            }
    }
};
typedef EpiPleGate_T<false, true> EpiPleGate;
struct EpiInProj {
    static constexpr bool PERM = true, AFTER_DRAIN = false, KHOOK = false;
    bf16_t *qb, *kb, *vb, *rb; const float* ss;
    __device__ __forceinline__ void operator()(const f32x4 (&acc)[2][2][4][2], const Unit& u, int wr, int wc, int fr, int fq) const {
        const int ln = stg_lane(); const Stg sg = stg_ptr(wr, wc);
        float rs[2][4]; row_rstd8_cached(ss, u, wr, fr, fq, rs);
        const int pn = u.pn; int mode, ld, colt; bf16_t* O;
        if (pn < 4) { mode = 0; O = qb; ld = 1024; colt = pn * BM; } else if (pn < 8) { mode = 1; O = kb; ld = 1024; colt = (pn - 4) * BM; }
        else if (pn < 16) { mode = 2; O = vb; ld = 2048; colt = (pn - 8) * BM; } else { mode = 3; O = rb; ld = 2048; colt = (pn - 16) * BM; }
        const int colp = colt + wc * 32;
#pragma unroll
        for (int ai = 0; ai < 2; ++ai)
#pragma unroll
            for (int m = 0; m < 4; ++m) {
                const int row0 = u.pm * BM + ai * HALF + wr * 64 + m * 16; const float r = rs[ai][m];
#pragma unroll
                for (int bj = 0; bj < 2; ++bj) {
                    f32x4 v0 = acc[ai][bj][m][0] * r, v1 = acc[ai][bj][m][1] * r;
                    if (mode == 0) { v0 = v0 * 0.0625f; v1 = v1 * 0.0625f; }
                    if (mode == 3) {
#pragma unroll
                        for (int i = 0; i < 4; ++i) { v0[i] = v0[i] * sigmoid_f(v0[i]); v1[i] = v1[i] * sigmoid_f(v1[i]); } }
                    st_bf16_patch(sg, ln, fr, fq, pack8(v0, v1), O + (size_t)row0 * ld + colp + bj * HALF, ld);
                }
            }
    }
};
struct EpiHeadNorm {
    static constexpr bool PERM = true, AFTER_DRAIN = false, KHOOK = false;
    bf16_t* O0; bf16_t* O1; int ld; const float* ss; const float* g; float oscale; int norm_tiles;;
    __device__ __forceinline__ void operator()(const f32x4 (&acc)[2][2][4][2], const Unit& u, int wr, int wc, int fr, int fq) const {
        const int ln = stg_lane(); const Stg sg = stg_ptr(wr, wc);
        float rs[2][4]; row_rstd8_cached(ss, u, wr, fr, fq, rs);
        const bool nrm = u.pn < norm_tiles; bf16_t* O = nrm ? O0 : O1; const int colp = (nrm ? u.pn : u.pn - norm_tiles) * BM + 64 * wc;
        f32x4 gv[2][2];
#pragma unroll
        for (int bj = 0; bj < 2; ++bj)
#pragma unroll
            for (int n = 0; n < 2; ++n) gv[bj][n] = *(const f32x4*)(g + 32 * bj + 8 * fq + 4 * n) * oscale;
#pragma unroll
        for (int ai = 0; ai < 2; ++ai)
#pragma unroll
            for (int m = 0; m < 4; ++m) {
                const int row0 = u.pm * BM + ai * HALF + wr * 64 + m * 16; const float r = rs[ai][m];
                f32x4 v[2][2]; float s = 0.f;
#pragma unroll
                for (int bj = 0; bj < 2; ++bj)
#pragma unroll
                    for (int n = 0; n < 2; ++n) { v[bj][n] = acc[ai][bj][m][n] * r; s += dot4(v[bj][n]); }
                s += __shfl_xor(s, 16); s += __shfl_xor(s, 32);
                const float hn = 1.0f / sqrtf(s * (1.0f / 64.0f) + RMS_EPS);
#pragma unroll
                for (int bj = 0; bj < 2; ++bj) {
                    f32x4 o0 = v[bj][0], o1 = v[bj][1];
                    if (nrm) { o0 = o0 * hn * gv[bj][0]; o1 = o1 * hn * gv[bj][1]; }
                    st_bf16_patch(sg, ln, fr, fq, pack8(o0, o1), O + (size_t)row0 * ld + colp + 32 * bj, ld);
                }
            }
    }
};
struct EpiPlainBf16 {
    static constexpr bool PERM = true, AFTER_DRAIN = false, KHOOK = false;
    bf16_t* O; int ld;;
    __device__ __forceinline__ void operator()(const f32x4 (&acc)[2][2][4][2], const Unit& u, int wr, int wc, int fr, int fq) const {
        const int ln = stg_lane(); const Stg sg = stg_ptr(wr, wc);
        const int colp = u.pn * BM + wc * 32;
#pragma unroll
        for (int ai = 0; ai < 2; ++ai)
#pragma unroll
            for (int m = 0; m < 4; ++m) {
                const int row0 = u.pm * BM + ai * HALF + wr * 64 + m * 16;
#pragma unroll
                for (int bj = 0; bj < 2; ++bj) { st_bf16_patch(sg, ln, fr, fq, pack8(acc[ai][bj][m][0], acc[ai][bj][m][1]), O + (size_t)row0 * ld + colp + bj * HALF, ld); asm volatile("" ::: "memory"); }
            }
    }
};
struct NoPre { __device__ __forceinline__ void operator()() const {} };
template <class Epi, class Sched, bool ALIGN_EPI = false, bool SP2 = false, int DIAG = 0  , class Pre = NoPre>
__device__ __forceinline__ void gemm_phase(PG8_LAS unsigned char* lds, const Gemm g, const Sched& S, const Epi& E, const int tid_in, const Pre& pre = Pre()) {
    int tid_l_ = tid_in; asm volatile("" : "+v"(tid_l_));
    const int tid = tid_l_, wid = __builtin_amdgcn_readfirstlane(tid >> 6), lane = tid & 63, wr = wid >> 2, wc = wid & 3, fr = lane & 15, fq = lane >> 4;
    const int K = g.K, nt = K / BK, ld = g.ld;
    unsigned voffA[2], voffB[2];
#pragma unroll
    for (int i = 0; i < 2; ++i) { int R, C;
#if MK_FULLLINE
        { const int b = tid * 16 + i * 8192, st = b >> 10, rr = (b & 1023) >> 7, cp = (b & 127) >> 4; R = st * 8 + rr; C = (cp ^ (((st & 1) << 2) + (rr >> 1))) * 8; }
#else
        stage_rc(tid * 16 + i * 8192, R, C);
#endif
        const int Rb = Epi::PERM ? ((R & ~31) + perm32(R & 31)) : R;
        voffA[i] = (unsigned)(R * ld + C) * 2u; voffB[i] = (unsigned)(Rb * ld + C) * 2u; }
    const ptrdiff_t kstep = (DIAG == 4) ? -(ptrdiff_t)(BK * 2) : (ptrdiff_t)(BK * 2);
    const size_t kfirst = (DIAG == 4) ? (size_t)(nt - 1) * (BK * 2) : 0;
    const unsigned hstep = (unsigned)(HALF * ld * 2);
    const size_t tstep = (size_t)2 * hstep;
    const unsigned ldsw = (unsigned)wid * 1024u;
#if MK_FULLLINE
    int aoffk[2], boffk[2];
#pragma unroll
    for (int k = 0; k < 2; ++k) { const int ra = wr * 64 + fr, rb = wc * 32 + fr; aoffk[k] = (ra >> 3) * 1024 + (ra & 7) * 128 + (((k * 4 + fq) ^ (fr >> 1)) << 4); boffk[k] = (rb >> 3) * 1024 + (rb & 7) * 128 + (((k * 4 + fq) ^ (fr >> 1)) << 4); }
#define PG8_AOFF(m, k) (aoffk[k] + (m) * 2048)
#define PG8_BOFF(n, k) (boffk[k] + (n) * 2048)
#else
    const int aoff = lds_byte(wr * 64 + fr, fq * 8), boff = lds_byte(wc * 32 + fr, fq * 8);
#define PG8_AOFF(m, k) (aoff + (m) * 2048 + (k) * 1024)
#define PG8_BOFF(n, k) (boff + (n) * 2048 + (k) * 1024)
#endif
#define PG8_SA(b, h) (((b) * 2 + (h)) * HTB)
#define PG8_SB(b, h) ((4 + (b) * 2 + (h)) * HTB)
#define PG8_STAGE(bufoff, gbase, voff) do { _Pragma("unroll") for (int _i = 0; _i < 2; ++_i) \
        __builtin_amdgcn_global_load_lds((const unsigned*)((const char*)(gbase) + (voff)[_i]), (PG8_LAS unsigned*)(lds + (bufoff) + ldsw + _i * 8192), 16, 0, 0); } while (0)
#define PG8_STAGEA(bufoff, gbase, voff) do { _Pragma("unroll") for (int _i = 0; _i < 2; ++_i) \
        __builtin_amdgcn_global_load_lds((const unsigned*)((const char*)(gbase) + (voff)[_i]), (PG8_LAS unsigned*)(lds + (bufoff) + ldsw + _i * 8192), 16, 0, (DIAG == 3) ? 2 : 0); } while (0)
#define PG8_LDA(dst, b, h) do { _Pragma("unroll") for (int m = 0; m < 4; ++m) _Pragma("unroll") for (int k = 0; k < 2; ++k) dst[m][k] = *(const PG8_LAS bf16x8*)(lds + PG8_SA(b, h) + PG8_AOFF(m, k)); } while (0)
#define PG8_LDB(dst, b, h) do { _Pragma("unroll") for (int n = 0; n < 2; ++n) _Pragma("unroll") for (int k = 0; k < 2; ++k) dst[n][k] = *(const PG8_LAS bf16x8*)(lds + PG8_SB(b, h) + PG8_BOFF(n, k)); } while (0)
#define PG8_MMA(ai, bj, At, Bt) do { if (DIAG == 1 && (ai) == 1) break; __builtin_amdgcn_s_setprio(MK_PRIO); _Pragma("unroll") for (int m = 0; m < 4; ++m) _Pragma("unroll") for (int n = 0; n < 2; ++n) _Pragma("unroll") for (int k = 0; k < 2; ++k) \
        acc[ai][bj][m][n] = __builtin_amdgcn_mfma_f32_16x16x32_bf16(Bt[n][k], At[m][k], acc[ai][bj][m][n], 0, 0, 0); __builtin_amdgcn_s_setprio(MK_LPRIO); } while (0)
#define PG8_MMA_PAIR_BAR(ai, At, Ba, Bb) do { if (DIAG == 1 && (ai) == 1) { PG8_BAR; break; } __builtin_amdgcn_s_setprio(MK_PRIO); \
        _Pragma("unroll") for (int m = 0; m < 4; ++m) _Pragma("unroll") for (int n = 0; n < 2; ++n) _Pragma("unroll") for (int k = 0; k < 2; ++k) \
            acc[ai][0][m][n] = __builtin_amdgcn_mfma_f32_16x16x32_bf16(Ba[n][k], At[m][k], acc[ai][0][m][n], 0, 0, 0); \
        _Pragma("unroll") for (int m = 0; m < 4; ++m) _Pragma("unroll") for (int n = 0; n < 2; ++n) _Pragma("unroll") for (int k = 0; k < 2; ++k) { \
            if ((m * 4 + n * 2 + k) == 16 - MK_EARLY) { __builtin_amdgcn_sched_barrier(0); __builtin_amdgcn_s_barrier(); __builtin_amdgcn_sched_barrier(0); } \
            acc[ai][1][m][n] = __builtin_amdgcn_mfma_f32_16x16x32_bf16(Bb[n][k], At[m][k], acc[ai][1][m][n], 0, 0, 0); } \
        __builtin_amdgcn_s_setprio(0); } while (0)
#define PG8_WAIT_V(n) asm volatile("s_waitcnt vmcnt(" #n ")" ::: "memory")
#define PG8_WAIT_L(n) asm volatile("s_waitcnt lgkmcnt(" #n ")" ::: "memory")
#define PG8_BAR __builtin_amdgcn_s_barrier()
#define PG8_SCHED __builtin_amdgcn_sched_barrier(0)
    Unit cur, nxt; int ui = 0;
    if (!S.next(0, cur)) return;
    f32x4 acc[2][2][4][2];
#pragma unroll
    for (int a = 0; a < 2; ++a)
#pragma unroll
        for (int b = 0; b < 2; ++b)
#pragma unroll
            for (int m = 0; m < 4; ++m)
#pragma unroll
                for (int n = 0; n < 2; ++n) acc[a][b][m][n] = (f32x4){0.f, 0.f, 0.f, 0.f};
    bf16x8 At[4][2], B0[2][2], B1[2][2];
    const char* cA = (const char*)g.A + (size_t)(cur.pm & g.pm_mask) * tstep + kfirst; const char* cB = (const char*)g.Bt + (size_t)(cur.pn & g.pn_mask) * tstep + kfirst;
    S.a_ready(cur);
#if MK_KSR
    if constexpr (SP2) {
        PG8_STAGE(PG8_SB(0, 0), cB, voffB); PG8_STAGE(PG8_SB(0, 1), cB + hstep, voffB); PG8_STAGEA(PG8_SA(0, 0), cA, voffA); PG8_STAGEA(PG8_SA(0, 1), cA + hstep, voffA);
        if (wr == 1) { PG8_STAGE(PG8_SB(1, 0), cB + kstep, voffB); PG8_STAGE(PG8_SB(1, 1), cB + hstep + kstep, voffB); PG8_STAGEA(PG8_SA(1, 0), cA + kstep, voffA); PG8_STAGEA(PG8_SA(1, 1), cA + hstep + kstep, voffA); }
        PG8_WAIT_V(0); PG8_BAR;
        if (wr == 1) PG8_BAR;
    } else
#endif
#if MK_SP4
    if constexpr (SP2) {
        PG8_STAGE(PG8_SB(0, 0), cB, voffB); PG8_STAGE(PG8_SB(0, 1), cB + hstep, voffB); PG8_STAGEA(PG8_SA(0, 0), cA, voffA); PG8_STAGEA(PG8_SA(0, 1), cA + hstep, voffA);
        if (wr == 1) { PG8_STAGE(PG8_SB(1, 0), cB + kstep, voffB); PG8_STAGE(PG8_SB(1, 1), cB + hstep + kstep, voffB); PG8_STAGEA(PG8_SA(1, 0), cA + kstep, voffA); }
        PG8_WAIT_V(0); PG8_BAR;
        if (wr == 1) PG8_BAR;
    } else
#endif
    if constexpr (SP2) {
        PG8_STAGE(PG8_SB(0, 0), cB, voffB); PG8_STAGE(PG8_SB(0, 1), cB + hstep, voffB); PG8_STAGEA(PG8_SA(0, 0), cA, voffA); PG8_STAGEA(PG8_SA(0, 1), cA + hstep, voffA);
        pre();
        if (wr == 1) PG8_BAR;
        PG8_WAIT_V(2); PG8_BAR;
        PG8_STAGE(PG8_SB(1, 0), cB + kstep, voffB); PG8_STAGEA(PG8_SA(1, 0), cA + kstep, voffA); PG8_STAGE(PG8_SB(1, 1), cB + hstep + kstep, voffB);
        PG8_WAIT_V(6); PG8_BAR;
    } else {
        PG8_STAGE(PG8_SB(0, 0), cB, voffB); PG8_STAGEA(PG8_SA(0, 0), cA, voffA); PG8_STAGE(PG8_SB(0, 1), cB + hstep, voffB); PG8_STAGEA(PG8_SA(0, 1), cA + hstep, voffA);
        if (wr == 1) PG8_BAR;
        PG8_WAIT_V(4); PG8_BAR;
        PG8_STAGE(PG8_SB(1, 0), cB + kstep, voffB); PG8_STAGEA(PG8_SA(1, 0), cA + kstep, voffA); PG8_STAGE(PG8_SB(1, 1), cB + hstep + kstep, voffB);
        PG8_WAIT_V(6); PG8_BAR;
    }
    for (;;) {
        const bool has_next = S.next(ui + 1, nxt);
        const char* nA = has_next ? (const char*)g.A + (size_t)(nxt.pm & g.pm_mask) * tstep + kfirst : cA; const char* nB = has_next ? (const char*)g.Bt + (size_t)(nxt.pn & g.pn_mask) * tstep + kfirst : cB;
        for (int t = 0; t < nt; t += 2) {
            const bool last = (t == nt - 2);
            const char* a1 = cA + (ptrdiff_t)(t + 1) * kstep;
            const char* a2 = last ? nA : cA + (ptrdiff_t)(t + 2) * kstep; const char* b2 = last ? nB : cB + (ptrdiff_t)(t + 2) * kstep;
            const char* a3 = a2 + kstep; const char* b3 = b2 + kstep;
            if (last && has_next) S.a_ready(nxt);
            if constexpr (Epi::KHOOK && MK_HOOK_IN) { if (t > 0 && (t & 7) == 0) Epi::khook(acc, ui, t >> 3, wr); }
#if MK_KSR
            if constexpr (SP2) {
            const char* b1 = cB + (ptrdiff_t)(t + 1) * kstep;
#define PG8_DMA1(bufoff, gbase, voff, i_) do { unsigned vo_ = (voff)[i_]; asm volatile("" : "+v"(vo_)); \
        __builtin_amdgcn_global_load_lds((const unsigned*)((const char*)(gbase) + vo_), (PG8_LAS unsigned*)(lds + (bufoff) + ldsw + (i_) * 8192), 16, 0, 0); } while (0)
#define PG8_KDMA(j, b, pa, pb) do { if ((j) == 0) PG8_DMA1(PG8_SB(b, 0), pb, voffB, 0); else if ((j) == 1) PG8_DMA1(PG8_SB(b, 0), pb, voffB, 1); else if ((j) == 2) PG8_DMA1(PG8_SB(b, 1), (pb) + hstep, voffB, 0); else if ((j) == 3) PG8_DMA1(PG8_SB(b, 1), (pb) + hstep, voffB, 1); \
        else if ((j) == 4) PG8_DMA1(PG8_SA(b, 0), pa, voffA, 0); else if ((j) == 5) PG8_DMA1(PG8_SA(b, 0), pa, voffA, 1); else if ((j) == 6) PG8_DMA1(PG8_SA(b, 1), (pa) + hstep, voffA, 0); else PG8_DMA1(PG8_SA(b, 1), (pa) + hstep, voffA, 1); } while (0)
#define PG8_G8(b, pa, pb) do { _Pragma("unroll") for (int j_ = 0; j_ < 8; ++j_) PG8_KDMA(j_, b, pa, pb); } while (0)
#define PG8_KLD(b, k) do { _Pragma("unroll") for (int n = 0; n < 2; ++n) { B0[n][0] = *(const PG8_LAS bf16x8*)(lds + PG8_SB(b, 0) + PG8_BOFF(n, k)); B1[n][0] = *(const PG8_LAS bf16x8*)(lds + PG8_SB(b, 1) + PG8_BOFF(n, k)); } PG8_SCHED; \
        _Pragma("unroll") for (int m = 0; m < 4; ++m) { At[m][0] = *(const PG8_LAS bf16x8*)(lds + PG8_SA(b, 0) + PG8_AOFF(m, k)); At[m][1] = *(const PG8_LAS bf16x8*)(lds + PG8_SA(b, 1) + PG8_AOFF(m, k)); } } while (0)
#define PG8_KMMA(DMAT, b, pa, pb) do { __builtin_amdgcn_s_setprio(MK_PRIO); \
        _Pragma("unroll") for (int ai = 0; ai < 2; ++ai) _Pragma("unroll") for (int m = 0; m < 4; ++m) { _Pragma("unroll") for (int n = 0; n < 2; ++n) { \
            acc[ai][0][m][n] = __builtin_amdgcn_mfma_f32_16x16x32_bf16(B0[n][0], At[m][ai], acc[ai][0][m][n], 0, 0, 0); acc[ai][1][m][n] = __builtin_amdgcn_mfma_f32_16x16x32_bf16(B1[n][0], At[m][ai], acc[ai][1][m][n], 0, 0, 0); } \
            if (DMAT && MK_KSR_TDMA) { if (wr == 1) PG8_KDMA(ai * 4 + m, b, pa, pb); } PG8_SCHED; } \
        __builtin_amdgcn_s_setprio(0); } while (0)
            PG8_KLD(0, 0); PG8_SCHED; if (wr == 0) PG8_G8(1, a1, b1);
            PG8_WAIT_L(0); PG8_BAR; PG8_KMMA(0, 0, a2, b2); PG8_BAR; PG8_SCHED;
            PG8_KLD(0, 1); if (wr == 1) PG8_WAIT_V(0);
            PG8_WAIT_L(0); PG8_BAR; PG8_KMMA(1, 0, a2, b2); if (wr == 0) PG8_WAIT_V(0); PG8_BAR; PG8_SCHED;
            PG8_KLD(1, 0); PG8_SCHED; if (wr == 0) PG8_G8(0, a2, b2);
            PG8_WAIT_L(0); PG8_BAR; PG8_KMMA(0, 1, a3, b3); PG8_BAR; PG8_SCHED;
            PG8_KLD(1, 1); if (wr == 1) PG8_WAIT_V(0);
            PG8_WAIT_L(0); PG8_BAR; PG8_KMMA(1, 1, a3, b3); if (wr == 0) PG8_WAIT_V(0); PG8_BAR; PG8_SCHED;
#undef PG8_DMA1
#undef PG8_G8
#undef PG8_KDMA
#undef PG8_KLD
#undef PG8_KMMA
            } else
#endif
#if MK_SP4
            if constexpr (SP2) {
            const char* b1 = cB + (ptrdiff_t)(t + 1) * kstep;
#define PG8_DMA1(bufoff, gbase, voff, i_) do { unsigned vo_ = (voff)[i_]; asm volatile("" : "+v"(vo_));   \
        __builtin_amdgcn_global_load_lds((const unsigned*)((const char*)(gbase) + vo_), (PG8_LAS unsigned*)(lds + (bufoff) + ldsw + (i_) * 8192), 16, 0, 0); } while (0)
#define PG8_G6(b, pa, pb) do { PG8_STAGE(PG8_SB(b, 0), pb, voffB); PG8_STAGE(PG8_SB(b, 1), (pb) + hstep, voffB); PG8_STAGEA(PG8_SA(b, 0), pa, voffA); } while (0)
#define PG8_G2(b, pa) PG8_STAGEA(PG8_SA(b, 1), (pa) + hstep, voffA)
#define PG8_ROWDMA(r, bT, paT, pbT, bL, paL) do { if (wr == 1) { \
            if ((r) == 0) PG8_DMA1(PG8_SB(bT, 0), pbT, voffB, 0); else if ((r) == 1) PG8_DMA1(PG8_SB(bT, 0), pbT, voffB, 1); \
            else if ((r) == 2) PG8_DMA1(PG8_SB(bT, 1), (pbT) + hstep, voffB, 0); else if ((r) == 3) PG8_DMA1(PG8_SB(bT, 1), (pbT) + hstep, voffB, 1); \
            else if ((r) == 4) PG8_DMA1(PG8_SA(bT, 0), paT, voffA, 0); else if ((r) == 5) PG8_DMA1(PG8_SA(bT, 0), paT, voffA, 1); \
        } else { if ((r) == 0) PG8_DMA1(PG8_SA(bL, 1), (paL) + hstep, voffA, 0); else if ((r) == 1) PG8_DMA1(PG8_SA(bL, 1), (paL) + hstep, voffA, 1); } } while (0)
#define PG8_MMA_ROW(ai, m) do { _Pragma("unroll") for (int n = 0; n < 2; ++n) _Pragma("unroll") for (int k = 0; k < 2; ++k) { \
        acc[ai][0][m][n] = __builtin_amdgcn_mfma_f32_16x16x32_bf16(B0[n][k], At[m][k], acc[ai][0][m][n], 0, 0, 0); acc[ai][1][m][n] = __builtin_amdgcn_mfma_f32_16x16x32_bf16(B1[n][k], At[m][k], acc[ai][1][m][n], 0, 0, 0); } } while (0)
#define PG8_SEG_MMA(b, bT, paT, pbT, bL, paL) do { __builtin_amdgcn_s_setprio(MK_PRIO); \
        _Pragma("unroll") for (int m = 0; m < 4; ++m) { PG8_MMA_ROW(0, m); _Pragma("unroll") for (int k = 0; k < 2; ++k) At[m][k] = *(const PG8_LAS bf16x8*)(lds + PG8_SA(b, 1) + PG8_AOFF(m, k)); PG8_ROWDMA(m, bT, paT, pbT, bL, paL); PG8_SCHED; } \
        _Pragma("unroll") for (int m = 0; m < 4; ++m) { PG8_MMA_ROW(1, m); PG8_ROWDMA(4 + m, bT, paT, pbT, bL, paL); PG8_SCHED; } \
        __builtin_amdgcn_s_setprio(0); } while (0)
            PG8_LDB(B0, 0, 0); PG8_LDB(B1, 0, 1); PG8_SCHED; PG8_LDA(At, 0, 0); PG8_SCHED;
            if (wr == 0) { PG8_G6(1, a1, b1); PG8_WAIT_V(6); } else { PG8_G2(1, a1); PG8_WAIT_V(2); }
            PG8_WAIT_L(0); PG8_BAR;
            PG8_SEG_MMA(0, 0, a2, b2, 1, a1);
            if (wr == 0) PG8_WAIT_V(2); else PG8_WAIT_V(6);
            PG8_WAIT_L(0); PG8_BAR; PG8_SCHED;
            PG8_LDB(B0, 1, 0); PG8_LDB(B1, 1, 1); PG8_SCHED; PG8_LDA(At, 1, 0); PG8_SCHED;
            if (wr == 0) { PG8_G6(0, a2, b2); PG8_WAIT_V(6); } else { PG8_G2(0, a2); PG8_WAIT_V(2); }
            PG8_WAIT_L(0); PG8_BAR;
            PG8_SEG_MMA(1, 1, a3, b3, 0, a2);
            if (wr == 0) PG8_WAIT_V(2); else PG8_WAIT_V(6);
            PG8_WAIT_L(0); PG8_BAR; PG8_SCHED;
#undef PG8_DMA1
#undef PG8_G6
#undef PG8_G2
#undef PG8_ROWDMA
#undef PG8_MMA_ROW
#undef PG8_SEG_MMA
            } else
#endif
            if constexpr (SP2) {
            PG8_LDB(B0, 0, 0); PG8_LDB(B1, 0, 1); PG8_SCHED; PG8_LDA(At, 0, 0); PG8_STAGEA(PG8_SA(1, 1), a1 + hstep, voffA);
            PG8_WAIT_V(8); PG8_WAIT_L(0); PG8_BAR; if (MK_EARLY > 0) { PG8_MMA_PAIR_BAR(0, At, B0, B1); } else { PG8_MMA(0, 0, At, B0); PG8_MMA(0, 1, At, B1); PG8_BAR; } PG8_SCHED;
            PG8_LDA(At, 0, 1); PG8_STAGE(PG8_SB(0, 0), b2, voffB); PG8_STAGE(PG8_SB(0, 1), b2 + hstep, voffB); PG8_STAGEA(PG8_SA(0, 0), a2, voffA);
            PG8_WAIT_V(8); PG8_WAIT_L(0); PG8_BAR; if (MK_EARLY > 0) { PG8_MMA_PAIR_BAR(1, At, B0, B1); } else { PG8_MMA(1, 0, At, B0); PG8_MMA(1, 1, At, B1); PG8_BAR; } PG8_SCHED;
            PG8_LDB(B0, 1, 0); PG8_LDB(B1, 1, 1); PG8_SCHED; PG8_LDA(At, 1, 0); PG8_STAGEA(PG8_SA(0, 1), a2 + hstep, voffA);
            PG8_WAIT_V(8); PG8_WAIT_L(0); PG8_BAR; if (MK_EARLY > 0) { PG8_MMA_PAIR_BAR(0, At, B0, B1); } else { PG8_MMA(0, 0, At, B0); PG8_MMA(0, 1, At, B1); PG8_BAR; } PG8_SCHED;
            PG8_LDA(At, 1, 1); PG8_STAGE(PG8_SB(1, 0), b3, voffB); PG8_STAGE(PG8_SB(1, 1), b3 + hstep, voffB); PG8_STAGEA(PG8_SA(1, 0), a3, voffA);
            PG8_WAIT_V(8); PG8_WAIT_L(0); PG8_BAR; if (MK_EARLY > 0) { PG8_MMA_PAIR_BAR(1, At, B0, B1); } else { PG8_MMA(1, 0, At, B0); PG8_MMA(1, 1, At, B1); PG8_BAR; } PG8_SCHED;
            } else {
            PG8_LDB(B0, 0, 0); PG8_SCHED; PG8_LDA(At, 0, 0); PG8_STAGEA(PG8_SA(1, 1), a1 + hstep, voffA);
            PG8_WAIT_L(8); PG8_BAR; PG8_WAIT_L(0); PG8_MMA(0, 0, At, B0); PG8_BAR; PG8_SCHED;
            PG8_LDB(B1, 0, 1); PG8_STAGE(PG8_SB(0, 0), b2, voffB);
            PG8_BAR; PG8_WAIT_L(0); PG8_MMA(0, 1, At, B1); PG8_BAR;
            PG8_LDA(At, 0, 1); PG8_STAGEA(PG8_SA(0, 0), a2, voffA);
            PG8_BAR; PG8_WAIT_L(0); PG8_MMA(1, 0, At, B0); PG8_BAR; PG8_SCHED;
            PG8_STAGE(PG8_SB(0, 1), b2 + hstep, voffB);
            PG8_WAIT_V(6); PG8_BAR; PG8_MMA(1, 1, At, B1); PG8_BAR;
            PG8_LDB(B0, 1, 0); PG8_SCHED; PG8_LDA(At, 1, 0); PG8_STAGEA(PG8_SA(0, 1), a2 + hstep, voffA);
            PG8_WAIT_L(8); PG8_BAR; PG8_WAIT_L(0); PG8_MMA(0, 0, At, B0); PG8_BAR; PG8_SCHED;
            PG8_LDB(B1, 1, 1); PG8_STAGE(PG8_SB(1, 0), b3, voffB);
            PG8_BAR; PG8_WAIT_L(0); PG8_MMA(0, 1, At, B1); PG8_BAR;
            PG8_LDA(At, 1, 1); PG8_STAGEA(PG8_SA(1, 0), a3, voffA);
            PG8_BAR; PG8_WAIT_L(0); PG8_MMA(1, 0, At, B0); PG8_BAR; PG8_SCHED;
            PG8_STAGE(PG8_SB(1, 1), b3 + hstep, voffB);
            PG8_WAIT_V(6); PG8_BAR; PG8_MMA(1, 1, At, B1); PG8_BAR;
            }
        }
        if constexpr (Epi::KHOOK) Epi::khook(acc, ui, 4, wr);
        if constexpr (ALIGN_EPI) { if (wr == 0) PG8_BAR; }
        if constexpr (!Epi::AFTER_DRAIN) { const int ln2_ = stg_lane(); E(acc, cur, wr, wc, ln2_ & 15, ln2_ >> 4); S.done(cur); }
        if (!has_next) break;
#pragma unroll
        for (int a = 0; a < 2; ++a)
#pragma unroll
            for (int b = 0; b < 2; ++b)
#pragma unroll
                for (int m = 0; m < 4; ++m)
#pragma unroll
                    for (int n = 0; n < 2; ++n) acc[a][b][m][n] = (f32x4){0.f, 0.f, 0.f, 0.f};
        cur = nxt; cA = nA; cB = nB; ++ui;
        if constexpr (ALIGN_EPI) { if (wr == 1) PG8_BAR; }
    }
    PG8_WAIT_V(0);
    if constexpr (!ALIGN_EPI) { if (wr == 0) PG8_BAR; }
    PG8_BAR;
    if constexpr (Epi::AFTER_DRAIN) { E.fused(acc, cur, wr, wc, fr, fq, lds, wid, lane); S.done(cur); }
#undef PG8_AOFF
#undef PG8_BOFF
#undef PG8_SA
#undef PG8_SB
#undef PG8_STAGE
#undef PG8_STAGEA
#undef PG8_LDA
#undef PG8_LDB
#undef PG8_MMA
#undef PG8_WAIT_V
#undef PG8_WAIT_L
#undef PG8_BAR
#undef PG8_SCHED
}
template <class Epi, class Sched, bool ALIGN_EPI = true>
__device__ __forceinline__ void gemm_phase_ks(PG8_LAS unsigned char* lds, const Gemm g, const Sched& S, const Epi& E, const int tid_in) {
    int tid_l_ = tid_in; asm volatile("" : "+v"(tid_l_));
    const int tid = tid_l_, wid = __builtin_amdgcn_readfirstlane(tid >> 6), lane = tid & 63, wr = wid >> 2, wc = wid & 3, fr = lane & 15, fq = lane >> 4;
    const int K = g.K, nt = K / BK, ld = g.ld;
    unsigned voffA[2], voffB[2];
#pragma unroll
    for (int i = 0; i < 2; ++i) { const int b = tid * 16 + i * 8192, st = b >> 10, sb = b & 1023, swz = sb ^ (((sb >> 9) & 1) << 5); const int R = st * 16 + (swz >> 6), C = (swz & 63) >> 1;
        const int Rb = Epi::PERM ? ((R & ~31) + perm32(R & 31)) : R;
        voffA[i] = (unsigned)(R * ld + C) * 2u; voffB[i] = (unsigned)(Rb * ld + C) * 2u; }
    const ptrdiff_t kstep = (ptrdiff_t)(BK * 2);
    const size_t tstep = (size_t)BM * ld * 2;
    const unsigned ldsw = (unsigned)wid * 1024u;
    const int fsub = lds_byte(fr, fq * 8);
    const int aoff = (wr * 4) * 1024 + fsub, boff = (wc * 2) * 1024 + fsub;
#define KS_SLOT(b, kh, ab) (((((b) * 2 + (kh)) * 2) + (ab)) * 16384)
#define KS_STAGE1(slot, gbase, voff) do { _Pragma("unroll") for (int _i = 0; _i < 2; ++_i) \
        __builtin_amdgcn_global_load_lds((const unsigned*)((const char*)(gbase) + (voff)[_i]), (PG8_LAS unsigned*)(lds + (slot) + ldsw + _i * 8192), 16, 0, 0); } while (0)
#define KS_STAGE(b, kh, pa, pb) do { KS_STAGE1(KS_SLOT(b, kh, 1), (pb) + 64 * (kh), voffB); KS_STAGE1(KS_SLOT(b, kh, 0), (pa) + 64 * (kh), voffA); } while (0)
#define KS_LD(b, kh) do { _Pragma("unroll") for (int bj = 0; bj < 2; ++bj) _Pragma("unroll") for (int n = 0; n < 2; ++n) Bf[bj][n] = *(const PG8_LAS bf16x8*)(lds + KS_SLOT(b, kh, 1) + boff + (8 * bj + n) * 1024); \
        __builtin_amdgcn_sched_barrier(0); \
        _Pragma("unroll") for (int ai = 0; ai < 2; ++ai) _Pragma("unroll") for (int m = 0; m < 4; ++m) Af[ai][m] = *(const PG8_LAS bf16x8*)(lds + KS_SLOT(b, kh, 0) + aoff + (8 * ai + m) * 1024); } while (0)
#define KS_MMA() do { __builtin_amdgcn_s_setprio(MK_PRIO); _Pragma("unroll") for (int ai = 0; ai < 2; ++ai) _Pragma("unroll") for (int bj = 0; bj < 2; ++bj) _Pragma("unroll") for (int m = 0; m < 4; ++m) _Pragma("unroll") for (int n = 0; n < 2; ++n) \
        acc[ai][bj][m][n] = __builtin_amdgcn_mfma_f32_16x16x32_bf16(Bf[bj][n], Af[ai][m], acc[ai][bj][m][n], 0, 0, 0); __builtin_amdgcn_s_setprio(0); } while (0)
#define KS_WAIT_V(n) asm volatile("s_waitcnt vmcnt(" #n ")" ::: "memory")
#define KS_WAIT_L(n) asm volatile("s_waitcnt lgkmcnt(" #n ")" ::: "memory")
#define KS_BAR __builtin_amdgcn_s_barrier()
#define KS_SCHED __builtin_amdgcn_sched_barrier(0)
    Unit cur, nxt; int ui = 0;
    if (!S.next(0, cur)) return;
    f32x4 acc[2][2][4][2];
#pragma unroll
    for (int a = 0; a < 2; ++a)
#pragma unroll
        for (int b = 0; b < 2; ++b)
#pragma unroll
            for (int m = 0; m < 4; ++m)
#pragma unroll
                for (int n = 0; n < 2; ++n) acc[a][b][m][n] = (f32x4){0.f, 0.f, 0.f, 0.f};
    bf16x8 Af[2][4], Bf[2][2];
    const char* cA = (const char*)g.A + (size_t)(cur.pm & g.pm_mask) * tstep; const char* cB = (const char*)g.Bt + (size_t)(cur.pn & g.pn_mask) * tstep;
    S.a_ready(cur);
    KS_STAGE(0, 0, cA, cB); KS_STAGE(0, 1, cA, cB);
    if (wr == 1) KS_BAR;
    KS_WAIT_V(4); KS_BAR;
    KS_STAGE(1, 0, cA + kstep, cB + kstep);
    KS_WAIT_V(4); KS_BAR;
    for (;;) {
        const bool has_next = S.next(ui + 1, nxt);
        const char* nA = has_next ? (const char*)g.A + (size_t)(nxt.pm & g.pm_mask) * tstep : cA; const char* nB = has_next ? (const char*)g.Bt + (size_t)(nxt.pn & g.pn_mask) * tstep : cB;
        for (int t = 0; t < nt; t += 2) {
            const bool last = (t == nt - 2);
            const char* a1 = cA + (ptrdiff_t)(t + 1) * kstep; const char* b1 = cB + (ptrdiff_t)(t + 1) * kstep;
            const char* a2 = last ? nA : cA + (ptrdiff_t)(t + 2) * kstep; const char* b2 = last ? nB : cB + (ptrdiff_t)(t + 2) * kstep;
            const char* a3 = a2 + kstep; const char* b3 = b2 + kstep;
            if (last && has_next) S.a_ready(nxt);
            KS_LD(0, 0); KS_STAGE(1, 1, a1, b1);
            KS_WAIT_V(8); KS_WAIT_L(0); KS_BAR; KS_MMA(); KS_BAR; KS_SCHED;
            KS_LD(0, 1); KS_STAGE(0, 0, a2, b2);
            KS_WAIT_V(8); KS_WAIT_L(0); KS_BAR; KS_MMA(); KS_BAR; KS_SCHED;
            KS_LD(1, 0); KS_STAGE(0, 1, a2, b2);
            KS_WAIT_V(8); KS_WAIT_L(0); KS_BAR; KS_MMA(); KS_BAR; KS_SCHED;
            KS_LD(1, 1); KS_STAGE(1, 0, a3, b3);
            KS_WAIT_V(8); KS_WAIT_L(0); KS_BAR; KS_MMA(); KS_BAR; KS_SCHED;
        }
        if constexpr (ALIGN_EPI) { if (wr == 0) KS_BAR; }
        E(acc, cur, wr, wc, fr, fq); S.done(cur);
        if (!has_next) break;
#pragma unroll
        for (int a = 0; a < 2; ++a)
#pragma unroll
            for (int b = 0; b < 2; ++b)
#pragma unroll
                for (int m = 0; m < 4; ++m)
#pragma unroll
                    for (int n = 0; n < 2; ++n) acc[a][b][m][n] = (f32x4){0.f, 0.f, 0.f, 0.f};
        cur = nxt; cA = nA; cB = nB; ++ui;
        if constexpr (ALIGN_EPI) { if (wr == 1) KS_BAR; }
    }
    KS_WAIT_V(0);
    if constexpr (!ALIGN_EPI) { if (wr == 0) KS_BAR; }
    KS_BAR;
#undef KS_SLOT
#undef KS_STAGE1
#undef KS_STAGE
#undef KS_LD
#undef KS_MMA
#undef KS_WAIT_V
#undef KS_WAIT_L
#undef KS_BAR
#undef KS_SCHED
}
}

constexpr int NWAVES = 8;
constexpr int BATCH = 2, SEQ = 8192, M = BATCH * SEQ, D = 2048, FF = 5632, DEPTH = 4, PLE = 256;
constexpr int LDF = pg8::DFF;
constexpr int NUP = 2 * FF;
constexpr int GIN = 6160, NIN = 6144;
constexpr int NCHUNK = 128;
constexpr int NPH = 1 + 10 * DEPTH;

constexpr size_t MiB = 1u << 20;
constexpr size_t WS_CTL = 0, CTL_ZERO_BYTES = 1 * MiB;
constexpr size_t WS_WUP = 1 * MiB;
constexpr size_t WS_WDN = WS_WUP + 352 * MiB;
constexpr size_t WS_WGATE = WS_WDN + 184 * MiB;
constexpr size_t WS_WPLE = WS_WGATE + 32 * MiB;
constexpr size_t WS_WIN = WS_WPLE + 4 * MiB;
constexpr size_t WS_WGO = WS_WIN + 56 * MiB;
constexpr size_t WS_WKV = WS_WGO + 16 * MiB;
constexpr size_t WS_WQ = WS_WKV + 2 * MiB;
constexpr size_t WS_WSO = WS_WQ + 16 * MiB;
constexpr size_t WS_HB = WS_WSO + 16 * MiB;
constexpr size_t WS_SS = WS_HB + 128 * MiB;
constexpr size_t WS_PB = WS_SS + 4 * MiB;
constexpr size_t WS_PP = WS_PB + 32 * MiB;
constexpr size_t WS_KX = WS_PP + 64 * MiB;
constexpr size_t WS_VX = WS_KX + 8 * MiB;
constexpr size_t WS_SCR = WS_VX + 8 * MiB;
constexpr size_t WS_ACT = WS_SCR;
constexpr size_t WS_QB = WS_SCR, WS_KB = WS_SCR + 32 * MiB, WS_VB = WS_SCR + 64 * MiB, WS_RB = WS_SCR + 128 * MiB;
constexpr size_t WS_A1 = WS_SCR + 192 * MiB;
constexpr size_t WS_SO2 = WS_SCR + 208 * MiB;
constexpr size_t WS_WA1 = WS_CTL + 768 * 1024;
constexpr size_t WS_QD = WS_SCR + 256 * MiB, WS_KDT = WS_SCR + 288 * MiB, WS_AT = WS_SCR + 320 * MiB, WS_DEC = WS_SCR + 328 * MiB;
constexpr size_t WS_OB = WS_SCR + 336 * MiB;
constexpr size_t WS_OG = WS_SCR;
constexpr size_t WS_QN = WS_SCR, WS_AO = WS_SCR + 64 * MiB;
constexpr size_t WS_END = WS_SCR + 464 * MiB;
constexpr int CW_TMO = 0, CW_CODE = 1, CW_BAR = 4096;
constexpr size_t WS_BIAST = WS_CTL + 512 * 1024;

constexpr int RING_OFF = 0, RING_BYTES = 131072;
constexpr int LDSCTL_OFF = RING_BYTES, MISC_OFF = LDSCTL_OFF + 320;
constexpr int STG_OFF = pg8::STG_LDS_OFF; static_assert(STG_OFF == RING_BYTES + 2048, "staging tiles");
constexpr int HSC_OFF = STG_OFF + 8 * pg8::STG_BYTES; static_assert(HSC_OFF == pg8::HSC_LDS_OFF, "head-scale table");
constexpr int LDS_BYTES = HSC_OFF + 8192;

#define GAS __attribute__((address_space(1)))
#define LAS __attribute__((address_space(3)))
typedef unsigned short bf16;
typedef unsigned v4u __attribute__((ext_vector_type(4)));
typedef unsigned v2u __attribute__((ext_vector_type(2)));
typedef float f32x4 __attribute__((ext_vector_type(4)));
typedef short bf16x8 __attribute__((ext_vector_type(8)));
typedef GAS unsigned gu32;
#define RLX_AGENT __ATOMIC_RELAXED, __HIP_MEMORY_SCOPE_AGENT
#define LDS_WAIT() asm volatile("s_waitcnt lgkmcnt(0)" ::: "memory")
#define VM_WAIT() asm volatile("s_waitcnt vmcnt(0)" ::: "memory")
__device__ __forceinline__ unsigned pk2(float lo, float hi) { return pg8::cvt_pk_bf16(lo, hi); }
__device__ __forceinline__ float bf2f(unsigned short b) { return __uint_as_float((unsigned)b << 16); }
__device__ __forceinline__ unsigned short f2bf(float f) { return (unsigned short)(pg8::cvt_pk_bf16(f, 0.f) & 0xffffu); }
#define MFMA16(a, b, c) __builtin_amdgcn_mfma_f32_16x16x32_bf16((a), (b), (c), 0, 0, 0)

#define XB_TMO      128
#define XB_XCNT(j)  (256  + 64 * (j))
#define XB_XSUB(j)  (1280 + 64 * (j))
#define XB_XGEN(j)  (2304 + 64 * (j))
#define XB_TOP      3328
#define XB_TOPGEN   3392
#define XCD_BAR_WORDS 3456
#define XB_SPIN_CAP (1u << 18)

__device__ __forceinline__ unsigned xb_ld(unsigned* p)              { return __hip_atomic_load(p, __ATOMIC_RELAXED, __HIP_MEMORY_SCOPE_AGENT); }
__device__ __forceinline__ unsigned xb_add(unsigned* p, unsigned v) { return __hip_atomic_fetch_add(p, v, __ATOMIC_RELAXED, __HIP_MEMORY_SCOPE_AGENT); }
__device__ __forceinline__ unsigned xb_xcc_id() { return (unsigned)__builtin_amdgcn_s_getreg((3 << 11) | 20) & 0xFu; }
#define XB_SPIN(cond, bar) do { unsigned _sp = 0; while (cond) { __builtin_amdgcn_s_sleep(1); \
    if ((++_sp & 255u) == 0u) { if (xb_ld(&(bar)[XB_TMO])) break; if (_sp > XB_SPIN_CAP) { atomicAdd(&(bar)[XB_TMO], 1u); break; } } } } while (0)

struct XcdBarrier {
    bool lead;
    unsigned* bar; unsigned x;
    volatile LAS unsigned* st;
};

__device__ __forceinline__ XcdBarrier xcd_barrier_post(unsigned* bar, volatile LAS unsigned* st, bool lead) {
    XcdBarrier b; b.bar = bar; b.x = xb_xcc_id(); b.st = st; b.lead = lead;
    if (lead) (void)xb_add(&bar[XB_XCNT(b.x)], 1u);
    return b;
}
__device__ __forceinline__ void xcd_barrier_complete(unsigned* bar, unsigned x, unsigned& nloc, unsigned& nx) {
    const unsigned G = gridDim.x * gridDim.y * gridDim.z;
    unsigned sum, cnt, mine, sp = 0u;
    for (;;) {
        sum = 0u; cnt = 0u; mine = 0u;
#pragma unroll
        for (unsigned j = 0; j < 16; ++j) { const unsigned c = xb_ld(&bar[XB_XCNT(j)]); sum += c; cnt += (c > 0u) ? 1u : 0u; mine = (j == x) ? c : mine; }
        if (sum == G) break;
        __builtin_amdgcn_s_sleep(1);
        if ((++sp & 255u) == 0u) { if (xb_ld(&bar[XB_TMO])) break; if (sp > XB_SPIN_CAP) { atomicAdd(&bar[XB_TMO], 1u); break; } }
    }
    nloc = mine > 0u ? mine : 1u; nx = cnt > 0u ? cnt : 1u;
}

__device__ __forceinline__ void xcd_barrier(const XcdBarrier& b) {
    asm volatile("s_waitcnt vmcnt(0)" ::: "memory");
    __syncthreads();
    if (b.lead) {
        unsigned* bar = b.bar;
        __builtin_amdgcn_s_waitcnt(0);
        unsigned nloc = b.st[0], nx = b.st[1];
        if (nloc == 0u) { xcd_barrier_complete(bar, b.x, nloc, nx); b.st[0] = nloc; b.st[1] = nx; }
        const unsigned old = xb_add(&bar[XB_XSUB(b.x)], 1u);
        const unsigned gen = old / nloc;
        if (old + 1u == (gen + 1u) * nloc) {
            __builtin_amdgcn_fence(__ATOMIC_RELEASE, "agent");
            asm volatile("s_waitcnt vmcnt(0)" ::: "memory");
            const unsigned og = xb_add(&bar[XB_TOP], 1u);
            const unsigned tg = og / nx;
            if (og + 1u == (tg + 1u) * nx) xb_add(&bar[XB_TOPGEN], 1u);
            else XB_SPIN(xb_ld(&bar[XB_TOPGEN]) == tg, bar);
            __builtin_amdgcn_fence(__ATOMIC_ACQUIRE, "agent");
            xb_add(&bar[XB_XGEN(b.x)], 1u);
            asm volatile("s_waitcnt vmcnt(0)" ::: "memory");
        } else {
            XB_SPIN(xb_ld(&bar[XB_XGEN(b.x)]) == gen, bar);
            __builtin_amdgcn_fence(__ATOMIC_ACQUIRE, "agent");
            asm volatile("s_waitcnt vmcnt(0)" ::: "memory");
        }
    }
    __syncthreads();
}

struct Frame {
    LAS unsigned char* lds;
    volatile LAS unsigned* MISC;
    gu32* ctl;
    int tid, lane, wave;
    int vcu, G;
};
#define LDS_BAR() do { asm volatile("s_waitcnt lgkmcnt(0)" ::: "memory"); __builtin_amdgcn_s_barrier(); asm volatile("" ::: "memory"); } while (0)
__device__ __forceinline__ float wave_sum(float v) {
#pragma unroll
    for (int o = 1; o < 64; o <<= 1) v += __shfl_xor(v, o);
    return v;
}

#ifndef MK_W_NT
#define MK_W_NT 1
#endif
#ifndef MK_W_NTST
#define MK_W_NTST 1
#endif
#if MK_W_NT
#define MK_WLOAD(p) __builtin_nontemporal_load(p)
#else
#define MK_WLOAD(p) (*(p))
#endif
__device__ __forceinline__ int t5_bucket(int d) { if (d < 16) return d; const int l = 16 + (int)(logf((float)d / 16.0f) / logf(8.0f) * 16.0f); return l < 31 ? l : 31; }
__device__ __forceinline__ void p0_store_item(LAS float* scr, bf16* WT, int K, int k0, int dst_row0, int lane) {
    LDS_WAIT(); asm volatile("" ::: "memory");
    const int c = lane & 7;
#pragma unroll
    for (int j = 0; j < 4; ++j) { const int n = (lane >> 3) + 8 * j; const LAS float* s = scr + (8 * c) * 33 + n;
        v4u o; o.x = pk2(s[0 * 33], s[1 * 33]); o.y = pk2(s[2 * 33], s[3 * 33]); o.z = pk2(s[4 * 33], s[5 * 33]); o.w = pk2(s[6 * 33], s[7 * 33]);
#if MK_W_NTST
        __builtin_nontemporal_store(o, (GAS v4u*)(WT + (size_t)(dst_row0 + n) * K + k0 + 8 * c)); }
#else
        *(GAS v4u*)(WT + (size_t)(dst_row0 + n) * K + k0 + 8 * c) = o; }
#endif
    LDS_WAIT(); asm volatile("" ::: "memory");
}
__device__ __forceinline__ void p0_item(const float* W, int N, int n0, int k0, const float* gain, int gmask, bf16* WT, int K, int dst_row0, LAS float* scr, int lane) {
    float v[32];
#pragma unroll
    for (int i = 0; i < 32; ++i) { const int k = k0 + 2 * i + (lane >> 5); v[i] = MK_WLOAD(W + (size_t)k * N + n0 + (lane & 31)); }
    if (gain) {
#pragma unroll
        for (int i = 0; i < 32; ++i) { const int k = k0 + 2 * i + (lane >> 5); v[i] *= gain[k & gmask]; } }
#pragma unroll
    for (int i = 0; i < 32; ++i) scr[(2 * i + (lane >> 5)) * 33 + (lane & 31)] = v[i];
    p0_store_item(scr, WT, K, k0, dst_row0, lane);
}
struct In { const float *x, *p, *norm_g, *ffn_wg, *ffn_wu, *ffn_wd, *ple_w, *ple_gate_w, *gla_w_in, *gla_w_a2, *gla_b_a, *gla_norm_g, *gla_w_o, *kv_norm_g, *w_kv, *k_norm_g, *rel_bias, *swa_w_q, *q_norm_g, *sinks, *swa_w_o; };

__device__ __forceinline__ void p0_prologue(Frame& F, const In& I, unsigned char* ws) {
    LAS float* scr = (LAS float*)(F.lds + RING_OFF + F.wave * 16384);
    const int gw = F.vcu * NWAVES + F.wave, NGW = F.G * NWAVES, lane = F.lane;
    constexpr int IT_UP = 32 * 176, IT_DN = 88 * 64, IT_SQ = 32 * 64, IT_PLE = 4 * 64, IT_IN = 32 * 192, IT_GF = 0, IT_KV = 32 * 16;
    constexpr int C1 = 8 * IT_UP, C2 = C1 + 8 * IT_UP, C3 = C2 + 8 * IT_DN, C4 = C3 + 4 * IT_SQ, C5 = C4 + 4 * IT_PLE, C6 = C5 + 2 * IT_IN, C7 = C6 + 2 * IT_GF, C8 = C7 + 2 * IT_SQ, C9 = C8 + IT_KV, C10 = C9 + 2 * IT_SQ, C11 = C10 + 2 * IT_SQ;
    for (int it = gw; it < C11; it += NGW) {
        int r = it;
        if (r < C2) {
            const int isu = r >= C1; if (isu) r -= C1;
            const int j = r / IT_UP, q = r % IT_UP, kb = q / 176, nb = q % 176, n0 = 32 * nb, L = j >> 1, f = j & 1;
            const float* W = (isu ? I.ffn_wu : I.ffn_wg) + (size_t)j * D * FF;
            p0_item(W, FF, n0, 64 * kb, I.norm_g + (L * 4 + 2 * f) * D, 0x7fffffff, (bf16*)(ws + WS_WUP) + (size_t)j * NUP * D, D, (n0 >> 7) * 256 + (n0 & 127) + 128 * isu, scr, lane);
            continue; }
        r -= C2;
        if (r < 8 * IT_DN) { const int j = r / IT_DN, q = r % IT_DN, kb = q / 64, nb = q % 64;
            p0_item(I.ffn_wd + (size_t)j * FF * D, D, 32 * nb, 64 * kb, nullptr, 0, (bf16*)(ws + WS_WDN) + (size_t)j * D * LDF, LDF, 32 * nb, scr, lane); continue; }
        r -= 8 * IT_DN;
        if (r < 4 * IT_SQ) { const int j = r / IT_SQ, q = r % IT_SQ, kb = q / 64, nb = q % 64;
            p0_item(I.ple_gate_w + (size_t)j * D * D, D, 32 * nb, 64 * kb, I.norm_g + (j * 4 + 3) * D, 0x7fffffff, (bf16*)(ws + WS_WGATE) + (size_t)j * D * D, D, 32 * nb, scr, lane); continue; }
        r -= 4 * IT_SQ;
        if (r < 4 * IT_PLE) { const int j = r / IT_PLE, q = r % IT_PLE, kb = q / 64, nb = q % 64;
            p0_item(I.ple_w + (size_t)j * PLE * D, D, 32 * nb, 64 * kb, nullptr, 0, (bf16*)(ws + WS_WPLE) + (size_t)j * D * PLE, PLE, 32 * nb, scr, lane); continue; }
        r -= 4 * IT_PLE;
        if (r < 2 * IT_IN) { const int j = r / IT_IN, q = r % IT_IN, kb = q / 192, nb = q % 192;
            p0_item(I.gla_w_in + (size_t)j * D * GIN, GIN, 32 * nb, 64 * kb, I.norm_g + (j * 4 + 1) * D, 0x7fffffff, (bf16*)(ws + WS_WIN) + (size_t)j * NIN * D, D, 32 * nb, scr, lane); continue; }
        r -= 2 * IT_IN;
        r -= 2 * IT_GF;
        if (r < 2 * IT_SQ) { const int j = r / IT_SQ, q = r % IT_SQ, kb = q / 64, nb = q % 64;
            p0_item(I.gla_w_o + (size_t)j * D * D, D, 32 * nb, 64 * kb, I.gla_norm_g + j * 512, 511, (bf16*)(ws + WS_WGO) + (size_t)j * D * D, D, 32 * nb, scr, lane); continue; }
        r -= 2 * IT_SQ;
        if (r < IT_KV) { const int kb = r / 16, nb = r % 16, n0 = 32 * nb;
            p0_item(I.w_kv, 512, n0, 64 * kb, I.kv_norm_g, 0x7fffffff, (bf16*)(ws + WS_WKV), D, (n0 & ~255) + 128 * ((n0 >> 5) & 1) + 32 * ((n0 >> 6) & 3), scr, lane); continue; }
        r -= IT_KV;
        if (r < 2 * IT_SQ) { const int j = r / IT_SQ, q = r % IT_SQ, kb = q / 64, nb = q % 64, n0 = 32 * nb;
            p0_item(I.swa_w_q + (size_t)j * D * D, D, n0, 64 * kb, I.norm_g + ((2 + j) * 4 + 1) * D, 0x7fffffff, (bf16*)(ws + WS_WQ) + (size_t)j * D * D, D, (n0 & ~255) + 128 * ((n0 >> 5) & 1) + 32 * ((n0 >> 6) & 3), scr, lane); continue; }
        r -= 2 * IT_SQ;
        { const int j = r / IT_SQ, q = r % IT_SQ, kb = q / 64, nb = q % 64;
            p0_item(I.swa_w_o + (size_t)j * D * D, D, 32 * nb, 64 * kb, nullptr, 0, (bf16*)(ws + WS_WSO) + (size_t)j * D * D, D, 32 * nb, scr, lane); }
    }
    { bf16* wa = (bf16*)(ws + WS_WA1); for (int t = (F.vcu * NWAVES + F.wave) * 64 + lane; t < 2 * 16 * D; t += F.G * NWAVES * 64) { const int j = t >> 15, r = (t >> 11) & 15, k = t & 2047;
        wa[t] = f2bf(I.norm_g[(j * 4 + 1) * D + k] * I.gla_w_in[(size_t)j * D * GIN + (size_t)k * GIN + 6144 + r]); } }
    { float* bt = (float*)(ws + WS_BIAST); const int t = (F.vcu * NWAVES + F.wave) * 64 + lane; if (t < 32 * 128) { const int hqh = t >> 7, dist = t & 127; bt[t] = I.rel_bias[t5_bucket(dist) * 32 + hqh]; } }
    { const size_t n8 = (size_t)DEPTH * M * PLE / 8; GAS v4u* o = (GAS v4u*)(ws + WS_PB);
        for (size_t i = (size_t)gw * 64 + lane; i < n8; i += (size_t)NGW * 64) { const f32x4 a = ((const GAS f32x4*)I.p)[2 * i], b = ((const GAS f32x4*)I.p)[2 * i + 1];
            v4u w; w.x = pk2(a[0], a[1]); w.y = pk2(a[2], a[3]); w.z = pk2(b[0], b[1]); w.w = pk2(b[2], b[3]); o[i] = w; } }
    { bf16* hb0 = (bf16*)(ws + WS_HB); float* ss0 = (float*)(ws + WS_SS);
        for (int m = gw; m < M; m += NGW) { const GAS f32x4* xr = (const GAS f32x4*)(I.x + (size_t)m * D); float s = 0.f;
#pragma unroll
            for (int j = 0; j < 4; ++j) { const f32x4 a = xr[128 * j + 2 * lane], b = xr[128 * j + 2 * lane + 1]; s += pg8::dot4(a) + pg8::dot4(b);
                v4u w; w.x = pk2(a[0], a[1]); w.y = pk2(a[2], a[3]); w.z = pk2(b[0], b[1]); w.w = pk2(b[2], b[3]); *(GAS v4u*)(hb0 + (size_t)m * D + 512 * j + 8 * lane) = w; }
            s = wave_sum(s);
            if (lane < 32) ss0[(size_t)m * 32 + lane] = (lane == 0) ? s : 0.f; } }
}

typedef float f32x2v __attribute__((ext_vector_type(2)));
__device__ __forceinline__ void gla_a1(Frame& F, const bf16* hb, const float* ss, const bf16* wa, float* a1) {
    LAS bf16* WA = (LAS bf16*)(F.lds);
    const int tid = F.tid, lane = F.lane, r16 = lane & 15, quad = lane >> 4;
#pragma unroll
    for (int e = 0; e < 8; ++e) { const int d = tid + 512 * e, row = d >> 8, ch = d & 255; *(LAS v4u*)(WA + row * 2056 + ch * 8) = *(const GAS v4u*)(wa + row * 2048 + ch * 8); }
    __syncthreads();
    for (int rt = F.vcu + F.G * F.wave; rt < M / 16; rt += F.G * NWAVES) {
        const bf16* ap = hb + (size_t)(16 * rt + r16) * D + 8 * quad; const LAS bf16* bp = WA + r16 * 2056 + 8 * quad;
        f32x4 c0 = {0.f, 0.f, 0.f, 0.f}, c1 = c0, c2 = c0, c3 = c0;
#pragma unroll 4
        for (int ks = 0; ks < 64; ks += 4) {
            c0 = MFMA16(*(const GAS bf16x8*)(ap + 32 * ks), *(const LAS bf16x8*)(bp + 32 * ks), c0);
            c1 = MFMA16(*(const GAS bf16x8*)(ap + 32 * ks + 32), *(const LAS bf16x8*)(bp + 32 * ks + 32), c1);
            c2 = MFMA16(*(const GAS bf16x8*)(ap + 32 * ks + 64), *(const LAS bf16x8*)(bp + 32 * ks + 64), c2);
            c3 = MFMA16(*(const GAS bf16x8*)(ap + 32 * ks + 96), *(const LAS bf16x8*)(bp + 32 * ks + 96), c3); }
        const f32x4 acc = (c0 + c1) + (c2 + c3);
        const GAS f32x4* sp = (const GAS f32x4*)(ss + (size_t)(16 * rt + r16) * 32 + 8 * quad); const f32x4 sa = sp[0], sb = sp[1];
        float s = ((sa[0] + sa[1]) + (sa[2] + sa[3])) + ((sb[0] + sb[1]) + (sb[2] + sb[3]));
        s += __shfl_xor(s, 16); s += __shfl_xor(s, 32);
        const float rstd = 1.0f / sqrtf(s * (1.0f / (float)D) + pg8::RMS_EPS);
#pragma unroll
        for (int j = 0; j < 4; ++j) { const float rj = __shfl(rstd, 4 * quad + j); a1[(size_t)(16 * rt + 4 * quad + j) * 16 + r16] = acc[j] * rj; }
    }
    __syncthreads();
}
struct G1Regs { unsigned q[16], k[16]; };
__device__ __forceinline__ void g1_load(G1Regs& R, int u, const bf16* qb, const bf16* kb, int c2, int tq) {
    const int bh = u >> 7, n = u & 127, b = bh >> 2, h = bh & 3;
    const size_t row0 = (size_t)b * SEQ + 64 * n + 16 * tq; const int cc = h * 256 + 2 * c2;
#pragma unroll
    for (int i = 0; i < 16; ++i) { R.q[i] = *(const GAS unsigned*)(qb + (row0 + i) * 1024 + cc); R.k[i] = *(const GAS unsigned*)(kb + (row0 + i) * 1024 + cc); }
}
__device__ __forceinline__ void g1_stage_a1(LAS float* dst, int u, const float* a1, int tid) {
    if (tid < 256) { const int bh = u >> 7, n = u & 127, b = bh >> 2; *(LAS f32x4*)(dst + 4 * tid) = *(const GAS f32x4*)(a1 + ((size_t)b * SEQ + 64 * n) * 16 + 4 * tid); }
}
template <int VAR = 0  > __device__ __forceinline__ void gla_g1(Frame& F, const bf16* qb, const bf16* kb, const float* a1, const float* w2, const float* b_a, bf16* qd, bf16* kdT, bf16* at, float* dec) {
    LAS bf16* QD = (LAS bf16*)(F.lds);
    LAS bf16* KI = (LAS bf16*)(F.lds + 33792);
    LAS bf16* KT = (LAS bf16*)(F.lds + 67584);
    LAS f32x2v* TOT = (LAS f32x2v*)(F.lds + 104448);
    LAS float* A1S = (LAS float*)(F.lds + 108544);
    LAS bf16* ATS = (LAS bf16*)(F.lds + 116736);
    const int tid = F.tid, c2 = tid & 127, tq = tid >> 7, lane = F.lane, w = F.wave, r16 = lane & 15, quad = lane >> 4;
    const int per = (1024 + F.G - 1) / F.G;
    G1Regs R; const int u0 = F.vcu * per;
    if (u0 < 1024) { g1_load(R, u0, qb, kb, c2, tq); g1_stage_a1(A1S, u0, a1, tid); }
    LDS_BAR();
    int cur_h = -1; float w2x[16], w2y[16]; float bax = 0.f, bay = 0.f;
    for (int i0 = 0; i0 < per; ++i0) {
        const int u = u0 + i0; if (u >= 1024) break;
        const int h = (u >> 7) & 3;
        if (h != cur_h) { cur_h = h;
#pragma unroll
            for (int r = 0; r < 16; ++r) { const f32x2v t = *(const GAS f32x2v*)(w2 + r * 1024 + h * 256 + 2 * c2); w2x[r] = t.x; w2y[r] = t.y; }
            const f32x2v t = *(const GAS f32x2v*)(b_a + h * 256 + 2 * c2); bax = t.x; bay = t.y; }
        const LAS float* as = A1S + (i0 & 1) * 1024 + (16 * tq) * 16;
        f32x2v bs[16];
        { f32x2v run = {0.f, 0.f};
#pragma unroll
            for (int i = 0; i < 16; ++i) { const f32x4 a0 = *(const LAS f32x4*)(as + 16 * i), a1v = *(const LAS f32x4*)(as + 16 * i + 4), a2 = *(const LAS f32x4*)(as + 16 * i + 8), a3 = *(const LAS f32x4*)(as + 16 * i + 12);
                float zx = bax, zy = bay;
#pragma unroll
                for (int r = 0; r < 4; ++r) { zx += a0[r] * w2x[r] + a1v[r] * w2x[4 + r] + a2[r] * w2x[8 + r] + a3[r] * w2x[12 + r]; zy += a0[r] * w2y[r] + a1v[r] * w2y[4 + r] + a2[r] * w2y[8 + r] + a3[r] * w2y[12 + r]; }
                run.x += (fminf(zx, 0.f) - __logf(1.0f + __expf(-fabsf(zx)))) * 0.0625f; run.y += (fminf(zy, 0.f) - __logf(1.0f + __expf(-fabsf(zy)))) * 0.0625f; bs[i] = run; } }
        unsigned qv[16], kv[16];
#pragma unroll
        for (int i = 0; i < 16; ++i) { qv[i] = R.q[i]; kv[i] = R.k[i]; }
        TOT[tq * 128 + c2] = bs[15];
        const bool nxt_ = (i0 + 1 < per && u + 1 < 1024); f32x4 a1n = {0.f, 0.f, 0.f, 0.f};
        if (nxt_) { if (tid < 256) { const int un = u + 1, bhn = un >> 7, nn = un & 127, bn = bhn >> 2; a1n = *(const GAS f32x4*)(a1 + ((size_t)bn * SEQ + 64 * nn) * 16 + 4 * tid); }
            g1_load(R, u + 1, qb, kb, c2, tq); }
        LDS_BAR();
        f32x2v pre = {0.f, 0.f}, tot = {0.f, 0.f};
#pragma unroll
        for (int t = 0; t < 4; ++t) { const f32x2v v = TOT[t * 128 + c2]; if (t < tq) { pre.x += v.x; pre.y += v.y; } tot.x += v.x; tot.y += v.y; }
        float kdx[16], kdy[16];
#pragma unroll
        for (int i = 0; i < 16; ++i) { const float bx = bs[i].x + pre.x, by = bs[i].y + pre.y;
            const float qx = __uint_as_float(qv[i] << 16), qy = __uint_as_float(qv[i] & 0xffff0000u), kx_ = __uint_as_float(kv[i] << 16), ky_ = __uint_as_float(kv[i] & 0xffff0000u);
            *(LAS unsigned*)(QD + (16 * tq + i) * 264 + 2 * c2) = pk2(qx * __expf(bx), qy * __expf(by));
            *(LAS unsigned*)(KI + (16 * tq + i) * 264 + 2 * c2) = pk2(kx_ * __expf(-bx), ky_ * __expf(-by));
            kdx[i] = kx_ * __expf(tot.x - bx); kdy[i] = ky_ * __expf(tot.y - by); }
#pragma unroll
        for (int e = 0; e < 2; ++e) { v4u wx, wy;
            wx.x = pk2(kdx[8 * e], kdx[8 * e + 1]); wx.y = pk2(kdx[8 * e + 2], kdx[8 * e + 3]); wx.z = pk2(kdx[8 * e + 4], kdx[8 * e + 5]); wx.w = pk2(kdx[8 * e + 6], kdx[8 * e + 7]);
            wy.x = pk2(kdy[8 * e], kdy[8 * e + 1]); wy.y = pk2(kdy[8 * e + 2], kdy[8 * e + 3]); wy.z = pk2(kdy[8 * e + 4], kdy[8 * e + 5]); wy.w = pk2(kdy[8 * e + 6], kdy[8 * e + 7]);
            *(LAS v4u*)(KT + (2 * c2) * 72 + 16 * tq + 8 * e) = wx; *(LAS v4u*)(KT + (2 * c2 + 1) * 72 + 16 * tq + 8 * e) = wy; }
        if (tq == 0) *(GAS f32x2v*)(dec + (size_t)u * 256 + 2 * c2) = (f32x2v){__expf(tot.x), __expf(tot.y)};
        LDS_BAR();
        if (VAR != 1) { const int ti = w >> 1;
#pragma unroll
            for (int tt = 0; tt < 2; ++tt) { const int tj = (w & 1) * 2 + tt; f32x4 a4 = {0.f, 0.f, 0.f, 0.f};
                if (tj <= ti) {
#pragma unroll
                    for (int ks = 0; ks < 8; ++ks) { const bf16x8 A = *(const LAS bf16x8*)(QD + (16 * ti + r16) * 264 + 32 * ks + 8 * quad), B = *(const LAS bf16x8*)(KI + (16 * tj + r16) * 264 + 32 * ks + 8 * quad); a4 = MFMA16(A, B, a4); } }
#pragma unroll
                for (int j = 0; j < 4; ++j) { const int ii = 16 * ti + 4 * quad + j, jj = 16 * tj + r16; ATS[(((ii >> 4) * 2 + (jj >> 5)) * 64 + ((jj & 31) >> 3) * 16 + (ii & 15)) * 8 + (jj & 7)] = f2bf(jj <= ii ? a4[j] : 0.f); } } }
        if (VAR != 1 && VAR != 3)
#pragma unroll
        for (int e = 0; e < 4; ++e) { const int d = tid + 512 * e, blk = d >> 6, ln = d & 63, row = 16 * (blk >> 3) + (ln & 15), ch = 4 * (blk & 7) + (ln >> 4);
            *(GAS v4u*)(qd + (size_t)u * 16384 + d * 8) = *(const LAS v4u*)(QD + row * 264 + ch * 8); }
        if (VAR != 1 && VAR != 3)
#pragma unroll
        for (int e = 0; e < 4; ++e) { const int d = tid + 512 * e, blk = d >> 6, ln = d & 63, row = 16 * (blk >> 1) + (ln & 15), ch = 4 * (blk & 1) + (ln >> 4);
            *(GAS v4u*)(kdT + (size_t)u * 16384 + d * 8) = *(const LAS v4u*)(KT + row * 72 + ch * 8); }
        if (nxt_ && tid < 256) *(LAS f32x4*)(A1S + ((i0 + 1) & 1) * 1024 + 4 * tid) = a1n;
        LDS_BAR();
        if (VAR != 1 && VAR != 2) *(GAS v4u*)(at + (size_t)u * 4096 + tid * 8) = *(const LAS v4u*)(ATS + tid * 8);
        LDS_BAR();
    }
}
struct ScanBig { bf16x8 q[4]; bf16x8 k0[2], k1[2]; v4u v; };
struct ScanSmall { bf16x8 a; f32x4 d0, d1; };
struct ScanOff { unsigned q, a, k, d, v; };
__device__ __forceinline__ void scan_load_big_kv(ScanBig& R, int n, int bh, const bf16* kdT, const bf16* vrow, const ScanOff& O, int tid) {
    const size_t u = (size_t)(bh * NCHUNK + n);
    if (tid >= 256 && tid < 384) R.v = *(const GAS v4u*)((const GAS char*)vrow + (size_t)n * (64 * 4096) + O.v);
    const GAS char* kp = (const GAS char*)kdT + u * 32768 + O.k;
#pragma unroll
    for (int ks = 0; ks < 2; ++ks) { R.k0[ks] = *(const GAS bf16x8*)(kp + 1024 * ks); R.k1[ks] = *(const GAS bf16x8*)(kp + 2048 + 1024 * ks); }
}
__device__ __forceinline__ void scan_load_big_q(ScanBig& R, int n, int bh, const bf16* qd, const ScanOff& O) {
    const size_t u = (size_t)(bh * NCHUNK + n);
    const GAS char* qp = (const GAS char*)qd + u * 32768 + O.q;
#pragma unroll
    for (int ks = 0; ks < 4; ++ks) R.q[ks] = *(const GAS bf16x8*)(qp + 1024 * ks);
}
__device__ __forceinline__ void scan_load_big(ScanBig& R, int n, int bh, const bf16* qd, const bf16* kdT, const bf16* vrow, const ScanOff& O, int tid) {
    scan_load_big_kv(R, n, bh, kdT, vrow, O, tid); scan_load_big_q(R, n, bh, qd, O);
}
__device__ __forceinline__ void scan_load_small(ScanSmall& R, int n, int bh, const bf16* at, const float* dec, const bf16* vrow, const ScanOff& O, int tid) {
    const size_t u = (size_t)(bh * NCHUNK + n);
    R.a = *(const GAS bf16x8*)((const GAS char*)at + u * 8192 + O.a);
    const GAS char* dp = (const GAS char*)dec + u * 1024 + O.d;
    R.d0 = *(const GAS f32x4*)dp; R.d1 = *(const GAS f32x4*)(dp + 64);
}
template <int VAR = 0  > __device__ __forceinline__ void gla_scan(Frame& F, const bf16* qd, const bf16* kdT, const bf16* at, const float* dec, const bf16* vb, bf16* ob) {
    LAS bf16* ST = (LAS bf16*)(F.lds);
    LAS bf16* VT = (LAS bf16*)(F.lds + 16896);
    LAS f32x4* OP = (LAS f32x4*)(F.lds + 21504);
    const int tid = F.tid, lane = F.lane, w = F.wave, r16 = lane & 15, quad = lane >> 4, rt = w & 3, kh = w >> 2;
#define SCAN_BAR() do { asm volatile("s_waitcnt lgkmcnt(0)" ::: "memory"); __builtin_amdgcn_s_barrier(); asm volatile("" ::: "memory"); } while (0)
#ifdef PROBE_SCANHALF
    for (int item = F.vcu; item < ((F.vcu & 1) ? 0 : F.vcu + 2); ++item) {
#else
    for (int item = F.vcu; item < 256; item += F.G) {
#endif
        const int bh = item >> 5, sl = item & 31, b = bh >> 2, h = bh & 3;
        const size_t tok0 = (size_t)b * SEQ; const int vcol = h * 512 + 16 * sl;
        const bf16* vrow = vb + tok0 * 2048 + vcol; bf16* ob_item = ob + tok0 * 2048 + vcol; const unsigned ooff = (unsigned)(((16 * rt + 4 * quad) * 2048 + r16) * 2);
        f32x4 S0 = {0.f, 0.f, 0.f, 0.f}, S1 = {0.f, 0.f, 0.f, 0.f}, oprev = {0.f, 0.f, 0.f, 0.f};
        ScanBig B0, B1, B2, B3; ScanSmall T0, T1;
        ScanOff O; O.q = (unsigned)(((rt * 8 + 4 * kh) * 64 + lane) * 16); O.a = (unsigned)(((rt * 2 + kh) * 64 + lane) * 16); O.k = (unsigned)(((4 * w) * 64 + lane) * 16);
        O.d = (unsigned)((32 * w + 4 * quad) * 4); O.v = (unsigned)((((tid - 256) & 127) >> 1) * 4096 + 16 * (tid & 1));
        scan_load_big(B0, 0, bh, qd, kdT, vrow, O, tid); scan_load_small(T0, 0, bh, at, dec, vrow, O, tid);
        scan_load_big(B1, 1, bh, qd, kdT, vrow, O, tid); scan_load_big(B2, 2, bh, qd, kdT, vrow, O, tid);
#define SCAN_STEP(n_, BC, BN, TC, TN) do { const int n = (n_); const int buf = n & 1; \
            scan_load_big_kv(BN, (VAR == 4) ? 0 : ((n + 3 < NCHUNK) ? n + 3 : NCHUNK - 1), bh, kdT, vrow, O, tid);        \
            LAS bf16* st = ST + buf * (16 * 264); LAS bf16* vt = VT + buf * (16 * 72); \
            if (tid >= 256 && tid < 384) { const int tok = (tid - 256) >> 1, hh = tid & 1; const v4u v = BC.v; \
                vt[(8 * hh + 0) * 72 + tok] = (bf16)(v.x & 0xffffu); vt[(8 * hh + 1) * 72 + tok] = (bf16)(v.x >> 16); vt[(8 * hh + 2) * 72 + tok] = (bf16)(v.y & 0xffffu); vt[(8 * hh + 3) * 72 + tok] = (bf16)(v.y >> 16); \
                vt[(8 * hh + 4) * 72 + tok] = (bf16)(v.z & 0xffffu); vt[(8 * hh + 5) * 72 + tok] = (bf16)(v.z >> 16); vt[(8 * hh + 6) * 72 + tok] = (bf16)(v.w & 0xffffu); vt[(8 * hh + 7) * 72 + tok] = (bf16)(v.w >> 16); } \
            { v2u p0, p1; p0.x = pk2(S0[0], S0[1]); p0.y = pk2(S0[2], S0[3]); p1.x = pk2(S1[0], S1[1]); p1.y = pk2(S1[2], S1[3]); \
                *(LAS v2u*)(st + r16 * 264 + 32 * w + 4 * quad) = p0; *(LAS v2u*)(st + r16 * 264 + 32 * w + 16 + 4 * quad) = p1; } \
            SCAN_BAR(); \
            scan_load_small(TN, (VAR == 4) ? 0 : ((n + 1 < NCHUNK) ? n + 1 : NCHUNK - 1), bh, at, dec, vrow, O, tid); \
            if (VAR != 1 && kh == 0 && n > 0) { const f32x4 po = OP[((n - 1) & 1) * 256 + rt * 64 + lane]; const f32x4 of = oprev + po; GAS bf16* op_ = (GAS bf16*)((GAS char*)ob_item + (size_t)(n - 1) * (64 * 4096) + ooff); \
                if (VAR == 3) { if (of[0] + of[1] + of[2] + of[3] == 12345.678f) op_[0] = 1; } else { op_[0] = f2bf(of[0]); op_[2048] = f2bf(of[1]); op_[4096] = f2bf(of[2]); op_[6144] = f2bf(of[3]); } } \
            { f32x4 c0 = S0 * TC.d0, c1 = S1 * TC.d1; \
                _Pragma("unroll") for (int ks = 0; ks < 2; ++ks) { const bf16x8 B = *(const LAS bf16x8*)(vt + r16 * 72 + 32 * ks + 8 * quad); c0 = MFMA16(BC.k0[ks], B, c0); c1 = MFMA16(BC.k1[ks], B, c1); } \
                S0 = c0; S1 = c1; } \
            scan_load_big_q(BN, (VAR == 4) ? 0 : ((n + 3 < NCHUNK) ? n + 3 : NCHUNK - 1), bh, qd, O); \
            if (VAR != 1) { f32x4 o = {0.f, 0.f, 0.f, 0.f}; \
                _Pragma("unroll") for (int ks = 0; ks < 4; ++ks) o = MFMA16(BC.q[ks], *(const LAS bf16x8*)(st + r16 * 264 + 128 * kh + 32 * ks + 8 * quad), o); \
                o = MFMA16(TC.a, *(const LAS bf16x8*)(vt + r16 * 72 + 32 * kh + 8 * quad), o); \
                if (kh) OP[buf * 256 + rt * 64 + lane] = o; else oprev = o; } \
        } while (0)
        for (int n4 = 0; n4 < NCHUNK; n4 += 4) { SCAN_STEP(n4, B0, B3, T0, T1); SCAN_STEP(n4 + 1, B1, B0, T1, T0); SCAN_STEP(n4 + 2, B2, B1, T0, T1); SCAN_STEP(n4 + 3, B3, B2, T1, T0); }
        SCAN_BAR();
        if (kh == 0) { const f32x4 po = OP[(127 & 1) * 256 + rt * 64 + lane]; const f32x4 of = oprev + po; GAS bf16* op_ = (GAS bf16*)((GAS char*)ob_item + (size_t)127 * (64 * 4096) + ooff);
            op_[0] = f2bf(of[0]); op_[2048] = f2bf(of[1]); op_[4096] = f2bf(of[2]); op_[6144] = f2bf(of[3]); }
        SCAN_BAR();
    }
#undef SCAN_STEP
#undef SCAN_BAR
}
__device__ __forceinline__ void gla_g3(Frame& F, const bf16* ob, const bf16* rb, bf16* og) {
    const int gw = F.vcu * NWAVES + F.wave, NGW = F.G * NWAVES, lane = F.lane;
    for (int it0 = gw; it0 < M * 4; it0 += 4 * NGW) {
        v4u ow[4], rw[4]; size_t off[4];
#pragma unroll
        for (int j = 0; j < 4; ++j) { const int it = it0 + j * NGW; off[j] = (size_t)(it >> 2) * 2048 + (it & 3) * 512 + lane * 8; if (it < M * 4) { ow[j] = *(const GAS v4u*)(ob + off[j]); rw[j] = *(const GAS v4u*)(rb + off[j]); } }
#pragma unroll
        for (int j = 0; j < 4; ++j) { if (it0 + j * NGW < M * 4) { f32x4 a, b, r0, r1; pg8::unpack8(ow[j], a, b); pg8::unpack8(rw[j], r0, r1);
            const float s = wave_sum(pg8::dot4(a) + pg8::dot4(b)); const float rstd = 1.0f / sqrtf(s * (1.0f / 512.0f) + pg8::RMS_EPS);
            *(GAS v4u*)(og + off[j]) = pg8::pack8(a * rstd * r0, b * rstd * r1); } }
    }
}

template <int VAR = 0  > __device__ __forceinline__ void swa_attn(Frame& F, const bf16* qn, const bf16* kx, const bf16* vx, const float* biasT, const float* sinks, bf16* ao) {
    LAS bf16* KS = (LAS bf16*)(F.lds);
    LAS bf16* VT = (LAS bf16*)(F.lds + 36864);
    const int tid = F.tid, lane = F.lane, g = F.wave, r16 = lane & 15, quad = lane >> 4;
    const int per = (512 + F.G - 1) / F.G;
    for (int i0 = 0; i0 < per; ++i0) {
        const int u = F.vcu * per + i0; if (u >= 512) break;
        const int b = u >> 8, kvh = (u >> 6) & 3, nb = u & 63;
        const int hq = kvh * 8 + g;
        const bf16* qp = qn + ((size_t)b * SEQ + 128 * nb + r16) * 2048 + hq * 64 + 8 * quad;
        bf16x8 Qa[8], Qb[8];
#pragma unroll
        for (int t = 0; t < 8; ++t) { Qa[t] = *(const GAS bf16x8*)(qp + (size_t)(16 * t) * 2048); Qb[t] = *(const GAS bf16x8*)(qp + (size_t)(16 * t) * 2048 + 32); }
        { const int key = tid >> 1, hh = tid & 1, kpos = 128 * (nb - 1) + key;
            v4u kv[4], vv[4];
            if (kpos >= 0) { const GAS v4u* kp = (const GAS v4u*)(kx + ((size_t)b * SEQ + kpos) * 256 + kvh * 64 + 32 * hh); const GAS v4u* vp = (const GAS v4u*)(vx + ((size_t)b * SEQ + kpos) * 256 + kvh * 64 + 32 * hh);
#pragma unroll
                for (int e = 0; e < 4; ++e) { kv[e] = kp[e]; vv[e] = vp[e]; } }
            else {
#pragma unroll
                for (int e = 0; e < 4; ++e) { kv[e] = (v4u){0u, 0u, 0u, 0u}; vv[e] = (v4u){0u, 0u, 0u, 0u}; } }
#pragma unroll
            for (int e = 0; e < 4; ++e) { *(LAS v4u*)(KS + key * 72 + 32 * hh + 8 * e) = kv[e];
                LAS bf16* vtp = VT + (32 * hh + 8 * e) * 264 + key;
                vtp[0 * 264] = (bf16)(vv[e].x & 0xffffu); vtp[1 * 264] = (bf16)(vv[e].x >> 16); vtp[2 * 264] = (bf16)(vv[e].y & 0xffffu); vtp[3 * 264] = (bf16)(vv[e].y >> 16);
                vtp[4 * 264] = (bf16)(vv[e].z & 0xffffu); vtp[5 * 264] = (bf16)(vv[e].z >> 16); vtp[6 * 264] = (bf16)(vv[e].w & 0xffffu); vtp[7 * 264] = (bf16)(vv[e].w >> 16); } }
        const float sink = sinks[hq];
        float bm[9][4];
#pragma unroll
        for (int t9 = 0; t9 < 9; ++t9)
#pragma unroll
            for (int j = 0; j < 4; ++j) { const int dist = r16 + 128 - 16 * t9 - 4 * quad - j; bm[t9][j] = (dist >= 0 && dist < 128) ? biasT[hq * 128 + (dist & 127)] : -INFINITY; }
        LDS_BAR();
#pragma unroll
        for (int qt = 0; qt < (VAR == 1 ? 0 : 8); ++qt) {
            __builtin_amdgcn_sched_barrier(0);
            const bf16x8 Q0 = Qa[qt], Q1 = Qb[qt];
            f32x4 S[9];
#pragma unroll
            for (int t9 = 0; t9 < 9; ++t9) { const LAS bf16* kp = KS + (16 * (qt + t9) + r16) * 72 + 8 * quad;
                f32x4 z = {0.f, 0.f, 0.f, 0.f}; z = MFMA16(*(const LAS bf16x8*)kp, Q0, z); S[t9] = MFMA16(*(const LAS bf16x8*)(kp + 32), Q1, z); }
            if (VAR == 3) { bf16* op3 = ao + ((size_t)b * SEQ + 128 * nb + 16 * qt + r16) * 2048 + hq * 64 + 4 * quad; float t3 = 0.f;
#pragma unroll
                for (int t9 = 0; t9 < 9; ++t9) t3 += S[t9][0] + S[t9][1] + S[t9][2] + S[t9][3];
                v2u w3; w3.x = pk2(t3, t3); w3.y = w3.x; *(GAS v2u*)op3 = w3; continue; }
            float mx = sink;
            if (nb > 0) {
#pragma unroll
                for (int t9 = 0; t9 < 9; ++t9)
#pragma unroll
                    for (int j = 0; j < 4; ++j) { const float s = S[t9][j] + bm[t9][j]; S[t9][j] = s; mx = fmaxf(mx, s); }
            } else {
#pragma unroll
                for (int t9 = 0; t9 < 9; ++t9)
#pragma unroll
                    for (int j = 0; j < 4; ++j) { const int sj = 16 * (qt + t9) + 4 * quad + j; const float s = (sj >= 128) ? S[t9][j] + bm[t9][j] : -INFINITY; S[t9][j] = s; mx = fmaxf(mx, s); }
            }
            mx = fmaxf(mx, __shfl_xor(mx, 16)); mx = fmaxf(mx, __shfl_xor(mx, 32));
            float l = 0.f;
#pragma unroll
            for (int t9 = 0; t9 < 9; ++t9)
#pragma unroll
                for (int j = 0; j < 4; ++j) { const float p = __expf(S[t9][j] - mx); S[t9][j] = p; l += p; }
            l += __shfl_xor(l, 16); l += __shfl_xor(l, 32); l += __expf(sink - mx);
            const float inv = 1.0f / l;
            f32x4 O[4];
#pragma unroll
            for (int dt = 0; dt < 4; ++dt) O[dt] = (VAR == 2) ? (f32x4){inv + S[0][0] + S[8][3], l, mx, 0.f} : (f32x4){0.f, 0.f, 0.f, 0.f};
#pragma unroll
            for (int kp5 = 0; kp5 < (VAR == 2 ? 0 : 5); ++kp5) { const int ta = 2 * kp5, tb = (2 * kp5 + 1 < 9) ? 2 * kp5 + 1 : 8;
                v4u pw; pw.x = pk2(S[ta][0] * inv, S[ta][1] * inv); pw.y = pk2(S[ta][2] * inv, S[ta][3] * inv);
                if (2 * kp5 + 1 < 9) { pw.z = pk2(S[tb][0] * inv, S[tb][1] * inv); pw.w = pk2(S[tb][2] * inv, S[tb][3] * inv); } else { pw.z = 0u; pw.w = 0u; }
                const bf16x8 P = __builtin_bit_cast(bf16x8, pw);
                const int kta = qt + ta, ktb = (qt + 2 * kp5 + 1) < 15 ? (qt + 2 * kp5 + 1) : 15;
#pragma unroll
                for (int dt = 0; dt < 4; ++dt) { const v2u lo = *(const LAS v2u*)(VT + (16 * dt + r16) * 264 + 16 * kta + 4 * quad), hi = *(const LAS v2u*)(VT + (16 * dt + r16) * 264 + 16 * ktb + 4 * quad);
                    v4u bw; bw.x = lo.x; bw.y = lo.y; bw.z = hi.x; bw.w = hi.y; O[dt] = MFMA16(__builtin_bit_cast(bf16x8, bw), P, O[dt]); } }
            bf16* op = ao + ((size_t)b * SEQ + 128 * nb + 16 * qt + r16) * 2048 + hq * 64 + 4 * quad;
#pragma unroll
            for (int dt = 0; dt < 4; ++dt) { v2u w2; w2.x = pk2(O[dt][0], O[dt][1]); w2.y = pk2(O[dt][2], O[dt][3]); *(GAS v2u*)(op + 16 * dt) = w2; }
            __builtin_amdgcn_sched_barrier(0);
        }
        LDS_BAR();
    }
}

__device__ __forceinline__ void rstd_table_fill(Frame& F, const float* ss, const pg8::StaticOrder& S) {
    pg8::Unit u0; const bool has = S.next(0, u0);
    LAS float* tab = (LAS float*)(F.lds + pg8::RSTD_LDS_OFF); LAS int* tag = (LAS int*)(F.lds + pg8::RSTD_TAG_OFF);
    if (has && F.tid < 256) { const GAS f32x4* p = (const GAS f32x4*)(ss + (size_t)(u0.pm * 256 + F.tid) * 32); float s = 0.f;
#pragma unroll
        for (int e = 0; e < 8; ++e) { const f32x4 v = p[e]; s += (v[0] + v[1]) + (v[2] + v[3]); }
        tab[F.tid] = 1.0f / sqrtf(s * (1.0f / (float)D) + pg8::RMS_EPS); }
    if (F.tid == 0) *tag = has ? u0.pm + 1 : 0;
    __syncthreads();
}
#ifndef MK_ONE_LAUNCH
#define MK_ONE_LAUNCH 1
#endif
#ifndef STREAM_BF16
#define STREAM_BF16 0
#endif
__device__ __forceinline__ bool wg_leader(int wave_s) { int l; asm volatile("v_mbcnt_lo_u32_b32 %0, -1, 0\n\tv_mbcnt_hi_u32_b32 %0, -1, %0" : "=v"(l)); return wave_s == 0 && l == 0; }
template <class T> __device__ __forceinline__ T* opq(T* p) { asm volatile("" : "+s"(p)); return p; }
__device__ __forceinline__ int opqi(int v) { asm volatile("" : "+s"(v)); return v; }
struct Args { const float* in[21]; float* out; unsigned char* ws; int ph_lo, ph_hi; };
#define HB0_ ((bf16*)(ws + WS_HB))
#define HB1_ ((bf16*)(ws + WS_HB) + (size_t)M * D)
#define SS0_ ((float*)(ws + WS_SS))
#define SS1_ ((float*)(ws + WS_SS) + (size_t)M * 32)
typedef const __attribute__((address_space(4))) Args* KArgs;
__device__ __forceinline__ KArgs kargs() { KArgs p = (KArgs)__builtin_amdgcn_kernarg_segment_ptr(); asm volatile("" : "+s"(p)); return p; }
#if MK_ONE_LAUNCH
#define SEAM(p) do { if ((p) + 1 < hi) { XcdBarrier bar_; bar_.bar = (unsigned*)((gu32*)(kargs()->ws + WS_CTL) + CW_BAR); bar_.x = xb_xcc_id(); bar_.lead = wg_leader(wv_); bar_.st = (volatile LAS unsigned*)((LAS unsigned char*)lds + MISC_OFF) + 8; xcd_barrier(bar_); } } while (0)
#define FORCE_BAR2() do { XcdBarrier bar_; bar_.bar = (unsigned*)((gu32*)(kargs()->ws + WS_CTL) + CW_BAR); bar_.x = xb_xcc_id(); bar_.lead = wg_leader(wv_); bar_.st = (volatile LAS unsigned*)((LAS unsigned char*)lds + MISC_OFF) + 8; xcd_barrier(bar_); } while (0)
#else
#define SEAM(p) do { } while (0)
#endif
#define IN(k) (lo <= (k) && (k) < hi)
#define PH_LOCALS const KArgs ap = kargs(); unsigned char* const ws = ap->ws; float* const out = ap->out; const int G_ = opqi((int)gridDim.x); const int bx_ = opqi((int)blockIdx.x); (void)out; (void)G_; (void)bx_; \
    Frame Fp; { int t_ = (wv_ << 6) | pg8::stg_lane(); asm volatile("" : "+v"(t_)); Fp.lds = (LAS unsigned char*)lds; Fp.MISC = nullptr; Fp.ctl = nullptr; Fp.tid = t_; Fp.lane = t_ & 63; Fp.wave = __builtin_amdgcn_readfirstlane(t_ >> 6); Fp.G = G_; Fp.vcu = (G_ % 8 == 0) ? (bx_ % 8) * (G_ / 8) + bx_ / 8 : bx_; } \
    const pg8::Stg SG_ = (LAS unsigned*)((LAS unsigned char*)lds + STG_OFF + Fp.wave * pg8::STG_BYTES); (void)SG_

template <int L, bool RR = false> __device__ __forceinline__ void layer_body(const int lo, const int hi, const int wv_) {
    extern __shared__ __attribute__((aligned(16))) unsigned char lds[];
#ifndef PROBE_DBLBAR
#define PROBE_DBLBAR 0
#endif
#ifndef PROBE_G1_VAR
#define PROBE_G1_VAR 0
#endif
#ifndef PROBE_SCAN_VAR
#define PROBE_SCAN_VAR 0
#endif
#ifndef PROBE_ATTN_VAR
#define PROBE_ATTN_VAR 0
#endif
#ifndef MK_KS
#define MK_KS 0
#endif
#if MK_KS
#define GEMM_SEL(EPI, DIAGV) pg8::gemm_phase_ks<EPI, pg8::StaticOrder, AL>
#else
#define GEMM_SEL(EPI, DIAGV) pg8::gemm_phase<EPI, pg8::StaticOrder, AL, SP, DIAGV>
#endif
#ifndef MK_WGM_SQ
#define MK_WGM_SQ 8
#endif
#ifndef MK_WGM_UP
#define MK_WGM_UP 8
#endif
#ifndef MK_DOWN_DIAG
#define MK_DOWN_DIAG 0
#endif
#ifndef MK_AL
#define MK_AL true
#endif
#ifndef MK_SP
#define MK_SP true
#endif
    constexpr bool AL = MK_AL, SP = MK_SP;
        const int p0 = 1 + 10 * L;
        if (IN(p0 + 0)) { PH_LOCALS;
            { pg8::Gemm g{HB0_, (const bf16*)(ws + WS_WUP) + (size_t)(2 * L) * NUP * D, M, NUP, D, D}; pg8::StaticOrder S; S.init(M, NUP, G_, bx_, MK_WGM_UP); auto pre_ = [&]() { rstd_table_fill(Fp, SS0_, S); };
              pg8::EpiSwiGLU E{(bf16*)(ws + WS_ACT), SS0_};
              GEMM_SEL(pg8::EpiSwiGLU, 0)(Fp.lds + RING_OFF, g, S, E, Fp.tid, pre_); }
            if (L == 2) { pg8::Gemm g{HB0_, (const bf16*)(ws + WS_WKV), M, 512, D, D}; pg8::StaticOrder S; S.init(M, 512, G_, bx_); auto pre_ = [&]() { rstd_table_fill(Fp, SS0_, S); };
              pg8::EpiHeadNorm E{(bf16*)(ws + WS_KX), (bf16*)(ws + WS_VX), 256, SS0_, (ap->in[15]), 1.0f, 1};
              GEMM_SEL(pg8::EpiHeadNorm, 0)(Fp.lds + RING_OFF, g, S, E, Fp.tid, pre_); }
            if (L == 2 && G_ == 256 && bx_ >= 128) { pg8::Gemm g{(const bf16*)(ws + WS_PB) + (size_t)L * M * PLE, (const bf16*)(ws + WS_WPLE) + (size_t)L * D * PLE, M, D, opqi(PLE), PLE}; pg8::StaticOrder S; S.init(M, D, 128, bx_ - 128, MK_WGM_SQ);
              pg8::EpiPlainBf16 E{(bf16*)(ws + WS_PP), D};
              GEMM_SEL(pg8::EpiPlainBf16, 0)(Fp.lds + RING_OFF, g, S, E, Fp.tid); }
            SEAM(p0 + 0);
        }
        if (IN(p0 + 1)) { PH_LOCALS;
            pg8::Gemm g{(const bf16*)(ws + WS_ACT), (const bf16*)(ws + WS_WDN) + (size_t)(2 * L) * D * LDF, M, D, FF, LDF}; pg8::StaticOrder S; S.init(M, D, G_, bx_, 4);
#ifdef PROBE_AMASK
            if (RR) { g.pm_mask = PROBE_AMASK; g.pn_mask = PROBE_BMASK; }
#endif
#if STREAM_BF16
            typedef pg8::EpiResid_T<(L > 0) || RR, false> EpiD1;
#else
            typedef pg8::EpiResid EpiD1;
#endif
            EpiD1 E{(L == 0 && !RR) ? (ap->in[0]) : out, out, HB1_, SS1_, HB0_, RR ? 0.f : 0.5f};
            GEMM_SEL(EpiD1, MK_DOWN_DIAG)(Fp.lds + RING_OFF, g, S, E, Fp.tid);
            SEAM(p0 + 1);
        }
        if (L < 2) {
            if (IN(p0 + 2)) { PH_LOCALS;
                pg8::Gemm g{HB1_, (const bf16*)(ws + WS_WIN) + (size_t)L * NIN * D, M, NIN, D, D}; pg8::StaticOrder S; S.init(M, NIN, G_, bx_); auto pre_ = [&]() { rstd_table_fill(Fp, SS1_, S); };
                pg8::EpiInProj E{(bf16*)(ws + WS_QB), (bf16*)(ws + WS_KB), (bf16*)(ws + WS_VB), (bf16*)(ws + WS_RB), SS1_};
                GEMM_SEL(pg8::EpiInProj, 0)(Fp.lds + RING_OFF, g, S, E, Fp.tid, pre_);
                gla_a1(Fp, HB1_, SS1_, (const bf16*)(ws + WS_WA1) + (size_t)L * 16 * D, (float*)(ws + WS_A1));
                SEAM(p0 + 2);
            }
            if (IN(p0 + 3)) { PH_LOCALS; gla_g1<RR ? PROBE_G1_VAR : 0>(Fp, (const bf16*)(ws + WS_QB), (const bf16*)(ws + WS_KB), (const float*)(ws + WS_A1), (ap->in[9]) + (size_t)L * 16 * 1024, (ap->in[10]) + L * 1024, (bf16*)(ws + WS_QD), (bf16*)(ws + WS_KDT), (bf16*)(ws + WS_AT), (float*)(ws + WS_DEC)); SEAM(p0 + 3); }
            if (IN(p0 + 4)) { PH_LOCALS; gla_scan<RR ? PROBE_SCAN_VAR : 0>(Fp, (const bf16*)(ws + WS_QD), (const bf16*)(ws + WS_KDT), (const bf16*)(ws + WS_AT), (const float*)(ws + WS_DEC), (const bf16*)(ws + WS_VB), (bf16*)(ws + WS_OB)); SEAM(p0 + 4); }
            if (IN(p0 + 5)) { PH_LOCALS; gla_g3(Fp, (const bf16*)(ws + WS_OB), (const bf16*)(ws + WS_RB), (bf16*)(ws + WS_OG)); SEAM(p0 + 5); }
        } else {
            if (IN(p0 + 2)) { PH_LOCALS;
                pg8::Gemm g{HB1_, (const bf16*)(ws + WS_WQ) + (size_t)(L - 2) * D * D, M, D, D, D}; pg8::StaticOrder S; S.init(M, D, G_, bx_, MK_WGM_SQ); auto pre_ = [&]() { rstd_table_fill(Fp, SS1_, S); };
                pg8::EpiHeadNorm E{(bf16*)(ws + WS_QN), nullptr, 2048, SS1_, (ap->in[18]) + (L - 2) * 64, 0.125f, 8};
                GEMM_SEL(pg8::EpiHeadNorm, 0)(Fp.lds + RING_OFF, g, S, E, Fp.tid, pre_);
                SEAM(p0 + 2);
            }
            if (IN(p0 + 3)) { PH_LOCALS; swa_attn<RR ? PROBE_ATTN_VAR : 0>(Fp, (const bf16*)(ws + WS_QN), (const bf16*)(ws + WS_KX), (const bf16*)(ws + WS_VX), (const float*)(ws + WS_BIAST), (ap->in[19]) + (L - 2) * 32, (bf16*)(ws + WS_AO)); SEAM(p0 + 3); }
        }
        if (IN(p0 + 6)) { PH_LOCALS;
            pg8::Gemm g{L < 2 ? (const bf16*)(ws + WS_OG) : (const bf16*)(ws + WS_AO), L < 2 ? (const bf16*)(ws + WS_WGO) + (size_t)L * D * D : (const bf16*)(ws + WS_WSO) + (size_t)(L - 2) * D * D, M, D, D, D};
            pg8::StaticOrder S; S.init(M, D, G_, bx_, MK_WGM_SQ);
#if STREAM_BF16
            typedef pg8::EpiResid_T<true, false> EpiO;
#else
            typedef pg8::EpiResid EpiO;
#endif
            EpiO E{out, out, HB0_, SS0_, HB1_, RR ? 0.f : 1.0f};
            GEMM_SEL(EpiO, 0)(Fp.lds + RING_OFF, g, S, E, Fp.tid);
            SEAM(p0 + 6);
        }
        if (IN(p0 + 7)) { PH_LOCALS;
#ifdef PROBE_CLOCK
            unsigned long long pc_t0 = 0, pc_r0 = 0; if (L == 0) { pc_t0 = __builtin_readcyclecounter(); pc_r0 = __builtin_amdgcn_s_memrealtime(); }
#endif
            pg8::Gemm g{HB0_, (const bf16*)(ws + WS_WUP) + (size_t)(2 * L + 1) * NUP * D, M, NUP, D, D}; pg8::StaticOrder S; S.init(M, NUP, G_, bx_, MK_WGM_UP); auto pre_ = [&]() { rstd_table_fill(Fp, SS0_, S); };
#ifdef PROBE_NOEPI
            typedef pg8::EpiSwiGLU_T<RR> EpiUp2;
#else
            typedef pg8::EpiSwiGLU EpiUp2;
#endif
            EpiUp2 E{(bf16*)(ws + WS_ACT), SS0_};
#ifdef PROBE_SPLITUP
            { pg8::OffsetOrder S1; S1.init(M, NUP, G_, bx_, MK_WGM_UP); S1.off = 0; S1.cnt = 6; pg8::gemm_phase<EpiUp2, pg8::OffsetOrder, AL, SP>(Fp.lds + RING_OFF, g, S1, E, Fp.tid);
              FORCE_BAR2();
              pg8::OffsetOrder S2; S2.init(M, NUP, G_, bx_, MK_WGM_UP); S2.off = 6; S2.cnt = 5; pg8::gemm_phase<EpiUp2, pg8::OffsetOrder, AL, SP>(Fp.lds + RING_OFF, g, S2, E, Fp.tid); }
#elif defined(PROBE_DIAG)
            GEMM_SEL(EpiUp2, RR ? PROBE_DIAG : 0)(Fp.lds + RING_OFF, g, S, E, Fp.tid);
#else
            GEMM_SEL(EpiUp2, 0)(Fp.lds + RING_OFF, g, S, E, Fp.tid, pre_);
#endif
#ifdef PROBE_CLOCK
            if (L == 0 && bx_ == 0 && Fp.tid == 0) { const unsigned long long dt = __builtin_readcyclecounter() - pc_t0, dr = __builtin_amdgcn_s_memrealtime() - pc_r0;
                ((float*)(ws + WS_CTL))[200000] = (float)dt / (float)dr * 0.1f; }
#endif
            SEAM(p0 + 7);
        }
        if (IN(p0 + 8)) {
            { PH_LOCALS; pg8::Gemm g{(const bf16*)(ws + WS_ACT), (const bf16*)(ws + WS_WDN) + (size_t)(2 * L + 1) * D * LDF, M, D, FF, LDF}; pg8::StaticOrder S; S.init(M, D, G_, bx_, 4);
#if STREAM_BF16
              typedef pg8::EpiResid_T<true, false> EpiD2;
#else
              typedef pg8::EpiResid EpiD2;
#endif
              EpiD2 E{out, out, HB1_, SS1_, HB0_, RR ? 0.f : 0.5f};
              GEMM_SEL(EpiD2, MK_DOWN_DIAG)(Fp.lds + RING_OFF, g, S, E, Fp.tid); }
            SEAM(p0 + 8);
        }
        if (IN(p0 + 9)) {
            { PH_LOCALS; if (!(L == 2 && G_ == 256)) {
              pg8::Gemm g{(const bf16*)(ws + WS_PB) + (size_t)L * M * PLE, (const bf16*)(ws + WS_WPLE) + (size_t)L * D * PLE, M, D, opqi(PLE), PLE}; pg8::StaticOrder S; S.init(M, D, G_, bx_, MK_WGM_SQ);
              pg8::EpiPlainBf16 E{(bf16*)(ws + WS_PP), D};
              GEMM_SEL(pg8::EpiPlainBf16, 0)(Fp.lds + RING_OFF, g, S, E, Fp.tid); } }
          { PH_LOCALS;
            pg8::Gemm g{HB1_, (const bf16*)(ws + WS_WGATE) + (size_t)L * D * D, M, D, D, D}; pg8::StaticOrder S; S.init(M, D, G_, bx_, MK_WGM_SQ); auto pre_ = [&]() { rstd_table_fill(Fp, SS1_, S); };
#if STREAM_BF16
            typedef pg8::EpiPleGate_T<true, L == DEPTH - 1> EpiG;
#else
            typedef pg8::EpiPleGate EpiG;
#endif
            EpiG E{out, HB0_, SS1_, SS0_, (const bf16*)(ws + WS_PP), HB1_};
            GEMM_SEL(EpiG, 0)(Fp.lds + RING_OFF, g, S, E, Fp.tid, pre_); }
            SEAM(p0 + 9);
        }
    }

__global__ void __launch_bounds__(NWAVES * 64, 2) yoco_fwd(Args args_unused_) {
    extern __shared__ __attribute__((aligned(16))) unsigned char lds[];
    Frame F;
    F.lds = (LAS unsigned char*)lds;
    F.MISC = (volatile LAS unsigned*)(F.lds + MISC_OFF);
    F.tid = threadIdx.x; F.lane = F.tid & 63; F.wave = __builtin_amdgcn_readfirstlane(F.tid >> 6);
    const int wv_ = F.wave;
    F.G = gridDim.x; { const int bx = blockIdx.x; F.vcu = (F.G % 8 == 0) ? (bx % 8) * (F.G / 8) + bx / 8 : bx; }
    F.ctl = nullptr;
    for (int u = F.tid; u < (LDS_BYTES - LDSCTL_OFF) / 4; u += NWAVES * 64) ((LAS unsigned*)(F.lds + LDSCTL_OFF))[u] = 0u;
    __syncthreads();
    const int lo = kargs()->ph_lo, hi = kargs()->ph_hi;
#if MK_ONE_LAUNCH
    { unsigned char* ws0 = kargs()->ws; (void)xcd_barrier_post((unsigned*)((gu32*)(ws0 + WS_CTL) + CW_BAR), (volatile LAS unsigned*)((LAS unsigned char*)lds + MISC_OFF) + 8, wg_leader(wv_)); }
#endif
#ifndef PROBE_DBLBAR
#define PROBE_DBLBAR 0
#endif
#ifndef PROBE_SCAN_VAR
#define PROBE_SCAN_VAR 0
#endif
#ifndef PROBE_ATTN_VAR
#define PROBE_ATTN_VAR 0
#endif
#ifndef MK_WGM_SQ
#define MK_WGM_SQ 8
#endif
#ifndef MK_WGM_UP
#define MK_WGM_UP 8
#endif
#ifndef MK_DOWN_DIAG
#define MK_DOWN_DIAG 0
#endif
#ifndef MK_AL
#define MK_AL true
#endif
#ifndef MK_SP
#define MK_SP true
#endif
    constexpr bool AL = MK_AL, SP = MK_SP;

    if (IN(0)) { PH_LOCALS;
        In I; I.x = ap->in[0]; I.p = ap->in[1]; I.norm_g = ap->in[2]; I.ffn_wg = ap->in[3]; I.ffn_wu = ap->in[4]; I.ffn_wd = ap->in[5]; I.ple_w = ap->in[6]; I.ple_gate_w = ap->in[7];
        I.gla_w_in = ap->in[8]; I.gla_w_a2 = ap->in[9]; I.gla_b_a = ap->in[10]; I.gla_norm_g = ap->in[11]; I.gla_w_o = ap->in[12]; I.kv_norm_g = ap->in[13]; I.w_kv = ap->in[14]; I.k_norm_g = ap->in[15];
        I.rel_bias = ap->in[16]; I.swa_w_q = ap->in[17]; I.q_norm_g = ap->in[18]; I.sinks = ap->in[19]; I.swa_w_o = ap->in[20];
        p0_prologue(Fp, I, ws); SEAM(0); }

#ifndef PROBE_SLOT
#define PROBE_SLOT (-1)
#endif
#ifndef PROBE_LAYERS
#define PROBE_LAYERS 0
#endif
#ifndef PROBE_PROLOGUE
#define PROBE_PROLOGUE 0
#endif
#define FORCE_BAR() do { XcdBarrier bar_; bar_.bar = (unsigned*)((gu32*)(kargs()->ws + WS_CTL) + CW_BAR); bar_.x = xb_xcc_id(); bar_.lead = wg_leader(wv_); bar_.st = (volatile LAS unsigned*)((LAS unsigned char*)lds + MISC_OFF) + 8; xcd_barrier(bar_); } while (0)
#define LAYER(L_) do { layer_body<L_>(lo, hi, wv_); \
    if (PROBE_SLOT >= 0 && ((PROBE_LAYERS >> L_) & 1)) { FORCE_BAR(); layer_body<L_, true>(1 + 10 * L_ + PROBE_SLOT, 1 + 10 * L_ + PROBE_SLOT + 1, wv_); FORCE_BAR(); } } while (0)
    if (PROBE_PROLOGUE) { PH_LOCALS;
        In I; I.x = ap->in[0]; I.p = ap->in[1]; I.norm_g = ap->in[2]; I.ffn_wg = ap->in[3]; I.ffn_wu = ap->in[4]; I.ffn_wd = ap->in[5]; I.ple_w = ap->in[6]; I.ple_gate_w = ap->in[7];
        I.gla_w_in = ap->in[8]; I.gla_w_a2 = ap->in[9]; I.gla_b_a = ap->in[10]; I.gla_norm_g = ap->in[11]; I.gla_w_o = ap->in[12]; I.kv_norm_g = ap->in[13]; I.w_kv = ap->in[14]; I.k_norm_g = ap->in[15];
        I.rel_bias = ap->in[16]; I.swa_w_q = ap->in[17]; I.q_norm_g = ap->in[18]; I.sinks = ap->in[19]; I.swa_w_o = ap->in[20];
        p0_prologue(Fp, I, ws); FORCE_BAR(); }
    LAYER(0); LAYER(1); LAYER(2); LAYER(3);
#ifdef PROBE_CLOCK
    FORCE_BAR();
    if (blockIdx.x == 0 && wg_leader(wv_)) { unsigned char* ws = kargs()->ws; float* out = kargs()->out; out[0] += ((const float*)(ws + WS_CTL))[200000] * 0.125f; }
#endif
#undef IN
#undef SEAM
}

extern "C" void kernel_launch(void* const* d_in, const int* in_sizes, int n_in, void* d_out, int out_size, void* d_ws, size_t ws_size, hipStream_t stream) {
    static int grid = 0;
    if (grid == 0) {
        if (n_in != 21 || in_sizes[0] != M * D || out_size != M * D || ws_size < WS_END) { fprintf(stderr, "kernel_launch: unexpected shapes (n_in %d, in0 %d, out %d, ws %zu < %zu); nothing launched\n", n_in, n_in > 0 ? in_sizes[0] : -1, out_size, ws_size, (size_t)WS_END); grid = -1; return; }
        int dev = 0, cus = 0, per_cu = 0;
        if (hipGetDevice(&dev) != hipSuccess || hipDeviceGetAttribute(&cus, hipDeviceAttributeMultiprocessorCount, dev) != hipSuccess) { grid = -1; return; }
        if (hipFuncSetAttribute((const void*)yoco_fwd, hipFuncAttributeMaxDynamicSharedMemorySize, LDS_BYTES) != hipSuccess) { fprintf(stderr, "kernel_launch: hipFuncSetAttribute failed\n"); grid = -1; return; }
        if (hipOccupancyMaxActiveBlocksPerMultiprocessor(&per_cu, (const void*)yoco_fwd, NWAVES * 64, LDS_BYTES) != hipSuccess || per_cu < 1) fprintf(stderr, "kernel_launch: occupancy query reports %d blocks per CU\n", per_cu);
        (void)hipGetLastError();
        grid = cus;
    }
    if (grid < 0) return;
    if (hipMemsetAsync((char*)d_ws + WS_CTL, 0, CTL_ZERO_BYTES, stream) != hipSuccess) return;
    Args a{};
    for (int i = 0; i < 21; ++i) a.in[i] = (const float*)d_in[i];
    a.out = (float*)d_out; a.ws = (unsigned char*)d_ws;
#if MK_ONE_LAUNCH
    a.ph_lo = 0; a.ph_hi = NPH;
    hipLaunchKernelGGL(yoco_fwd, dim3(grid), dim3(NWAVES * 64), LDS_BYTES, stream, a);
#else
    for (int ph = 0; ph < NPH; ++ph) {
        const int k = (ph - 1) % 10, L = (ph - 1) / 10;
        if (ph > 0 && L >= 2 && (k == 4 || k == 5)) continue;
        a.ph_lo = ph; a.ph_hi = ph + 1;
        hipLaunchKernelGGL(yoco_fwd, dim3(grid), dim3(NWAVES * 64), LDS_BYTES, stream, a);
    }
#endif
}
```

```cpp
#include <hip/hip_runtime.h>
#include <cstdio>
#include <cstdint>
#ifndef MK_PRIO
#define MK_PRIO 1
#endif
#ifndef MK_FULLLINE
#define MK_FULLLINE 0
#endif
#ifndef MK_KOUTER
#define MK_KOUTER 1
#endif
#ifndef MK_SP4
#define MK_SP4 0
#endif
#ifndef MK_EARLY
#define MK_EARLY 0
#endif
#ifndef MK_KSR
#define MK_KSR 0
#endif
#ifndef MK_LPRIO
#define MK_LPRIO 0
#endif
#define MK_ONE_LAUNCH 1
#define STREAM_BF16 1
#define MK_HOOK_IN 1
namespace pg8 {
#define PG8_LAS __attribute__((address_space(3)))
typedef unsigned short bf16_t;
typedef short bf16x8 __attribute__((ext_vector_type(8)));
typedef float f32x4 __attribute__((ext_vector_type(4)));
typedef unsigned u32x4 __attribute__((ext_vector_type(4)));
constexpr int BM = 256, BK = 64, HALF = 128, HTB = HALF * BK * 2  , STAGE_BYTES = 8 * HTB, NXCD = 8, WGM = 8;

__host__ __device__ __forceinline__ int lds_byte(int r, int c) { const int st = (r >> 4) * 2 + (c >> 5), rr = r & 15, cc = c & 31, ob = rr * 64 + cc * 2; return st * 1024 + (ob ^ (((ob >> 9) & 1) << 5)); }
__host__ __device__ __forceinline__ void stage_rc(int b, int& R, int& C) { const int st = b / 1024, sb = b % 1024, swz = sb ^ (((sb >> 9) & 1) << 5); R = (st >> 1) * 16 + swz / 64; C = (st & 1) * 32 + (swz % 64) / 2; }
__host__ __device__ __forceinline__ int perm32(int rho) { const int n = rho >> 4, i = rho & 15; return 8 * (i >> 2) + 4 * n + (i & 3); }

struct Unit { int pm, pn; };
struct Gemm { const bf16_t* A; const bf16_t* Bt; int M, N, K, ld; int pm_mask = -1, pn_mask = -1; };

struct StaticOrder {
    int nM, nN, nwg, G, c, wgm;
    __host__ __device__ void init(int M, int N, int G_, int c_, int wgm_ = WGM) { nM = M / BM; nN = N / BM; nwg = nM * nN; G = G_; c = c_; wgm = wgm_; }
    __host__ __device__ bool next(int i, Unit& u) const {
        const long L = (long)i * G + c; if (L >= nwg) return false;
        int wgid = (int)L; { const int q = nwg / NXCD, r = nwg % NXCD, xcd = wgid % NXCD, off = wgid / NXCD; wgid = (xcd < r ? xcd * (q + 1) : r * (q + 1) + (xcd - r) * q) + off; }
        const int nig = wgm * nN, gid = wgid / nig, fm = gid * wgm, gsz = (nM - fm) < wgm ? (nM - fm) : wgm;
        u.pm = fm + ((wgid % nig) % gsz); u.pn = (wgid % nig) / gsz; return true;
    }
    __device__ __forceinline__ void a_ready(const Unit&) const {}
    __device__ __forceinline__ void done(const Unit&) const {}
};
typedef float cvt_f32x2_t __attribute__((ext_vector_type(2))); typedef __bf16 cvt_bf16x2_t __attribute__((ext_vector_type(2)));
__device__ __forceinline__ unsigned cvt_pk_bf16(float lo, float hi) { cvt_f32x2_t v = {lo, hi}; cvt_bf16x2_t b = __builtin_convertvector(v, cvt_bf16x2_t); return __builtin_bit_cast(unsigned, b); }
typedef float f32x2 __attribute__((ext_vector_type(2)));
struct OffsetOrder : StaticOrder { int off, cnt; __host__ __device__ bool next(int i, Unit& u) const { if (i >= cnt) return false; return StaticOrder::next(i + off, u); } };
constexpr float RMS_EPS = 1e-6f;
constexpr int DM = 2048, DFF = 5632 + 64;
typedef unsigned u32x2 __attribute__((ext_vector_type(2)));
__device__ __forceinline__ float bf2f(unsigned short b) { return __uint_as_float((unsigned)b << 16); }
__device__ __forceinline__ float sigmoid_f(float x) { return __builtin_amdgcn_rcpf(1.0f + __builtin_amdgcn_exp2f(-1.4426950408889634f * x)); }
__device__ __forceinline__ u32x4 pack8(const f32x4& a, const f32x4& b) { u32x4 w; w.x = cvt_pk_bf16(a[0], a[1]); w.y = cvt_pk_bf16(a[2], a[3]); w.z = cvt_pk_bf16(b[0], b[1]); w.w = cvt_pk_bf16(b[2], b[3]); return w; }
__device__ __forceinline__ void unpack8(const u32x4& w, f32x4& a, f32x4& b) {
    a[0] = __uint_as_float(w.x << 16); a[1] = __uint_as_float(w.x & 0xffff0000u); a[2] = __uint_as_float(w.y << 16); a[3] = __uint_as_float(w.y & 0xffff0000u);
    b[0] = __uint_as_float(w.z << 16); b[1] = __uint_as_float(w.z & 0xffff0000u); b[2] = __uint_as_float(w.w << 16); b[3] = __uint_as_float(w.w & 0xffff0000u); }
__device__ __forceinline__ float dot4(const f32x4& a) { return (a[0] * a[0] + a[1] * a[1]) + (a[2] * a[2] + a[3] * a[3]); }
__device__ __forceinline__ void row_rstd8(const float* ss, const Unit& u, int wr, int fr, int fq, float (&rs)[2][4]) {
#pragma unroll
    for (int ai = 0; ai < 2; ++ai)
#pragma unroll
        for (int m = 0; m < 4; ++m) {
            const int row = u.pm * BM + ai * HALF + wr * 64 + m * 16 + fr;
            const f32x4* p = (const f32x4*)(ss + (size_t)row * 32 + fq * 8);
            const f32x4 a = p[0], b = p[1];
            float s = ((a[0] + a[1]) + (a[2] + a[3])) + ((b[0] + b[1]) + (b[2] + b[3]));
            s += __shfl_xor(s, 16); s += __shfl_xor(s, 32);
            rs[ai][m] = 1.0f / sqrtf(s * (1.0f / (float)DM) + RMS_EPS);
        }
}
constexpr int STG_PITCH_B = 20, STG_PITCH_F = 36, STG_BYTES = 16 * STG_PITCH_F * 4;
typedef PG8_LAS unsigned* Stg;
constexpr int RSTD_LDS_OFF = STAGE_BYTES + 1024;
constexpr int RSTD_TAG_OFF = STAGE_BYTES + 448;
constexpr int HSC_LDS_OFF = STAGE_BYTES + 2048 + 8 * 2304;
constexpr int STG_LDS_OFF = STAGE_BYTES + 2048;
__device__ __forceinline__ Stg stg_ptr(int wr, int wc) { extern __shared__ __attribute__((aligned(16))) unsigned char pg8_dyn_lds[]; return (Stg)((PG8_LAS unsigned char*)pg8_dyn_lds + STG_LDS_OFF + (wr * 4 + wc) * (16 * 36 * 4)); }
__device__ __forceinline__ int stg_lane() { int l; asm volatile("v_mbcnt_lo_u32_b32 %0, -1, 0\n\tv_mbcnt_hi_u32_b32 %0, -1, %0" : "=v"(l)); return l; }
__device__ __forceinline__ void st_bf16_patch(const Stg S, int ln, int fr, int fq, const u32x4& w, bf16_t* dst, int ld) {
    *(PG8_LAS u32x4*)(S + fr * STG_PITCH_B + 4 * fq) = w;
    const u32x4 t = *(const PG8_LAS u32x4*)(S + (ln >> 2) * STG_PITCH_B + 4 * (ln & 3));
    *(u32x4*)(dst + (size_t)(ln >> 2) * ld + 8 * (ln & 3)) = t;
}
__device__ __forceinline__ void xp_f32_patch(const Stg S, int ln, int fr, int fq, const f32x4& v0, const f32x4& v1, f32x4 (&t)[2]) {
    PG8_LAS float* f = (PG8_LAS float*)S;
    *(PG8_LAS f32x4*)(f + fr * STG_PITCH_F + 8 * fq) = v0; *(PG8_LAS f32x4*)(f + fr * STG_PITCH_F + 8 * fq + 4) = v1;
#pragma unroll
    for (int hf = 0; hf < 2; ++hf) t[hf] = *(const PG8_LAS f32x4*)(f + ((ln >> 3) + 8 * hf) * STG_PITCH_F + 4 * (ln & 7));
}
__device__ __forceinline__ void row_rstd8_cached(const float* ss, const Unit& u, int wr, int fr, int fq, float (&rs)[2][4]) {
    extern __shared__ __attribute__((aligned(16))) unsigned char pg8_dyn_lds2[];
    const PG8_LAS float* tab = (const PG8_LAS float*)((PG8_LAS unsigned char*)pg8_dyn_lds2 + RSTD_LDS_OFF);
    const int tag = *(const PG8_LAS int*)((PG8_LAS unsigned char*)pg8_dyn_lds2 + RSTD_TAG_OFF);
    if (tag == u.pm + 1) {
#pragma unroll
        for (int ai = 0; ai < 2; ++ai)
#pragma unroll
            for (int m = 0; m < 4; ++m) rs[ai][m] = tab[ai * HALF + wr * 64 + m * 16 + fr];
    } else row_rstd8(ss, u, wr, fr, fq, rs);
}
template <bool NOEPI = false> struct EpiSwiGLU_T {
    static constexpr bool PERM = true, AFTER_DRAIN = false, KHOOK = false;
    bf16_t* O; const float* ss;;
    __device__ __forceinline__ void operator()(const f32x4 (&acc)[2][2][4][2], const Unit& u, int wr, int wc, int fr, int fq) const {
        if (NOEPI) {
            f32x4 t = {0.f, 0.f, 0.f, 0.f};
#pragma unroll
            for (int ai = 0; ai < 2; ++ai)
#pragma unroll
                for (int bj = 0; bj < 2; ++bj)
#pragma unroll
                    for (int m = 0; m < 4; ++m) { t += acc[ai][bj][m][0]; t += acc[ai][bj][m][1]; }
            if (t[0] + t[1] + t[2] + t[3] == 12345.678f) O[0] = 1;
            return; }
        const int ln = stg_lane(); const Stg sg = stg_ptr(wr, wc);
        float rs[2][4]; row_rstd8_cached(ss, u, wr, fr, fq, rs);
        const int col0 = u.pn * HALF + wc * 32;
#pragma unroll
        for (int ai = 0; ai < 2; ++ai)
#pragma unroll
            for (int m = 0; m < 4; ++m) {
                const int row0 = u.pm * BM + ai * HALF + wr * 64 + m * 16; const float r = rs[ai][m];
                f32x4 o[2];
#pragma unroll
                for (int n = 0; n < 2; ++n) { const f32x4 g = acc[ai][0][m][n] * r, uu = acc[ai][1][m][n] * r;
#pragma unroll
                    for (int i = 0; i < 4; ++i) o[n][i] = g[i] * sigmoid_f(g[i]) * uu[i]; }
                st_bf16_patch(sg, ln, fr, fq, pack8(o[0], o[1]), O + (size_t)row0 * DFF + col0, DFF);
            }
    }
};
typedef EpiSwiGLU_T<false> EpiSwiGLU;
template <bool BASE16 = false, bool OUT32 = true, bool HSC = false> struct EpiResid_T {
    static constexpr bool PERM = true, AFTER_DRAIN = false, KHOOK = HSC;
    const float* base; float* out; bf16_t* hb; float* sso; const bf16_t* hbi; float scale; int pad_;
    static __device__ __forceinline__ void khook(f32x4 (&acc)[2][2][4][2], int ui, int hidx, int wr) {
        extern __shared__ __attribute__((aligned(16))) unsigned char pg8_dyn_lds3[];
        const int fr = stg_lane() & 15;
        const PG8_LAS float* tab = (const PG8_LAS float*)((PG8_LAS unsigned char*)pg8_dyn_lds3 + HSC_LDS_OFF) + (ui & 1) * 1024 + (hidx - 1);
        __builtin_amdgcn_sched_barrier(0);
#pragma unroll
        for (int ai = 0; ai < 2; ++ai)
#pragma unroll
            for (int mh = 0; mh < 2; ++mh) {
                const float f0 = tab[(ai * HALF + wr * 64 + (2 * mh) * 16 + fr) * 4], f1 = tab[(ai * HALF + wr * 64 + (2 * mh + 1) * 16 + fr) * 4];
#pragma unroll
                for (int bj = 0; bj < 2; ++bj)
#pragma unroll
                    for (int n = 0; n < 2; ++n) { acc[ai][bj][2 * mh][n] *= f0; acc[ai][bj][2 * mh + 1][n] *= f1; }
                __builtin_amdgcn_sched_barrier(0);
            }
    }
    __device__ __forceinline__ void operator()(const f32x4 (&acc)[2][2][4][2], const Unit& u, int wr, int wc, int fr, int fq) const {
        const int ln = stg_lane(); const Stg sg = stg_ptr(wr, wc);
        const int colw = u.pn * BM + wc * 32 + 4 * (ln & 7);
        if (BASE16) {
#pragma unroll
            for (int ai = 0; ai < 2; ++ai) {
                const int rowa = u.pm * BM + ai * HALF + wr * 64 + (ln >> 3);
                u32x2 braw[4][2][2];
#pragma unroll
                for (int m = 0; m < 4; ++m)
#pragma unroll
                    for (int bj = 0; bj < 2; ++bj)
#pragma unroll
                        for (int hf = 0; hf < 2; ++hf) braw[m][bj][hf] = *(const u32x2*)(hbi + (size_t)(rowa + m * 16 + 8 * hf) * DM + colw + bj * HALF);
#pragma unroll
                for (int m = 0; m < 4; ++m) { const int row0 = rowa + m * 16; float s[2] = {0.f, 0.f};
#pragma unroll
                    for (int bj = 0; bj < 2; ++bj) {
                        f32x4 t[2]; xp_f32_patch(sg, ln, fr, fq, acc[ai][bj][m][0] * scale, acc[ai][bj][m][1] * scale, t);
#pragma unroll
                        for (int hf = 0; hf < 2; ++hf) { const size_t off = (size_t)(row0 + 8 * hf) * DM + colw + bj * HALF; const u32x2 bw = braw[m][bj][hf];
                            const f32x4 h = (f32x4){__uint_as_float(bw.x << 16), __uint_as_float(bw.x & 0xffff0000u), __uint_as_float(bw.y << 16), __uint_as_float(bw.y & 0xffff0000u)} + t[hf];
                            if (OUT32) *(f32x4*)(out + off) = h; u32x2 w; w.x = cvt_pk_bf16(h[0], h[1]); w.y = cvt_pk_bf16(h[2], h[3]); *(u32x2*)(hb + off) = w;
                            s[hf] += dot4(h); }
                    }
#pragma unroll
                    for (int hf = 0; hf < 2; ++hf) { float q = s[hf]; q += __shfl_xor(q, 1); q += __shfl_xor(q, 2); q += __shfl_xor(q, 4);
                        if ((ln & 7) == 0) sso[(size_t)(row0 + 8 * hf) * 32 + u.pn * 4 + wc] = q; }
                }
                asm volatile("" ::: "memory");
            }
            return;
        }
#pragma unroll
        for (int ai = 0; ai < 2; ++ai)
#pragma unroll
            for (int mh = 0; mh < 2; ++mh) {
                const int rowa = u.pm * BM + ai * HALF + wr * 64 + (ln >> 3);
                f32x4 bs[2][2][2];
#pragma unroll
                for (int mm = 0; mm < 2; ++mm)
#pragma unroll
                    for (int bj = 0; bj < 2; ++bj)
#pragma unroll
                        for (int hf = 0; hf < 2; ++hf) bs[mm][bj][hf] = *(const f32x4*)(base + (size_t)(rowa + (2 * mh + mm) * 16 + 8 * hf) * DM + colw + bj * HALF);
#pragma unroll
                for (int mm = 0; mm < 2; ++mm) { const int m = 2 * mh + mm;
                    const int row0 = rowa + m * 16; float s[2] = {0.f, 0.f};
#pragma unroll
                    for (int bj = 0; bj < 2; ++bj) {
                        f32x4 t[2]; xp_f32_patch(sg, ln, fr, fq, acc[ai][bj][m][0] * scale, acc[ai][bj][m][1] * scale, t);
#pragma unroll
                        for (int hf = 0; hf < 2; ++hf) { const size_t off = (size_t)(row0 + 8 * hf) * DM + colw + bj * HALF;
                            const f32x4 h = bs[mm][bj][hf] + t[hf];
                            if (OUT32) *(f32x4*)(out + off) = h; u32x2 w; w.x = cvt_pk_bf16(h[0], h[1]); w.y = cvt_pk_bf16(h[2], h[3]); *(u32x2*)(hb + off) = w;
                            s[hf] += dot4(h); }
                    }
#pragma unroll
                    for (int hf = 0; hf < 2; ++hf) { float q = s[hf]; q += __shfl_xor(q, 1); q += __shfl_xor(q, 2); q += __shfl_xor(q, 4);
                        if ((ln & 7) == 0) sso[(size_t)(row0 + 8 * hf) * 32 + u.pn * 4 + wc] = q; }
                }
                asm volatile("" ::: "memory");
            }
    }
};
typedef EpiResid_T<false, true> EpiResid;
template <bool BASE16 = false, bool OUT32 = true> struct EpiPleGate_T {
    static constexpr bool PERM = true, AFTER_DRAIN = false, KHOOK = false;
    float* h; bf16_t* hb; const float* ssi; float* sso; const bf16_t* pp; const bf16_t* hbi;
    __device__ __forceinline__ void operator()(const f32x4 (&acc)[2][2][4][2], const Unit& u, int wr, int wc, int fr, int fq) const {
        const int ln = stg_lane(); const Stg sg = stg_ptr(wr, wc);
        float rs[2][4]; row_rstd8_cached(ssi, u, wr, fr, fq, rs);
        const int colw = u.pn * BM + wc * 32 + 4 * (ln & 7);
        if (BASE16) {
#pragma unroll
            for (int ai = 0; ai < 2; ++ai)
#pragma unroll
                for (int mh = 0; mh < 2; ++mh) {
                const int rowa = u.pm * BM + ai * HALF + wr * 64 + (ln >> 3);
                u32x2 braw[2][2][2], praw[2][2][2];
#pragma unroll
                for (int mm = 0; mm < 2; ++mm)
#pragma unroll
                    for (int bj = 0; bj < 2; ++bj)
#pragma unroll
                        for (int hf = 0; hf < 2; ++hf) { const size_t off = (size_t)(rowa + (2 * mh + mm) * 16 + 8 * hf) * DM + colw + bj * HALF; braw[mm][bj][hf] = *(const u32x2*)(hbi + off); praw[mm][bj][hf] = *(const u32x2*)(pp + off); }
#pragma unroll
                for (int mm = 0; mm < 2; ++mm) { const int m = 2 * mh + mm; const int row0 = rowa + m * 16; const float r = rs[ai][m]; float s[2] = {0.f, 0.f};
#pragma unroll
                    for (int bj = 0; bj < 2; ++bj) {
                        f32x4 g0, g1;
#pragma unroll
                        for (int i = 0; i < 4; ++i) { g0[i] = sigmoid_f(acc[ai][bj][m][0][i] * r); g1[i] = sigmoid_f(acc[ai][bj][m][1][i] * r); }
                        f32x4 t[2]; xp_f32_patch(sg, ln, fr, fq, g0, g1, t);
#pragma unroll
                        for (int hf = 0; hf < 2; ++hf) { const size_t off = (size_t)(row0 + 8 * hf) * DM + colw + bj * HALF; const u32x2 bw = braw[mm][bj][hf], pw = praw[mm][bj][hf];
                            const f32x4 bv = {__uint_as_float(bw.x << 16), __uint_as_float(bw.x & 0xffff0000u), __uint_as_float(bw.y << 16), __uint_as_float(bw.y & 0xffff0000u)};
                            const f32x4 pv = {__uint_as_float(pw.x << 16), __uint_as_float(pw.x & 0xffff0000u), __uint_as_float(pw.y << 16), __uint_as_float(pw.y & 0xffff0000u)};
                            const f32x4 hn = bv + t[hf] * pv;
                            if (OUT32) *(f32x4*)(h + off) = hn; u32x2 w; w.x = cvt_pk_bf16(hn[0], hn[1]); w.y = cvt_pk_bf16(hn[2], hn[3]); *(u32x2*)(hb + off) = w;
                            s[hf] += dot4(hn); }
                    }
#pragma unroll
                    for (int hf = 0; hf < 2; ++hf) { float q = s[hf]; q += __shfl_xor(q, 1); q += __shfl_xor(q, 2); q += __shfl_xor(q, 4);
                        if ((ln & 7) == 0) sso[(size_t)(row0 + 8 * hf) * 32 + u.pn * 4 + wc] = q; }
                }
                asm volatile("" ::: "memory");
            }
            return;
        }
#pragma unroll
        for (int ai = 0; ai < 2; ++ai)
#pragma unroll
            for (int m = 0; m < 4; ++m) {
                const int row0 = u.pm * BM + ai * HALF + wr * 64 + m * 16 + (ln >> 3); const float r = rs[ai][m]; float s[2] = {0.f, 0.f};
                f32x4 bs[2][2]; u32x2 pq[2][2];
#pragma unroll
                for (int bj = 0; bj < 2; ++bj)
#pragma unroll
                    for (int hf = 0; hf < 2; ++hf) { const size_t off = (size_t)(row0 + 8 * hf) * DM + colw + bj * HALF; pq[bj][hf] = *(const u32x2*)(pp + off);
                        if (BASE16) { const u32x2 w = *(const u32x2*)(hbi + off); bs[bj][hf] = (f32x4){__uint_as_float(w.x << 16), __uint_as_float(w.x & 0xffff0000u), __uint_as_float(w.y << 16), __uint_as_float(w.y & 0xffff0000u)}; }
                        else bs[bj][hf] = *(const f32x4*)(h + off); }
#pragma unroll
                for (int bj = 0; bj < 2; ++bj) {
                    f32x4 g0, g1;
#pragma unroll
                    for (int i = 0; i < 4; ++i) { g0[i] = sigmoid_f(acc[ai][bj][m][0][i] * r); g1[i] = sigmoid_f(acc[ai][bj][m][1][i] * r); }
                    f32x4 t[2]; xp_f32_patch(sg, ln, fr, fq, g0, g1, t);
#pragma unroll
                    for (int hf = 0; hf < 2; ++hf) { const size_t off = (size_t)(row0 + 8 * hf) * DM + colw + bj * HALF;
                        const u32x2 pw = pq[bj][hf]; f32x4 pv; pv[0] = __uint_as_float(pw.x << 16); pv[1] = __uint_as_float(pw.x & 0xffff0000u); pv[2] = __uint_as_float(pw.y << 16); pv[3] = __uint_as_float(pw.y & 0xffff0000u);
                        const f32x4 hn = bs[bj][hf] + t[hf] * pv;
                        if (OUT32) *(f32x4*)(h + off) = hn; u32x2 w; w.x = cvt_pk_bf16(hn[0], hn[1]); w.y = cvt_pk_bf16(hn[2], hn[3]); *(u32x2*)(hb + off) = w;
                        s[hf] += dot4(hn); }
                }
#pragma unroll
                for (int hf = 0; hf < 2; ++hf) { float q = s[hf]; q += __shfl_xor(q, 1); q += __shfl_xor(q, 2); q += __shfl_xor(q, 4);
                    if ((ln & 7) == 0) sso[(size_t)(row0 + 8 * hf) * 32 + u.pn * 4 + wc] = q; }
                asm volatile("" ::: "memory");
            }
    }
};
typedef EpiPleGate_T<false, true> EpiPleGate;
struct EpiInProj {
    static constexpr bool PERM = true, AFTER_DRAIN = false, KHOOK = false;
    bf16_t *qb, *kb, *vb, *rb; const float* ss;
    __device__ __forceinline__ void operator()(const f32x4 (&acc)[2][2][4][2], const Unit& u, int wr, int wc, int fr, int fq) const {
        const int ln = stg_lane(); const Stg sg = stg_ptr(wr, wc);
        float rs[2][4]; row_rstd8_cached(ss, u, wr, fr, fq, rs);
        const int pn = u.pn; int mode, ld, colt; bf16_t* O;
        if (pn < 4) { mode = 0; O = qb; ld = 1024; colt = pn * BM; } else if (pn < 8) { mode = 1; O = kb; ld = 1024; colt = (pn - 4) * BM; }
        else if (pn < 16) { mode = 2; O = vb; ld = 2048; colt = (pn - 8) * BM; } else { mode = 3; O = rb; ld = 2048; colt = (pn - 16) * BM; }
        const int colp = colt + wc * 32;
#pragma unroll
        for (int ai = 0; ai < 2; ++ai)
#pragma unroll
            for (int m = 0; m < 4; ++m) {
                const int row0 = u.pm * BM + ai * HALF + wr * 64 + m * 16; const float r = rs[ai][m];
#pragma unroll
                for (int bj = 0; bj < 2; ++bj) {
                    f32x4 v0 = acc[ai][bj][m][0] * r, v1 = acc[ai][bj][m][1] * r;
                    if (mode == 0) { v0 = v0 * 0.0625f; v1 = v1 * 0.0625f; }
                    if (mode == 3) {
#pragma unroll
                        for (int i = 0; i < 4; ++i) { v0[i] = v0[i] * sigmoid_f(v0[i]); v1[i] = v1[i] * sigmoid_f(v1[i]); } }
                    st_bf16_patch(sg, ln, fr, fq, pack8(v0, v1), O + (size_t)row0 * ld + colp + bj * HALF, ld);
                }
            }
    }
};
struct EpiHeadNorm {
    static constexpr bool PERM = true, AFTER_DRAIN = false, KHOOK = false;
    bf16_t* O0; bf16_t* O1; int ld; const float* ss; const float* g; float oscale; int norm_tiles;;
    __device__ __forceinline__ void operator()(const f32x4 (&acc)[2][2][4][2], const Unit& u, int wr, int wc, int fr, int fq) const {
        const int ln = stg_lane(); const Stg sg = stg_ptr(wr, wc);
        float rs[2][4]; row_rstd8_cached(ss, u, wr, fr, fq, rs);
        const bool nrm = u.pn < norm_tiles; bf16_t* O = nrm ? O0 : O1; const int colp = (nrm ? u.pn : u.pn - norm_tiles) * BM + 64 * wc;
        f32x4 gv[2][2];
#pragma unroll
        for (int bj = 0; bj < 2; ++bj)
#pragma unroll
            for (int n = 0; n < 2; ++n) gv[bj][n] = *(const f32x4*)(g + 32 * bj + 8 * fq + 4 * n) * oscale;
#pragma unroll
        for (int ai = 0; ai < 2; ++ai)
#pragma unroll
            for (int m = 0; m < 4; ++m) {
                const int row0 = u.pm * BM + ai * HALF + wr * 64 + m * 16; const float r = rs[ai][m];
                f32x4 v[2][2]; float s = 0.f;
#pragma unroll
                for (int bj = 0; bj < 2; ++bj)
#pragma unroll
                    for (int n = 0; n < 2; ++n) { v[bj][n] = acc[ai][bj][m][n] * r; s += dot4(v[bj][n]); }
                s += __shfl_xor(s, 16); s += __shfl_xor(s, 32);
                const float hn = 1.0f / sqrtf(s * (1.0f / 64.0f) + RMS_EPS);
#pragma unroll
                for (int bj = 0; bj < 2; ++bj) {
                    f32x4 o0 = v[bj][0], o1 = v[bj][1];
                    if (nrm) { o0 = o0 * hn * gv[bj][0]; o1 = o1 * hn * gv[bj][1]; }
                    st_bf16_patch(sg, ln, fr, fq, pack8(o0, o1), O + (size_t)row0 * ld + colp + 32 * bj, ld);
                }
            }
    }
};
struct EpiPlainBf16 {
    static constexpr bool PERM = true, AFTER_DRAIN = false, KHOOK = false;
    bf16_t* O; int ld;;
    __device__ __forceinline__ void operator()(const f32x4 (&acc)[2][2][4][2], const Unit& u, int wr, int wc, int fr, int fq) const {
        const int ln = stg_lane(); const Stg sg = stg_ptr(wr, wc);
        const int colp = u.pn * BM + wc * 32;
#pragma unroll
        for (int ai = 0; ai < 2; ++ai)
#pragma unroll
            for (int m = 0; m < 4; ++m) {
                const int row0 = u.pm * BM + ai * HALF + wr * 64 + m * 16;
#pragma unroll
                for (int bj = 0; bj < 2; ++bj) { st_bf16_patch(sg, ln, fr, fq, pack8(acc[ai][bj][m][0], acc[ai][bj][m][1]), O + (size_t)row0 * ld + colp + bj * HALF, ld); asm volatile("" ::: "memory"); }
            }
    }
};
struct NoPre { __device__ __forceinline__ void operator()() const {} };
template <class Epi, class Sched, bool ALIGN_EPI = false, bool SP2 = false, int DIAG = 0  , class Pre = NoPre>
__device__ __forceinline__ void gemm_phase(PG8_LAS unsigned char* lds, const Gemm g, const Sched& S, const Epi& E, const int tid_in, const Pre& pre = Pre()) {
    int tid_l_ = tid_in; asm volatile("" : "+v"(tid_l_));
    const int tid = tid_l_, wid = __builtin_amdgcn_readfirstlane(tid >> 6), lane = tid & 63, wr = wid >> 2, wc = wid & 3, fr = lane & 15, fq = lane >> 4;
    const int K = g.K, nt = K / BK, ld = g.ld;
    unsigned voffA[2], voffB[2];
#pragma unroll
    for (int i = 0; i < 2; ++i) { int R, C;
#if MK_FULLLINE
        { const int b = tid * 16 + i * 8192, st = b >> 10, rr = (b & 1023) >> 7, cp = (b & 127) >> 4; R = st * 8 + rr; C = (cp ^ (((st & 1) << 2) + (rr >> 1))) * 8; }
#else
        stage_rc(tid * 16 + i * 8192, R, C);
#endif
        const int Rb = Epi::PERM ? ((R & ~31) + perm32(R & 31)) : R;
        voffA[i] = (unsigned)(R * ld + C) * 2u; voffB[i] = (unsigned)(Rb * ld + C) * 2u; }
    const ptrdiff_t kstep = (DIAG == 4) ? -(ptrdiff_t)(BK * 2) : (ptrdiff_t)(BK * 2);
    const size_t kfirst = (DIAG == 4) ? (size_t)(nt - 1) * (BK * 2) : 0;
    const unsigned hstep = (unsigned)(HALF * ld * 2);
    const size_t tstep = (size_t)2 * hstep;
    const unsigned ldsw = (unsigned)wid * 1024u;
#if MK_FULLLINE
    int aoffk[2], boffk[2];
#pragma unroll
    for (int k = 0; k < 2; ++k) { const int ra = wr * 64 + fr, rb = wc * 32 + fr; aoffk[k] = (ra >> 3) * 1024 + (ra & 7) * 128 + (((k * 4 + fq) ^ (fr >> 1)) << 4); boffk[k] = (rb >> 3) * 1024 + (rb & 7) * 128 + (((k * 4 + fq) ^ (fr >> 1)) << 4); }
#define PG8_AOFF(m, k) (aoffk[k] + (m) * 2048)
#define PG8_BOFF(n, k) (boffk[k] + (n) * 2048)
#else
    const int aoff = lds_byte(wr * 64 + fr, fq * 8), boff = lds_byte(wc * 32 + fr, fq * 8);
#define PG8_AOFF(m, k) (aoff + (m) * 2048 + (k) * 1024)
#define PG8_BOFF(n, k) (boff + (n) * 2048 + (k) * 1024)
#endif
#define PG8_SA(b, h) (((b) * 2 + (h)) * HTB)
#define PG8_SB(b, h) ((4 + (b) * 2 + (h)) * HTB)
#define PG8_STAGE(bufoff, gbase, voff) do { _Pragma("unroll") for (int _i = 0; _i < 2; ++_i) \
        __builtin_amdgcn_global_load_lds((const unsigned*)((const char*)(gbase) + (voff)[_i]), (PG8_LAS unsigned*)(lds + (bufoff) + ldsw + _i * 8192), 16, 0, 0); } while (0)
#define PG8_STAGEA(bufoff, gbase, voff) do { _Pragma("unroll") for (int _i = 0; _i < 2; ++_i) \
        __builtin_amdgcn_global_load_lds((const unsigned*)((const char*)(gbase) + (voff)[_i]), (PG8_LAS unsigned*)(lds + (bufoff) + ldsw + _i * 8192), 16, 0, (DIAG == 3) ? 2 : 0); } while (0)
#define PG8_LDA(dst, b, h) do { _Pragma("unroll") for (int m = 0; m < 4; ++m) _Pragma("unroll") for (int k = 0; k < 2; ++k) dst[m][k] = *(const PG8_LAS bf16x8*)(lds + PG8_SA(b, h) + PG8_AOFF(m, k)); } while (0)
#define PG8_LDB(dst, b, h) do { _Pragma("unroll") for (int n = 0; n < 2; ++n) _Pragma("unroll") for (int k = 0; k < 2; ++k) dst[n][k] = *(const PG8_LAS bf16x8*)(lds + PG8_SB(b, h) + PG8_BOFF(n, k)); } while (0)
#define PG8_MMA(ai, bj, At, Bt) do { if (DIAG == 1 && (ai) == 1) break; __builtin_amdgcn_s_setprio(MK_PRIO); _Pragma("unroll") for (int m = 0; m < 4; ++m) _Pragma("unroll") for (int n = 0; n < 2; ++n) _Pragma("unroll") for (int k = 0; k < 2; ++k) \
        acc[ai][bj][m][n] = __builtin_amdgcn_mfma_f32_16x16x32_bf16(Bt[n][k], At[m][k], acc[ai][bj][m][n], 0, 0, 0); __builtin_amdgcn_s_setprio(MK_LPRIO); } while (0)
#define PG8_MMA_PAIR_BAR(ai, At, Ba, Bb) do { if (DIAG == 1 && (ai) == 1) { PG8_BAR; break; } __builtin_amdgcn_s_setprio(MK_PRIO); \
        _Pragma("unroll") for (int m = 0; m < 4; ++m) _Pragma("unroll") for (int n = 0; n < 2; ++n) _Pragma("unroll") for (int k = 0; k < 2; ++k) \
            acc[ai][0][m][n] = __builtin_amdgcn_mfma_f32_16x16x32_bf16(Ba[n][k], At[m][k], acc[ai][0][m][n], 0, 0, 0); \
        _Pragma("unroll") for (int m = 0; m < 4; ++m) _Pragma("unroll") for (int n = 0; n < 2; ++n) _Pragma("unroll") for (int k = 0; k < 2; ++k) { \
            if ((m * 4 + n * 2 + k) == 16 - MK_EARLY) { __builtin_amdgcn_sched_barrier(0); __builtin_amdgcn_s_barrier(); __builtin_amdgcn_sched_barrier(0); } \
            acc[ai][1][m][n] = __builtin_amdgcn_mfma_f32_16x16x32_bf16(Bb[n][k], At[m][k], acc[ai][1][m][n], 0, 0, 0); } \
        __builtin_amdgcn_s_setprio(0); } while (0)
#define PG8_WAIT_V(n) asm volatile("s_waitcnt vmcnt(" #n ")" ::: "memory")
#define PG8_WAIT_L(n) asm volatile("s_waitcnt lgkmcnt(" #n ")" ::: "memory")
#define PG8_BAR __builtin_amdgcn_s_barrier()
#define PG8_SCHED __builtin_amdgcn_sched_barrier(0)
    Unit cur, nxt; int ui = 0;
    if (!S.next(0, cur)) return;
    f32x4 acc[2][2][4][2];
#pragma unroll
    for (int a = 0; a < 2; ++a)
#pragma unroll
        for (int b = 0; b < 2; ++b)
#pragma unroll
            for (int m = 0; m < 4; ++m)
#pragma unroll
                for (int n = 0; n < 2; ++n) acc[a][b][m][n] = (f32x4){0.f, 0.f, 0.f, 0.f};
    bf16x8 At[4][2], B0[2][2], B1[2][2];
    const char* cA = (const char*)g.A + (size_t)(cur.pm & g.pm_mask) * tstep + kfirst; const char* cB = (const char*)g.Bt + (size_t)(cur.pn & g.pn_mask) * tstep + kfirst;
    S.a_ready(cur);
#if MK_KSR
    if constexpr (SP2) {
        PG8_STAGE(PG8_SB(0, 0), cB, voffB); PG8_STAGE(PG8_SB(0, 1), cB + hstep, voffB); PG8_STAGEA(PG8_SA(0, 0), cA, voffA); PG8_STAGEA(PG8_SA(0, 1), cA + hstep, voffA);
        if (wr == 1) { PG8_STAGE(PG8_SB(1, 0), cB + kstep, voffB); PG8_STAGE(PG8_SB(1, 1), cB + hstep + kstep, voffB); PG8_STAGEA(PG8_SA(1, 0), cA + kstep, voffA); PG8_STAGEA(PG8_SA(1, 1), cA + hstep + kstep, voffA); }
        PG8_WAIT_V(0); PG8_BAR;
        if (wr == 1) PG8_BAR;
    } else
#endif
#if MK_SP4
    if constexpr (SP2) {
        PG8_STAGE(PG8_SB(0, 0), cB, voffB); PG8_STAGE(PG8_SB(0, 1), cB + hstep, voffB); PG8_STAGEA(PG8_SA(0, 0), cA, voffA); PG8_STAGEA(PG8_SA(0, 1), cA + hstep, voffA);
        if (wr == 1) { PG8_STAGE(PG8_SB(1, 0), cB + kstep, voffB); PG8_STAGE(PG8_SB(1, 1), cB + hstep + kstep, voffB); PG8_STAGEA(PG8_SA(1, 0), cA + kstep, voffA); }
        PG8_WAIT_V(0); PG8_BAR;
        if (wr == 1) PG8_BAR;
    } else
#endif
    if constexpr (SP2) {
        PG8_STAGE(PG8_SB(0, 0), cB, voffB); PG8_STAGE(PG8_SB(0, 1), cB + hstep, voffB); PG8_STAGEA(PG8_SA(0, 0), cA, voffA); PG8_STAGEA(PG8_SA(0, 1), cA + hstep, voffA);
        pre();
        if (wr == 1) PG8_BAR;
        PG8_WAIT_V(2); PG8_BAR;
        PG8_STAGE(PG8_SB(1, 0), cB + kstep, voffB); PG8_STAGEA(PG8_SA(1, 0), cA + kstep, voffA); PG8_STAGE(PG8_SB(1, 1), cB + hstep + kstep, voffB);
        PG8_WAIT_V(6); PG8_BAR;
    } else {
        PG8_STAGE(PG8_SB(0, 0), cB, voffB); PG8_STAGEA(PG8_SA(0, 0), cA, voffA); PG8_STAGE(PG8_SB(0, 1), cB + hstep, voffB); PG8_STAGEA(PG8_SA(0, 1), cA + hstep, voffA);
        if (wr == 1) PG8_BAR;
        PG8_WAIT_V(4); PG8_BAR;
        PG8_STAGE(PG8_SB(1, 0), cB + kstep, voffB); PG8_STAGEA(PG8_SA(1, 0), cA + kstep, voffA); PG8_STAGE(PG8_SB(1, 1), cB + hstep + kstep, voffB);
        PG8_WAIT_V(6); PG8_BAR;
    }
    for (;;) {
        const bool has_next = S.next(ui + 1, nxt);
        const char* nA = has_next ? (const char*)g.A + (size_t)(nxt.pm & g.pm_mask) * tstep + kfirst : cA; const char* nB = has_next ? (const char*)g.Bt + (size_t)(nxt.pn & g.pn_mask) * tstep + kfirst : cB;
        for (int t = 0; t < nt; t += 2) {
            const bool last = (t == nt - 2);
            const char* a1 = cA + (ptrdiff_t)(t + 1) * kstep;
            const char* a2 = last ? nA : cA + (ptrdiff_t)(t + 2) * kstep; const char* b2 = last ? nB : cB + (ptrdiff_t)(t + 2) * kstep;
            const char* a3 = a2 + kstep; const char* b3 = b2 + kstep;
            if (last && has_next) S.a_ready(nxt);
            if constexpr (Epi::KHOOK && MK_HOOK_IN) { if (t > 0 && (t & 7) == 0) Epi::khook(acc, ui, t >> 3, wr); }
#if MK_KSR
            if constexpr (SP2) {
            const char* b1 = cB + (ptrdiff_t)(t + 1) * kstep;
#define PG8_DMA1(bufoff, gbase, voff, i_) do { unsigned vo_ = (voff)[i_]; asm volatile("" : "+v"(vo_)); \
        __builtin_amdgcn_global_load_lds((const unsigned*)((const char*)(gbase) + vo_), (PG8_LAS unsigned*)(lds + (bufoff) + ldsw + (i_) * 8192), 16, 0, 0); } while (0)
#define PG8_KDMA(j, b, pa, pb) do { if ((j) == 0) PG8_DMA1(PG8_SB(b, 0), pb, voffB, 0); else if ((j) == 1) PG8_DMA1(PG8_SB(b, 0), pb, voffB, 1); else if ((j) == 2) PG8_DMA1(PG8_SB(b, 1), (pb) + hstep, voffB, 0); else if ((j) == 3) PG8_DMA1(PG8_SB(b, 1), (pb) + hstep, voffB, 1); \
        else if ((j) == 4) PG8_DMA1(PG8_SA(b, 0), pa, voffA, 0); else if ((j) == 5) PG8_DMA1(PG8_SA(b, 0), pa, voffA, 1); else if ((j) == 6) PG8_DMA1(PG8_SA(b, 1), (pa) + hstep, voffA, 0); else PG8_DMA1(PG8_SA(b, 1), (pa) + hstep, voffA, 1); } while (0)
#define PG8_G8(b, pa, pb) do { _Pragma("unroll") for (int j_ = 0; j_ < 8; ++j_) PG8_KDMA(j_, b, pa, pb); } while (0)
#define PG8_KLD(b, k) do { _Pragma("unroll") for (int n = 0; n < 2; ++n) { B0[n][0] = *(const PG8_LAS bf16x8*)(lds + PG8_SB(b, 0) + PG8_BOFF(n, k)); B1[n][0] = *(const PG8_LAS bf16x8*)(lds + PG8_SB(b, 1) + PG8_BOFF(n, k)); } PG8_SCHED; \
        _Pragma("unroll") for (int m = 0; m < 4; ++m) { At[m][0] = *(const PG8_LAS bf16x8*)(lds + PG8_SA(b, 0) + PG8_AOFF(m, k)); At[m][1] = *(const PG8_LAS bf16x8*)(lds + PG8_SA(b, 1) + PG8_AOFF(m, k)); } } while (0)
#define PG8_KMMA(DMAT, b, pa, pb) do { __builtin_amdgcn_s_setprio(MK_PRIO); \
        _Pragma("unroll") for (int ai = 0; ai < 2; ++ai) _Pragma("unroll") for (int m = 0; m < 4; ++m) { _Pragma("unroll") for (int n = 0; n < 2; ++n) { \
            acc[ai][0][m][n] = __builtin_amdgcn_mfma_f32_16x16x32_bf16(B0[n][0], At[m][ai], acc[ai][0][m][n], 0, 0, 0); acc[ai][1][m][n] = __builtin_amdgcn_mfma_f32_16x16x32_bf16(B1[n][0], At[m][ai], acc[ai][1][m][n], 0, 0, 0); } \
            if (DMAT && MK_KSR_TDMA) { if (wr == 1) PG8_KDMA(ai * 4 + m, b, pa, pb); } PG8_SCHED; } \
        __builtin_amdgcn_s_setprio(0); } while (0)
            PG8_KLD(0, 0); PG8_SCHED; if (wr == 0) PG8_G8(1, a1, b1);
            PG8_WAIT_L(0); PG8_BAR; PG8_KMMA(0, 0, a2, b2); PG8_BAR; PG8_SCHED;
            PG8_KLD(0, 1); if (wr == 1) PG8_WAIT_V(0);
            PG8_WAIT_L(0); PG8_BAR; PG8_KMMA(1, 0, a2, b2); if (wr == 0) PG8_WAIT_V(0); PG8_BAR; PG8_SCHED;
            PG8_KLD(1, 0); PG8_SCHED; if (wr == 0) PG8_G8(0, a2, b2);
            PG8_WAIT_L(0); PG8_BAR; PG8_KMMA(0, 1, a3, b3); PG8_BAR; PG8_SCHED;
            PG8_KLD(1, 1); if (wr == 1) PG8_WAIT_V(0);
            PG8_WAIT_L(0); PG8_BAR; PG8_KMMA(1, 1, a3, b3); if (wr == 0) PG8_WAIT_V(0); PG8_BAR; PG8_SCHED;
#undef PG8_DMA1
#undef PG8_G8
#undef PG8_KDMA
#undef PG8_KLD
#undef PG8_KMMA
            } else
#endif
#if MK_SP4
            if constexpr (SP2) {
            const char* b1 = cB + (ptrdiff_t)(t + 1) * kstep;
#define PG8_DMA1(bufoff, gbase, voff, i_) do { unsigned vo_ = (voff)[i_]; asm volatile("" : "+v"(vo_));   \
        __builtin_amdgcn_global_load_lds((const unsigned*)((const char*)(gbase) + vo_), (PG8_LAS unsigned*)(lds + (bufoff) + ldsw + (i_) * 8192), 16, 0, 0); } while (0)
#define PG8_G6(b, pa, pb) do { PG8_STAGE(PG8_SB(b, 0), pb, voffB); PG8_STAGE(PG8_SB(b, 1), (pb) + hstep, voffB); PG8_STAGEA(PG8_SA(b, 0), pa, voffA); } while (0)
#define PG8_G2(b, pa) PG8_STAGEA(PG8_SA(b, 1), (pa) + hstep, voffA)
#define PG8_ROWDMA(r, bT, paT, pbT, bL, paL) do { if (wr == 1) { \
            if ((r) == 0) PG8_DMA1(PG8_SB(bT, 0), pbT, voffB, 0); else if ((r) == 1) PG8_DMA1(PG8_SB(bT, 0), pbT, voffB, 1); \
            else if ((r) == 2) PG8_DMA1(PG8_SB(bT, 1), (pbT) + hstep, voffB, 0); else if ((r) == 3) PG8_DMA1(PG8_SB(bT, 1), (pbT) + hstep, voffB, 1); \
            else if ((r) == 4) PG8_DMA1(PG8_SA(bT, 0), paT, voffA, 0); else if ((r) == 5) PG8_DMA1(PG8_SA(bT, 0), paT, voffA, 1); \
        } else { if ((r) == 0) PG8_DMA1(PG8_SA(bL, 1), (paL) + hstep, voffA, 0); else if ((r) == 1) PG8_DMA1(PG8_SA(bL, 1), (paL) + hstep, voffA, 1); } } while (0)
#define PG8_MMA_ROW(ai, m) do { _Pragma("unroll") for (int n = 0; n < 2; ++n) _Pragma("unroll") for (int k = 0; k < 2; ++k) { \
        acc[ai][0][m][n] = __builtin_amdgcn_mfma_f32_16x16x32_bf16(B0[n][k], At[m][k], acc[ai][0][m][n], 0, 0, 0); acc[ai][1][m][n] = __builtin_amdgcn_mfma_f32_16x16x32_bf16(B1[n][k], At[m][k], acc[ai][1][m][n], 0, 0, 0); } } while (0)
#define PG8_SEG_MMA(b, bT, paT, pbT, bL, paL) do { __builtin_amdgcn_s_setprio(MK_PRIO); \
        _Pragma("unroll") for (int m = 0; m < 4; ++m) { PG8_MMA_ROW(0, m); _Pragma("unroll") for (int k = 0; k < 2; ++k) At[m][k] = *(const PG8_LAS bf16x8*)(lds + PG8_SA(b, 1) + PG8_AOFF(m, k)); PG8_ROWDMA(m, bT, paT, pbT, bL, paL); PG8_SCHED; } \
        _Pragma("unroll") for (int m = 0; m < 4; ++m) { PG8_MMA_ROW(1, m); PG8_ROWDMA(4 + m, bT, paT, pbT, bL, paL); PG8_SCHED; } \
        __builtin_amdgcn_s_setprio(0); } while (0)
            PG8_LDB(B0, 0, 0); PG8_LDB(B1, 0, 1); PG8_SCHED; PG8_LDA(At, 0, 0); PG8_SCHED;
            if (wr == 0) { PG8_G6(1, a1, b1); PG8_WAIT_V(6); } else { PG8_G2(1, a1); PG8_WAIT_V(2); }
            PG8_WAIT_L(0); PG8_BAR;
            PG8_SEG_MMA(0, 0, a2, b2, 1, a1);
            if (wr == 0) PG8_WAIT_V(2); else PG8_WAIT_V(6);
            PG8_WAIT_L(0); PG8_BAR; PG8_SCHED;
            PG8_LDB(B0, 1, 0); PG8_LDB(B1, 1, 1); PG8_SCHED; PG8_LDA(At, 1, 0); PG8_SCHED;
            if (wr == 0) { PG8_G6(0, a2, b2); PG8_WAIT_V(6); } else { PG8_G2(0, a2); PG8_WAIT_V(2); }
            PG8_WAIT_L(0); PG8_BAR;
            PG8_SEG_MMA(1, 1, a3, b3, 0, a2);
            if (wr == 0) PG8_WAIT_V(2); else PG8_WAIT_V(6);
            PG8_WAIT_L(0); PG8_BAR; PG8_SCHED;
#undef PG8_DMA1
#undef PG8_G6
#undef PG8_G2
#undef PG8_ROWDMA
#undef PG8_MMA_ROW
#undef PG8_SEG_MMA
            } else
#endif
            if constexpr (SP2) {
            PG8_LDB(B0, 0, 0); PG8_LDB(B1, 0, 1); PG8_SCHED; PG8_LDA(At, 0, 0); PG8_STAGEA(PG8_SA(1, 1), a1 + hstep, voffA);
            PG8_WAIT_V(8); PG8_WAIT_L(0); PG8_BAR; if (MK_EARLY > 0) { PG8_MMA_PAIR_BAR(0, At, B0, B1); } else { PG8_MMA(0, 0, At, B0); PG8_MMA(0, 1, At, B1); PG8_BAR; } PG8_SCHED;
            PG8_LDA(At, 0, 1); PG8_STAGE(PG8_SB(0, 0), b2, voffB); PG8_STAGE(PG8_SB(0, 1), b2 + hstep, voffB); PG8_STAGEA(PG8_SA(0, 0), a2, voffA);
            PG8_WAIT_V(8); PG8_WAIT_L(0); PG8_BAR; if (MK_EARLY > 0) { PG8_MMA_PAIR_BAR(1, At, B0, B1); } else { PG8_MMA(1, 0, At, B0); PG8_MMA(1, 1, At, B1); PG8_BAR; } PG8_SCHED;
            PG8_LDB(B0, 1, 0); PG8_LDB(B1, 1, 1); PG8_SCHED; PG8_LDA(At, 1, 0); PG8_STAGEA(PG8_SA(0, 1), a2 + hstep, voffA);
            PG8_WAIT_V(8); PG8_WAIT_L(0); PG8_BAR; if (MK_EARLY > 0) { PG8_MMA_PAIR_BAR(0, At, B0, B1); } else { PG8_MMA(0, 0, At, B0); PG8_MMA(0, 1, At, B1); PG8_BAR; } PG8_SCHED;
            PG8_LDA(At, 1, 1); PG8_STAGE(PG8_SB(1, 0), b3, voffB); PG8_STAGE(PG8_SB(1, 1), b3 + hstep, voffB); PG8_STAGEA(PG8_SA(1, 0), a3, voffA);
            PG8_WAIT_V(8); PG8_WAIT_L(0); PG8_BAR; if (MK_EARLY > 0) { PG8_MMA_PAIR_BAR(1, At, B0, B1); } else { PG8_MMA(1, 0, At, B0); PG8_MMA(1, 1, At, B1); PG8_BAR; } PG8_SCHED;
            } else {
            PG8_LDB(B0, 0, 0); PG8_SCHED; PG8_LDA(At, 0, 0); PG8_STAGEA(PG8_SA(1, 1), a1 + hstep, voffA);
            PG8_WAIT_L(8); PG8_BAR; PG8_WAIT_L(0); PG8_MMA(0, 0, At, B0); PG8_BAR; PG8_SCHED;
            PG8_LDB(B1, 0, 1); PG8_STAGE(PG8_SB(0, 0), b2, voffB);
            PG8_BAR; PG8_WAIT_L(0); PG8_MMA(0, 1, At, B1); PG8_BAR;
            PG8_LDA(At, 0, 1); PG8_STAGEA(PG8_SA(0, 0), a2, voffA);
            PG8_BAR; PG8_WAIT_L(0); PG8_MMA(1, 0, At, B0); PG8_BAR; PG8_SCHED;
            PG8_STAGE(PG8_SB(0, 1), b2 + hstep, voffB);
            PG8_WAIT_V(6); PG8_BAR; PG8_MMA(1, 1, At, B1); PG8_BAR;
            PG8_LDB(B0, 1, 0); PG8_SCHED; PG8_LDA(At, 1, 0); PG8_STAGEA(PG8_SA(0, 1), a2 + hstep, voffA);
            PG8_WAIT_L(8); PG8_BAR; PG8_WAIT_L(0); PG8_MMA(0, 0, At, B0); PG8_BAR; PG8_SCHED;
            PG8_LDB(B1, 1, 1); PG8_STAGE(PG8_SB(1, 0), b3, voffB);
            PG8_BAR; PG8_WAIT_L(0); PG8_MMA(0, 1, At, B1); PG8_BAR;
            PG8_LDA(At, 1, 1); PG8_STAGEA(PG8_SA(1, 0), a3, voffA);
            PG8_BAR; PG8_WAIT_L(0); PG8_MMA(1, 0, At, B0); PG8_BAR; PG8_SCHED;
            PG8_STAGE(PG8_SB(1, 1), b3 + hstep, voffB);
            PG8_WAIT_V(6); PG8_BAR; PG8_MMA(1, 1, At, B1); PG8_BAR;
            }
        }
        if constexpr (Epi::KHOOK) Epi::khook(acc, ui, 4, wr);
        if constexpr (ALIGN_EPI) { if (wr == 0) PG8_BAR; }
        if constexpr (!Epi::AFTER_DRAIN) { const int ln2_ = stg_lane(); E(acc, cur, wr, wc, ln2_ & 15, ln2_ >> 4); S.done(cur); }
        if (!has_next) break;
#pragma unroll
        for (int a = 0; a < 2; ++a)
#pragma unroll
            for (int b = 0; b < 2; ++b)
#pragma unroll
                for (int m = 0; m < 4; ++m)
#pragma unroll
                    for (int n = 0; n < 2; ++n) acc[a][b][m][n] = (f32x4){0.f, 0.f, 0.f, 0.f};
        cur = nxt; cA = nA; cB = nB; ++ui;
        if constexpr (ALIGN_EPI) { if (wr == 1) PG8_BAR; }
    }
    PG8_WAIT_V(0);
    if constexpr (!ALIGN_EPI) { if (wr == 0) PG8_BAR; }
    PG8_BAR;
    if constexpr (Epi::AFTER_DRAIN) { E.fused(acc, cur, wr, wc, fr, fq, lds, wid, lane); S.done(cur); }
#undef PG8_AOFF
#undef PG8_BOFF
#undef PG8_SA
#undef PG8_SB
#undef PG8_STAGE
#undef PG8_STAGEA
#undef PG8_LDA
#undef PG8_LDB
#undef PG8_MMA
#undef PG8_WAIT_V
#undef PG8_WAIT_L
#undef PG8_BAR
#undef PG8_SCHED
}
template <class Epi, class Sched, bool ALIGN_EPI = true>
__device__ __forceinline__ void gemm_phase_ks(PG8_LAS unsigned char* lds, const Gemm g, const Sched& S, const Epi& E, const int tid_in) {
    int tid_l_ = tid_in; asm volatile("" : "+v"(tid_l_));
    const int tid = tid_l_, wid = __builtin_amdgcn_readfirstlane(tid >> 6), lane = tid & 63, wr = wid >> 2, wc = wid & 3, fr = lane & 15, fq = lane >> 4;
    const int K = g.K, nt = K / BK, ld = g.ld;
    unsigned voffA[2], voffB[2];
#pragma unroll
    for (int i = 0; i < 2; ++i) { const int b = tid * 16 + i * 8192, st = b >> 10, sb = b & 1023, swz = sb ^ (((sb >> 9) & 1) << 5); const int R = st * 16 + (swz >> 6), C = (swz & 63) >> 1;
        const int Rb = Epi::PERM ? ((R & ~31) + perm32(R & 31)) : R;
        voffA[i] = (unsigned)(R * ld + C) * 2u; voffB[i] = (unsigned)(Rb * ld + C) * 2u; }
    const ptrdiff_t kstep = (ptrdiff_t)(BK * 2);
    const size_t tstep = (size_t)BM * ld * 2;
    const unsigned ldsw = (unsigned)wid * 1024u;
    const int fsub = lds_byte(fr, fq * 8);
    const int aoff = (wr * 4) * 1024 + fsub, boff = (wc * 2) * 1024 + fsub;
#define KS_SLOT(b, kh, ab) (((((b) * 2 + (kh)) * 2) + (ab)) * 16384)
#define KS_STAGE1(slot, gbase, voff) do { _Pragma("unroll") for (int _i = 0; _i < 2; ++_i) \
        __builtin_amdgcn_global_load_lds((const unsigned*)((const char*)(gbase) + (voff)[_i]), (PG8_LAS unsigned*)(lds + (slot) + ldsw + _i * 8192), 16, 0, 0); } while (0)
#define KS_STAGE(b, kh, pa, pb) do { KS_STAGE1(KS_SLOT(b, kh, 1), (pb) + 64 * (kh), voffB); KS_STAGE1(KS_SLOT(b, kh, 0), (pa) + 64 * (kh), voffA); } while (0)
#define KS_LD(b, kh) do { _Pragma("unroll") for (int bj = 0; bj < 2; ++bj) _Pragma("unroll") for (int n = 0; n < 2; ++n) Bf[bj][n] = *(const PG8_LAS bf16x8*)(lds + KS_SLOT(b, kh, 1) + boff + (8 * bj + n) * 1024); \
        __builtin_amdgcn_sched_barrier(0); \
        _Pragma("unroll") for (int ai = 0; ai < 2; ++ai) _Pragma("unroll") for (int m = 0; m < 4; ++m) Af[ai][m] = *(const PG8_LAS bf16x8*)(lds + KS_SLOT(b, kh, 0) + aoff + (8 * ai + m) * 1024); } while (0)
#define KS_MMA() do { __builtin_amdgcn_s_setprio(MK_PRIO); _Pragma("unroll") for (int ai = 0; ai < 2; ++ai) _Pragma("unroll") for (int bj = 0; bj < 2; ++bj) _Pragma("unroll") for (int m = 0; m < 4; ++m) _Pragma("unroll") for (int n = 0; n < 2; ++n) \
        acc[ai][bj][m][n] = __builtin_amdgcn_mfma_f32_16x16x32_bf16(Bf[bj][n], Af[ai][m], acc[ai][bj][m][n], 0, 0, 0); __builtin_amdgcn_s_setprio(0); } while (0)
#define KS_WAIT_V(n) asm volatile("s_waitcnt vmcnt(" #n ")" ::: "memory")
#define KS_WAIT_L(n) asm volatile("s_waitcnt lgkmcnt(" #n ")" ::: "memory")
#define KS_BAR __builtin_amdgcn_s_barrier()
#define KS_SCHED __builtin_amdgcn_sched_barrier(0)
    Unit cur, nxt; int ui = 0;
    if (!S.next(0, cur)) return;
    f32x4 acc[2][2][4][2];
#pragma unroll
    for (int a = 0; a < 2; ++a)
#pragma unroll
        for (int b = 0; b < 2; ++b)
#pragma unroll
            for (int m = 0; m < 4; ++m)
#pragma unroll
                for (int n = 0; n < 2; ++n) acc[a][b][m][n] = (f32x4){0.f, 0.f, 0.f, 0.f};
    bf16x8 Af[2][4], Bf[2][2];
    const char* cA = (const char*)g.A + (size_t)(cur.pm & g.pm_mask) * tstep; const char* cB = (const char*)g.Bt + (size_t)(cur.pn & g.pn_mask) * tstep;
    S.a_ready(cur);
    KS_STAGE(0, 0, cA, cB); KS_STAGE(0, 1, cA, cB);
    if (wr == 1) KS_BAR;
    KS_WAIT_V(4); KS_BAR;
    KS_STAGE(1, 0, cA + kstep, cB + kstep);
    KS_WAIT_V(4); KS_BAR;
    for (;;) {
        const bool has_next = S.next(ui + 1, nxt);
        const char* nA = has_next ? (const char*)g.A + (size_t)(nxt.pm & g.pm_mask) * tstep : cA; const char* nB = has_next ? (const char*)g.Bt + (size_t)(nxt.pn & g.pn_mask) * tstep : cB;
        for (int t = 0; t < nt; t += 2) {
            const bool last = (t == nt - 2);
            const char* a1 = cA + (ptrdiff_t)(t + 1) * kstep; const char* b1 = cB + (ptrdiff_t)(t + 1) * kstep;
            const char* a2 = last ? nA : cA + (ptrdiff_t)(t + 2) * kstep; const char* b2 = last ? nB : cB + (ptrdiff_t)(t + 2) * kstep;
            const char* a3 = a2 + kstep; const char* b3 = b2 + kstep;
            if (last && has_next) S.a_ready(nxt);
            KS_LD(0, 0); KS_STAGE(1, 1, a1, b1);
            KS_WAIT_V(8); KS_WAIT_L(0); KS_BAR; KS_MMA(); KS_BAR; KS_SCHED;
            KS_LD(0, 1); KS_STAGE(0, 0, a2, b2);
            KS_WAIT_V(8); KS_WAIT_L(0); KS_BAR; KS_MMA(); KS_BAR; KS_SCHED;
            KS_LD(1, 0); KS_STAGE(0, 1, a2, b2);
            KS_WAIT_V(8); KS_WAIT_L(0); KS_BAR; KS_MMA(); KS_BAR; KS_SCHED;
            KS_LD(1, 1); KS_STAGE(1, 0, a3, b3);
            KS_WAIT_V(8); KS_WAIT_L(0); KS_BAR; KS_MMA(); KS_BAR; KS_SCHED;
        }
        if constexpr (ALIGN_EPI) { if (wr == 0) KS_BAR; }
        E(acc, cur, wr, wc, fr, fq); S.done(cur);
        if (!has_next) break;
#pragma unroll
        for (int a = 0; a < 2; ++a)
#pragma unroll
            for (int b = 0; b < 2; ++b)
#pragma unroll
                for (int m = 0; m < 4; ++m)
#pragma unroll
                    for (int n = 0; n < 2; ++n) acc[a][b][m][n] = (f32x4){0.f, 0.f, 0.f, 0.f};
        cur = nxt; cA = nA; cB = nB; ++ui;
        if constexpr (ALIGN_EPI) { if (wr == 1) KS_BAR; }
    }
    KS_WAIT_V(0);
    if constexpr (!ALIGN_EPI) { if (wr == 0) KS_BAR; }
    KS_BAR;
#undef KS_SLOT
#undef KS_STAGE1
#undef KS_STAGE
#undef KS_LD
#undef KS_MMA
#undef KS_WAIT_V
#undef KS_WAIT_L
#undef KS_BAR
#undef KS_SCHED
}
}

constexpr int NWAVES = 8;
constexpr int BATCH = 2, SEQ = 8192, M = BATCH * SEQ, D = 2048, FF = 5632, DEPTH = 4, PLE = 256;
constexpr int LDF = pg8::DFF;
constexpr int NUP = 2 * FF;
constexpr int GIN = 6160, NIN = 6144;
constexpr int NCHUNK = 128;
constexpr int NPH = 1 + 10 * DEPTH;

constexpr size_t MiB = 1u << 20;
constexpr size_t WS_CTL = 0, CTL_ZERO_BYTES = 1 * MiB;
constexpr size_t WS_WUP = 1 * MiB;
constexpr size_t WS_WDN = WS_WUP + 352 * MiB;
constexpr size_t WS_WGATE = WS_WDN + 184 * MiB;
constexpr size_t WS_WPLE = WS_WGATE + 32 * MiB;
constexpr size_t WS_WIN = WS_WPLE + 4 * MiB;
constexpr size_t WS_WGO = WS_WIN + 56 * MiB;
constexpr size_t WS_WKV = WS_WGO + 16 * MiB;
constexpr size_t WS_WQ = WS_WKV + 2 * MiB;
constexpr size_t WS_WSO = WS_WQ + 16 * MiB;
constexpr size_t WS_HB = WS_WSO + 16 * MiB;
constexpr size_t WS_SS = WS_HB + 128 * MiB;
constexpr size_t WS_PB = WS_SS + 4 * MiB;
constexpr size_t WS_PP = WS_PB + 32 * MiB;
constexpr size_t WS_KX = WS_PP + 64 * MiB;
constexpr size_t WS_VX = WS_KX + 8 * MiB;
constexpr size_t WS_SCR = WS_VX + 8 * MiB;
constexpr size_t WS_ACT = WS_SCR;
constexpr size_t WS_QB = WS_SCR, WS_KB = WS_SCR + 32 * MiB, WS_VB = WS_SCR + 64 * MiB, WS_RB = WS_SCR + 128 * MiB;
constexpr size_t WS_A1 = WS_SCR + 192 * MiB;
constexpr size_t WS_SO2 = WS_SCR + 208 * MiB;
constexpr size_t WS_WA1 = WS_CTL + 768 * 1024;
constexpr size_t WS_QD = WS_SCR + 256 * MiB, WS_KDT = WS_SCR + 288 * MiB, WS_AT = WS_SCR + 320 * MiB, WS_DEC = WS_SCR + 328 * MiB;
constexpr size_t WS_OB = WS_SCR + 336 * MiB;
constexpr size_t WS_OG = WS_SCR;
constexpr size_t WS_QN = WS_SCR, WS_AO = WS_SCR + 64 * MiB;
constexpr size_t WS_END = WS_SCR + 464 * MiB;
constexpr int CW_TMO = 0, CW_CODE = 1, CW_BAR = 4096;
constexpr size_t WS_BIAST = WS_CTL + 512 * 1024;

constexpr int RING_OFF = 0, RING_BYTES = 131072;
constexpr int LDSCTL_OFF = RING_BYTES, MISC_OFF = LDSCTL_OFF + 320;
constexpr int STG_OFF = pg8::STG_LDS_OFF; static_assert(STG_OFF == RING_BYTES + 2048, "staging tiles");
constexpr int HSC_OFF = STG_OFF + 8 * pg8::STG_BYTES; static_assert(HSC_OFF == pg8::HSC_LDS_OFF, "head-scale table");
constexpr int LDS_BYTES = HSC_OFF + 8192;

#define GAS __attribute__((address_space(1)))
#define LAS __attribute__((address_space(3)))
typedef unsigned short bf16;
typedef unsigned v4u __attribute__((ext_vector_type(4)));
typedef unsigned v2u __attribute__((ext_vector_type(2)));
typedef float f32x4 __attribute__((ext_vector_type(4)));
typedef short bf16x8 __attribute__((ext_vector_type(8)));
typedef GAS unsigned gu32;
#define RLX_AGENT __ATOMIC_RELAXED, __HIP_MEMORY_SCOPE_AGENT
#define LDS_WAIT() asm volatile("s_waitcnt lgkmcnt(0)" ::: "memory")
#define VM_WAIT() asm volatile("s_waitcnt vmcnt(0)" ::: "memory")
__device__ __forceinline__ unsigned pk2(float lo, float hi) { return pg8::cvt_pk_bf16(lo, hi); }
__device__ __forceinline__ float bf2f(unsigned short b) { return __uint_as_float((unsigned)b << 16); }
__device__ __forceinline__ unsigned short f2bf(float f) { return (unsigned short)(pg8::cvt_pk_bf16(f, 0.f) & 0xffffu); }
#define MFMA16(a, b, c) __builtin_amdgcn_mfma_f32_16x16x32_bf16((a), (b), (c), 0, 0, 0)

#define XB_TMO      128
#define XB_XCNT(j)  (256  + 64 * (j))
#define XB_XSUB(j)  (1280 + 64 * (j))
#define XB_XGEN(j)  (2304 + 64 * (j))
#define XB_TOP      3328
#define XB_TOPGEN   3392
#define XCD_BAR_WORDS 3456
#define XB_SPIN_CAP (1u << 18)

__device__ __forceinline__ unsigned xb_ld(unsigned* p)              { return __hip_atomic_load(p, __ATOMIC_RELAXED, __HIP_MEMORY_SCOPE_AGENT); }
__device__ __forceinline__ unsigned xb_add(unsigned* p, unsigned v) { return __hip_atomic_fetch_add(p, v, __ATOMIC_RELAXED, __HIP_MEMORY_SCOPE_AGENT); }
__device__ __forceinline__ unsigned xb_xcc_id() { return (unsigned)__builtin_amdgcn_s_getreg((3 << 11) | 20) & 0xFu; }
#define XB_SPIN(cond, bar) do { unsigned _sp = 0; while (cond) { __builtin_amdgcn_s_sleep(1); \
    if ((++_sp & 255u) == 0u) { if (xb_ld(&(bar)[XB_TMO])) break; if (_sp > XB_SPIN_CAP) { atomicAdd(&(bar)[XB_TMO], 1u); break; } } } } while (0)

struct XcdBarrier {
    bool lead;
    unsigned* bar; unsigned x;
    volatile LAS unsigned* st;
};

__device__ __forceinline__ XcdBarrier xcd_barrier_post(unsigned* bar, volatile LAS unsigned* st, bool lead) {
    XcdBarrier b; b.bar = bar; b.x = xb_xcc_id(); b.st = st; b.lead = lead;
    if (lead) (void)xb_add(&bar[XB_XCNT(b.x)], 1u);
    return b;
}
__device__ __forceinline__ void xcd_barrier_complete(unsigned* bar, unsigned x, unsigned& nloc, unsigned& nx) {
    const unsigned G = gridDim.x * gridDim.y * gridDim.z;
    unsigned sum, cnt, mine, sp = 0u;
    for (;;) {
        sum = 0u; cnt = 0u; mine = 0u;
#pragma unroll
        for (unsigned j = 0; j < 16; ++j) { const unsigned c = xb_ld(&bar[XB_XCNT(j)]); sum += c; cnt += (c > 0u) ? 1u : 0u; mine = (j == x) ? c : mine; }
        if (sum == G) break;
        __builtin_amdgcn_s_sleep(1);
        if ((++sp & 255u) == 0u) { if (xb_ld(&bar[XB_TMO])) break; if (sp > XB_SPIN_CAP) { atomicAdd(&bar[XB_TMO], 1u); break; } }
    }
    nloc = mine > 0u ? mine : 1u; nx = cnt > 0u ? cnt : 1u;
}

__device__ __forceinline__ void xcd_barrier(const XcdBarrier& b) {
    asm volatile("s_waitcnt vmcnt(0)" ::: "memory");
    __syncthreads();
    if (b.lead) {
        unsigned* bar = b.bar;
        __builtin_amdgcn_s_waitcnt(0);
        unsigned nloc = b.st[0], nx = b.st[1];
        if (nloc == 0u) { xcd_barrier_complete(bar, b.x, nloc, nx); b.st[0] = nloc; b.st[1] = nx; }
        const unsigned old = xb_add(&bar[XB_XSUB(b.x)], 1u);
        const unsigned gen = old / nloc;
        if (old + 1u == (gen + 1u) * nloc) {
            __builtin_amdgcn_fence(__ATOMIC_RELEASE, "agent");
            asm volatile("s_waitcnt vmcnt(0)" ::: "memory");
            const unsigned og = xb_add(&bar[XB_TOP], 1u);
            const unsigned tg = og / nx;
            if (og + 1u == (tg + 1u) * nx) xb_add(&bar[XB_TOPGEN], 1u);
            else XB_SPIN(xb_ld(&bar[XB_TOPGEN]) == tg, bar);
            __builtin_amdgcn_fence(__ATOMIC_ACQUIRE, "agent");
            xb_add(&bar[XB_XGEN(b.x)], 1u);
            asm volatile("s_waitcnt vmcnt(0)" ::: "memory");
        } else {
            XB_SPIN(xb_ld(&bar[XB_XGEN(b.x)]) == gen, bar);
            __builtin_amdgcn_fence(__ATOMIC_ACQUIRE, "agent");
            asm volatile("s_waitcnt vmcnt(0)" ::: "memory");
        }
    }
    __syncthreads();
}

struct Frame {
    LAS unsigned char* lds;
    volatile LAS unsigned* MISC;
    gu32* ctl;
    int tid, lane, wave;
    int vcu, G;
};
#define LDS_BAR() do { asm volatile("s_waitcnt lgkmcnt(0)" ::: "memory"); __builtin_amdgcn_s_barrier(); asm volatile("" ::: "memory"); } while (0)
__device__ __forceinline__ float wave_sum(float v) {
#pragma unroll
    for (int o = 1; o < 64; o <<= 1) v += __shfl_xor(v, o);
    return v;
}

#ifndef MK_W_NT
#define MK_W_NT 1
#endif
#ifndef MK_W_NTST
#define MK_W_NTST 1
#endif
#if MK_W_NT
#define MK_WLOAD(p) __builtin_nontemporal_load(p)
#else
#define MK_WLOAD(p) (*(p))
#endif
__device__ __forceinline__ int t5_bucket(int d) { if (d < 16) return d; const int l = 16 + (int)(logf((float)d / 16.0f) / logf(8.0f) * 16.0f); return l < 31 ? l : 31; }
__device__ __forceinline__ void p0_store_item(LAS float* scr, bf16* WT, int K, int k0, int dst_row0, int lane) {
    LDS_WAIT(); asm volatile("" ::: "memory");
    const int c = lane & 7;
#pragma unroll
    for (int j = 0; j < 4; ++j) { const int n = (lane >> 3) + 8 * j; const LAS float* s = scr + (8 * c) * 33 + n;
        v4u o; o.x = pk2(s[0 * 33], s[1 * 33]); o.y = pk2(s[2 * 33], s[3 * 33]); o.z = pk2(s[4 * 33], s[5 * 33]); o.w = pk2(s[6 * 33], s[7 * 33]);
#if MK_W_NTST
        __builtin_nontemporal_store(o, (GAS v4u*)(WT + (size_t)(dst_row0 + n) * K + k0 + 8 * c)); }
#else
        *(GAS v4u*)(WT + (size_t)(dst_row0 + n) * K + k0 + 8 * c) = o; }
#endif
    LDS_WAIT(); asm volatile("" ::: "memory");
}
__device__ __forceinline__ void p0_item(const float* W, int N, int n0, int k0, const float* gain, int gmask, bf16* WT, int K, int dst_row0, LAS float* scr, int lane) {
    float v[32];
#pragma unroll
    for (int i = 0; i < 32; ++i) { const int k = k0 + 2 * i + (lane >> 5); v[i] = MK_WLOAD(W + (size_t)k * N + n0 + (lane & 31)); }
    if (gain) {
#pragma unroll
        for (int i = 0; i < 32; ++i) { const int k = k0 + 2 * i + (lane >> 5); v[i] *= gain[k & gmask]; } }
#pragma unroll
    for (int i = 0; i < 32; ++i) scr[(2 * i + (lane >> 5)) * 33 + (lane & 31)] = v[i];
    p0_store_item(scr, WT, K, k0, dst_row0, lane);
}
struct In { const float *x, *p, *norm_g, *ffn_wg, *ffn_wu, *ffn_wd, *ple_w, *ple_gate_w, *gla_w_in, *gla_w_a2, *gla_b_a, *gla_norm_g, *gla_w_o, *kv_norm_g, *w_kv, *k_norm_g, *rel_bias, *swa_w_q, *q_norm_g, *sinks, *swa_w_o; };

__device__ __forceinline__ void p0_prologue(Frame& F, const In& I, unsigned char* ws) {
    LAS float* scr = (LAS float*)(F.lds + RING_OFF + F.wave * 16384);
    const int gw = F.vcu * NWAVES + F.wave, NGW = F.G * NWAVES, lane = F.lane;
    constexpr int IT_UP = 32 * 176, IT_DN = 88 * 64, IT_SQ = 32 * 64, IT_PLE = 4 * 64, IT_IN = 32 * 192, IT_GF = 0, IT_KV = 32 * 16;
    constexpr int C1 = 8 * IT_UP, C2 = C1 + 8 * IT_UP, C3 = C2 + 8 * IT_DN, C4 = C3 + 4 * IT_SQ, C5 = C4 + 4 * IT_PLE, C6 = C5 + 2 * IT_IN, C7 = C6 + 2 * IT_GF, C8 = C7 + 2 * IT_SQ, C9 = C8 + IT_KV, C10 = C9 + 2 * IT_SQ, C11 = C10 + 2 * IT_SQ;
    for (int it = gw; it < C11; it += NGW) {
        int r = it;
        if (r < C2) {
            const int isu = r >= C1; if (isu) r -= C1;
            const int j = r / IT_UP, q = r % IT_UP, kb = q / 176, nb = q % 176, n0 = 32 * nb, L = j >> 1, f = j & 1;
            const float* W = (isu ? I.ffn_wu : I.ffn_wg) + (size_t)j * D * FF;
            p0_item(W, FF, n0, 64 * kb, I.norm_g + (L * 4 + 2 * f) * D, 0x7fffffff, (bf16*)(ws + WS_WUP) + (size_t)j * NUP * D, D, (n0 >> 7) * 256 + (n0 & 127) + 128 * isu, scr, lane);
            continue; }
        r -= C2;
        if (r < 8 * IT_DN) { const int j = r / IT_DN, q = r % IT_DN, kb = q / 64, nb = q % 64;
            p0_item(I.ffn_wd + (size_t)j * FF * D, D, 32 * nb, 64 * kb, nullptr, 0, (bf16*)(ws + WS_WDN) + (size_t)j * D * LDF, LDF, 32 * nb, scr, lane); continue; }
        r -= 8 * IT_DN;
        if (r < 4 * IT_SQ) { const int j = r / IT_SQ, q = r % IT_SQ, kb = q / 64, nb = q % 64;
            p0_item(I.ple_gate_w + (size_t)j * D * D, D, 32 * nb, 64 * kb, I.norm_g + (j * 4 + 3) * D, 0x7fffffff, (bf16*)(ws + WS_WGATE) + (size_t)j * D * D, D, 32 * nb, scr, lane); continue; }
        r -= 4 * IT_SQ;
        if (r < 4 * IT_PLE) { const int j = r / IT_PLE, q = r % IT_PLE, kb = q / 64, nb = q % 64;
            p0_item(I.ple_w + (size_t)j * PLE * D, D, 32 * nb, 64 * kb, nullptr, 0, (bf16*)(ws + WS_WPLE) + (size_t)j * D * PLE, PLE, 32 * nb, scr, lane); continue; }
        r -= 4 * IT_PLE;
        if (r < 2 * IT_IN) { const int j = r / IT_IN, q = r % IT_IN, kb = q / 192, nb = q % 192;
            p0_item(I.gla_w_in + (size_t)j * D * GIN, GIN, 32 * nb, 64 * kb, I.norm_g + (j * 4 + 1) * D, 0x7fffffff, (bf16*)(ws + WS_WIN) + (size_t)j * NIN * D, D, 32 * nb, scr, lane); continue; }
        r -= 2 * IT_IN;
        r -= 2 * IT_GF;
        if (r < 2 * IT_SQ) { const int j = r / IT_SQ, q = r % IT_SQ, kb = q / 64, nb = q % 64;
            p0_item(I.gla_w_o + (size_t)j * D * D, D, 32 * nb, 64 * kb, I.gla_norm_g + j * 512, 511, (bf16*)(ws + WS_WGO) + (size_t)j * D * D, D, 32 * nb, scr, lane); continue; }
        r -= 2 * IT_SQ;
        if (r < IT_KV) { const int kb = r / 16, nb = r % 16, n0 = 32 * nb;
            p0_item(I.w_kv, 512, n0, 64 * kb, I.kv_norm_g, 0x7fffffff, (bf16*)(ws + WS_WKV), D, (n0 & ~255) + 128 * ((n0 >> 5) & 1) + 32 * ((n0 >> 6) & 3), scr, lane); continue; }
        r -= IT_KV;
        if (r < 2 * IT_SQ) { const int j = r / IT_SQ, q = r % IT_SQ, kb = q / 64, nb = q % 64, n0 = 32 * nb;
            p0_item(I.swa_w_q + (size_t)j * D * D, D, n0, 64 * kb, I.norm_g + ((2 + j) * 4 + 1) * D, 0x7fffffff, (bf16*)(ws + WS_WQ) + (size_t)j * D * D, D, (n0 & ~255) + 128 * ((n0 >> 5) & 1) + 32 * ((n0 >> 6) & 3), scr, lane); continue; }
        r -= 2 * IT_SQ;
        { const int j = r / IT_SQ, q = r % IT_SQ, kb = q / 64, nb = q % 64;
            p0_item(I.swa_w_o + (size_t)j * D * D, D, 32 * nb, 64 * kb, nullptr, 0, (bf16*)(ws + WS_WSO) + (size_t)j * D * D, D, 32 * nb, scr, lane); }
    }
    { bf16* wa = (bf16*)(ws + WS_WA1); for (int t = (F.vcu * NWAVES + F.wave) * 64 + lane; t < 2 * 16 * D; t += F.G * NWAVES * 64) { const int j = t >> 15, r = (t >> 11) & 15, k = t & 2047;
        wa[t] = f2bf(I.norm_g[(j * 4 + 1) * D + k] * I.gla_w_in[(size_t)j * D * GIN + (size_t)k * GIN + 6144 + r]); } }
    { float* bt = (float*)(ws + WS_BIAST); const int t = (F.vcu * NWAVES + F.wave) * 64 + lane; if (t < 32 * 128) { const int hqh = t >> 7, dist = t & 127; bt[t] = I.rel_bias[t5_bucket(dist) * 32 + hqh]; } }
    { const size_t n8 = (size_t)DEPTH * M * PLE / 8; GAS v4u* o = (GAS v4u*)(ws + WS_PB);
        for (size_t i = (size_t)gw * 64 + lane; i < n8; i += (size_t)NGW * 64) { const f32x4 a = ((const GAS f32x4*)I.p)[2 * i], b = ((const GAS f32x4*)I.p)[2 * i + 1];
            v4u w; w.x = pk2(a[0], a[1]); w.y = pk2(a[2], a[3]); w.z = pk2(b[0], b[1]); w.w = pk2(b[2], b[3]); o[i] = w; } }
    { bf16* hb0 = (bf16*)(ws + WS_HB); float* ss0 = (float*)(ws + WS_SS);
        for (int m = gw; m < M; m += NGW) { const GAS f32x4* xr = (const GAS f32x4*)(I.x + (size_t)m * D); float s = 0.f;
#pragma unroll
            for (int j = 0; j < 4; ++j) { const f32x4 a = xr[128 * j + 2 * lane], b = xr[128 * j + 2 * lane + 1]; s += pg8::dot4(a) + pg8::dot4(b);
                v4u w; w.x = pk2(a[0], a[1]); w.y = pk2(a[2], a[3]); w.z = pk2(b[0], b[1]); w.w = pk2(b[2], b[3]); *(GAS v4u*)(hb0 + (size_t)m * D + 512 * j + 8 * lane) = w; }
            s = wave_sum(s);
            if (lane < 32) ss0[(size_t)m * 32 + lane] = (lane == 0) ? s : 0.f; } }
}

typedef float f32x2v __attribute__((ext_vector_type(2)));
__device__ __forceinline__ void gla_a1(Frame& F, const bf16* hb, const float* ss, const bf16* wa, float* a1) {
    LAS bf16* WA = (LAS bf16*)(F.lds);
    const int tid = F.tid, lane = F.lane, r16 = lane & 15, quad = lane >> 4;
#pragma unroll
    for (int e = 0; e < 8; ++e) { const int d = tid + 512 * e, row = d >> 8, ch = d & 255; *(LAS v4u*)(WA + row * 2056 + ch * 8) = *(const GAS v4u*)(wa + row * 2048 + ch * 8); }
    __syncthreads();
    for (int rt = F.vcu + F.G * F.wave; rt < M / 16; rt += F.G * NWAVES) {
        const bf16* ap = hb + (size_t)(16 * rt + r16) * D + 8 * quad; const LAS bf16* bp = WA + r16 * 2056 + 8 * quad;
        f32x4 c0 = {0.f, 0.f, 0.f, 0.f}, c1 = c0, c2 = c0, c3 = c0;
#pragma unroll 8
        for (int ks = 0; ks < 64; ks += 4) {
            c0 = MFMA16(*(const GAS bf16x8*)(ap + 32 * ks), *(const LAS bf16x8*)(bp + 32 * ks), c0);
            c1 = MFMA16(*(const GAS bf16x8*)(ap + 32 * ks + 32), *(const LAS bf16x8*)(bp + 32 * ks + 32), c1);
            c2 = MFMA16(*(const GAS bf16x8*)(ap + 32 * ks + 64), *(const LAS bf16x8*)(bp + 32 * ks + 64), c2);
            c3 = MFMA16(*(const GAS bf16x8*)(ap + 32 * ks + 96), *(const LAS bf16x8*)(bp + 32 * ks + 96), c3); }
        const f32x4 acc = (c0 + c1) + (c2 + c3);
        const GAS f32x4* sp = (const GAS f32x4*)(ss + (size_t)(16 * rt + r16) * 32 + 8 * quad); const f32x4 sa = sp[0], sb = sp[1];
        float s = ((sa[0] + sa[1]) + (sa[2] + sa[3])) + ((sb[0] + sb[1]) + (sb[2] + sb[3]));
        s += __shfl_xor(s, 16); s += __shfl_xor(s, 32);
        const float rstd = 1.0f / sqrtf(s * (1.0f / (float)D) + pg8::RMS_EPS);
#pragma unroll
        for (int j = 0; j < 4; ++j) { const float rj = __shfl(rstd, 4 * quad + j); a1[(size_t)(16 * rt + 4 * quad + j) * 16 + r16] = acc[j] * rj; }
    }
    __syncthreads();
}
struct G1Regs { unsigned q[16], k[16]; };
__device__ __forceinline__ void g1_load(G1Regs& R, int u, const bf16* qb, const bf16* kb, int c2, int tq) {
    const int bh = u >> 7, n = u & 127, b = bh >> 2, h = bh & 3;
    const size_t row0 = (size_t)b * SEQ + 64 * n + 16 * tq; const int cc = h * 256 + 2 * c2;
#pragma unroll
    for (int i = 0; i < 16; ++i) { R.q[i] = *(const GAS unsigned*)(qb + (row0 + i) * 1024 + cc); R.k[i] = *(const GAS unsigned*)(kb + (row0 + i) * 1024 + cc); }
}
__device__ __forceinline__ void g1_stage_a1(LAS float* dst, int u, const float* a1, int tid) {
    if (tid < 256) { const int bh = u >> 7, n = u & 127, b = bh >> 2; *(LAS f32x4*)(dst + 4 * tid) = *(const GAS f32x4*)(a1 + ((size_t)b * SEQ + 64 * n) * 16 + 4 * tid); }
}
template <int VAR = 0  > __device__ __forceinline__ void gla_g1(Frame& F, const bf16* qb, const bf16* kb, const float* a1, const float* w2, const float* b_a, bf16* qd, bf16* kdT, bf16* at, float* dec) {
    LAS bf16* QD = (LAS bf16*)(F.lds);
    LAS bf16* KI = (LAS bf16*)(F.lds + 33792);
    LAS bf16* KT = (LAS bf16*)(F.lds + 67584);
    LAS f32x2v* TOT = (LAS f32x2v*)(F.lds + 104448);
    LAS float* A1S = (LAS float*)(F.lds + 108544);
    LAS bf16* ATS = (LAS bf16*)(F.lds + 116736);
    const int tid = F.tid, c2 = tid & 127, tq = tid >> 7, lane = F.lane, w = F.wave, r16 = lane & 15, quad = lane >> 4;
    const int per = (1024 + F.G - 1) / F.G;
    G1Regs R; const int u0 = F.vcu * per;
    if (u0 < 1024) { g1_load(R, u0, qb, kb, c2, tq); g1_stage_a1(A1S, u0, a1, tid); }
    LDS_BAR();
    int cur_h = -1; float w2x[16], w2y[16]; float bax = 0.f, bay = 0.f;
    for (int i0 = 0; i0 < per; ++i0) {
        const int u = u0 + i0; if (u >= 1024) break;
        const int h = (u >> 7) & 3;
        if (h != cur_h) { cur_h = h;
#pragma unroll
            for (int r = 0; r < 16; ++r) { const f32x2v t = *(const GAS f32x2v*)(w2 + r * 1024 + h * 256 + 2 * c2); w2x[r] = t.x; w2y[r] = t.y; }
            const f32x2v t = *(const GAS f32x2v*)(b_a + h * 256 + 2 * c2); bax = t.x; bay = t.y; }
        const LAS float* as = A1S + (i0 & 1) * 1024 + (16 * tq) * 16;
        f32x2v bs[16];
        { f32x2v run = {0.f, 0.f};
#pragma unroll
            for (int i = 0; i < 16; ++i) { const f32x4 a0 = *(const LAS f32x4*)(as + 16 * i), a1v = *(const LAS f32x4*)(as + 16 * i + 4), a2 = *(const LAS f32x4*)(as + 16 * i + 8), a3 = *(const LAS f32x4*)(as + 16 * i + 12);
                float zx = bax, zy = bay;
#pragma unroll
                for (int r = 0; r < 4; ++r) { zx += a0[r] * w2x[r] + a1v[r] * w2x[4 + r] + a2[r] * w2x[8 + r] + a3[r] * w2x[12 + r]; zy += a0[r] * w2y[r] + a1v[r] * w2y[4 + r] + a2[r] * w2y[8 + r] + a3[r] * w2y[12 + r]; }
                run.x += (fminf(zx, 0.f) - __logf(1.0f + __expf(-fabsf(zx)))) * 0.0625f; run.y += (fminf(zy, 0.f) - __logf(1.0f + __expf(-fabsf(zy)))) * 0.0625f; bs[i] = run; } }
        unsigned qv[16], kv[16];
#pragma unroll
        for (int i = 0; i < 16; ++i) { qv[i] = R.q[i]; kv[i] = R.k[i]; }
        TOT[tq * 128 + c2] = bs[15];
        const bool nxt_ = (i0 + 1 < per && u + 1 < 1024); f32x4 a1n = {0.f, 0.f, 0.f, 0.f};
        if (nxt_) { if (tid < 256) { const int un = u + 1, bhn = un >> 7, nn = un & 127, bn = bhn >> 2; a1n = *(const GAS f32x4*)(a1 + ((size_t)bn * SEQ + 64 * nn) * 16 + 4 * tid); }
            g1_load(R, u + 1, qb, kb, c2, tq); }
        LDS_BAR();
        f32x2v pre = {0.f, 0.f}, tot = {0.f, 0.f};
#pragma unroll
        for (int t = 0; t < 4; ++t) { const f32x2v v = TOT[t * 128 + c2]; if (t < tq) { pre.x += v.x; pre.y += v.y; } tot.x += v.x; tot.y += v.y; }
        float kdx[16], kdy[16];
#pragma unroll
        for (int i = 0; i < 16; ++i) { const float bx = bs[i].x + pre.x, by = bs[i].y + pre.y;
            const float qx = __uint_as_float(qv[i] << 16), qy = __uint_as_float(qv[i] & 0xffff0000u), kx_ = __uint_as_float(kv[i] << 16), ky_ = __uint_as_float(kv[i] & 0xffff0000u);
            *(LAS unsigned*)(QD + (16 * tq + i) * 264 + 2 * c2) = pk2(qx * __expf(bx), qy * __expf(by));
            *(LAS unsigned*)(KI + (16 * tq + i) * 264 + 2 * c2) = pk2(kx_ * __expf(-bx), ky_ * __expf(-by));
            kdx[i] = kx_ * __expf(tot.x - bx); kdy[i] = ky_ * __expf(tot.y - by); }
#pragma unroll
        for (int e = 0; e < 2; ++e) { v4u wx, wy;
            wx.x = pk2(kdx[8 * e], kdx[8 * e + 1]); wx.y = pk2(kdx[8 * e + 2], kdx[8 * e + 3]); wx.z = pk2(kdx[8 * e + 4], kdx[8 * e + 5]); wx.w = pk2(kdx[8 * e + 6], kdx[8 * e + 7]);
            wy.x = pk2(kdy[8 * e], kdy[8 * e + 1]); wy.y = pk2(kdy[8 * e + 2], kdy[8 * e + 3]); wy.z = pk2(kdy[8 * e + 4], kdy[8 * e + 5]); wy.w = pk2(kdy[8 * e + 6], kdy[8 * e + 7]);
            *(LAS v4u*)(KT + (2 * c2) * 72 + 16 * tq + 8 * e) = wx; *(LAS v4u*)(KT + (2 * c2 + 1) * 72 + 16 * tq + 8 * e) = wy; }
        if (tq == 0) *(GAS f32x2v*)(dec + (size_t)u * 256 + 2 * c2) = (f32x2v){__expf(tot.x), __expf(tot.y)};
        LDS_BAR();
        if (VAR != 1) { const int ti = w >> 1;
#pragma unroll
            for (int tt = 0; tt < 2; ++tt) { const int tj = (w & 1) * 2 + tt; f32x4 a4 = {0.f, 0.f, 0.f, 0.f};
                if (tj <= ti) {
#pragma unroll
                    for (int ks = 0; ks < 8; ++ks) { const bf16x8 A = *(const LAS bf16x8*)(QD + (16 * ti + r16) * 264 + 32 * ks + 8 * quad), B = *(const LAS bf16x8*)(KI + (16 * tj + r16) * 264 + 32 * ks + 8 * quad); a4 = MFMA16(A, B, a4); } }
#pragma unroll
                for (int j = 0; j < 4; ++j) { const int ii = 16 * ti + 4 * quad + j, jj = 16 * tj + r16; ATS[(((ii >> 4) * 2 + (jj >> 5)) * 64 + ((jj & 31) >> 3) * 16 + (ii & 15)) * 8 + (jj & 7)] = f2bf(jj <= ii ? a4[j] : 0.f); } } }
        if (VAR != 1 && VAR != 3)
#pragma unroll
        for (int e = 0; e < 4; ++e) { const int d = tid + 512 * e, blk = d >> 6, ln = d & 63, row = 16 * (blk >> 3) + (ln & 15), ch = 4 * (blk & 7) + (ln >> 4);
            *(GAS v4u*)(qd + (size_t)u * 16384 + d * 8) = *(const LAS v4u*)(QD + row * 264 + ch * 8); }
        if (VAR != 1 && VAR != 3)
#pragma unroll
        for (int e = 0; e < 4; ++e) { const int d = tid + 512 * e, blk = d >> 6, ln = d & 63, row = 16 * (blk >> 1) + (ln & 15), ch = 4 * (blk & 1) + (ln >> 4);
            *(GAS v4u*)(kdT + (size_t)u * 16384 + d * 8) = *(const LAS v4u*)(KT + row * 72 + ch * 8); }
        if (nxt_ && tid < 256) *(LAS f32x4*)(A1S + ((i0 + 1) & 1) * 1024 + 4 * tid) = a1n;
        LDS_BAR();
        if (VAR != 1 && VAR != 2) *(GAS v4u*)(at + (size_t)u * 4096 + tid * 8) = *(const LAS v4u*)(ATS + tid * 8);
        LDS_BAR();
    }
}
struct ScanBig { bf16x8 q[4]; bf16x8 k0[2], k1[2]; v4u v; };
struct ScanSmall { bf16x8 a; f32x4 d0, d1; };
struct ScanOff { unsigned q, a, k, d, v; };
__device__ __forceinline__ void scan_load_big_kv(ScanBig& R, int n, int bh, const bf16* kdT, const bf16* vrow, const ScanOff& O, int tid) {
    const size_t u = (size_t)(bh * NCHUNK + n);
    if (tid >= 256 && tid < 384) R.v = *(const GAS v4u*)((const GAS char*)vrow + (size_t)n * (64 * 4096) + O.v);
    const GAS char* kp = (const GAS char*)kdT + u * 32768 + O.k;
#pragma unroll
    for (int ks = 0; ks < 2; ++ks) { R.k0[ks] = *(const GAS bf16x8*)(kp + 1024 * ks); R.k1[ks] = *(const GAS bf16x8*)(kp + 2048 + 1024 * ks); }
}
__device__ __forceinline__ void scan_load_big_q(ScanBig& R, int n, int bh, const bf16* qd, const ScanOff& O) {
    const size_t u = (size_t)(bh * NCHUNK + n);
    const GAS char* qp = (const GAS char*)qd + u * 32768 + O.q;
#pragma unroll
    for (int ks = 0; ks < 4; ++ks) R.q[ks] = *(const GAS bf16x8*)(qp + 1024 * ks);
}
__device__ __forceinline__ void scan_load_big(ScanBig& R, int n, int bh, const bf16* qd, const bf16* kdT, const bf16* vrow, const ScanOff& O, int tid) {
    scan_load_big_kv(R, n, bh, kdT, vrow, O, tid); scan_load_big_q(R, n, bh, qd, O);
}
__device__ __forceinline__ void scan_load_small(ScanSmall& R, int n, int bh, const bf16* at, const float* dec, const bf16* vrow, const ScanOff& O, int tid) {
    const size_t u = (size_t)(bh * NCHUNK + n);
    R.a = *(const GAS bf16x8*)((const GAS char*)at + u * 8192 + O.a);
    const GAS char* dp = (const GAS char*)dec + u * 1024 + O.d;
    R.d0 = *(const GAS f32x4*)dp; R.d1 = *(const GAS f32x4*)(dp + 64);
}
template <int VAR = 0  > __device__ __forceinline__ void gla_scan(Frame& F, const bf16* qd, const bf16* kdT, const bf16* at, const float* dec, const bf16* vb, bf16* ob) {
    LAS bf16* ST = (LAS bf16*)(F.lds);
    LAS bf16* VT = (LAS bf16*)(F.lds + 16896);
    LAS f32x4* OP = (LAS f32x4*)(F.lds + 21504);
    const int tid = F.tid, lane = F.lane, w = F.wave, r16 = lane & 15, quad = lane >> 4, rt = w & 3, kh = w >> 2;
#define SCAN_BAR() do { asm volatile("s_waitcnt lgkmcnt(0)" ::: "memory"); __builtin_amdgcn_s_barrier(); asm volatile("" ::: "memory"); } while (0)
#ifdef PROBE_SCANHALF
    for (int item = F.vcu; item < ((F.vcu & 1) ? 0 : F.vcu + 2); ++item) {
#else
    for (int item = F.vcu; item < 256; item += F.G) {
#endif
        const int bh = item >> 5, sl = item & 31, b = bh >> 2, h = bh & 3;
        const size_t tok0 = (size_t)b * SEQ; const int vcol = h * 512 + 16 * sl;
        const bf16* vrow = vb + tok0 * 2048 + vcol; bf16* ob_item = ob + tok0 * 2048 + vcol; const unsigned ooff = (unsigned)(((16 * rt + 4 * quad) * 2048 + r16) * 2);
        f32x4 S0 = {0.f, 0.f, 0.f, 0.f}, S1 = {0.f, 0.f, 0.f, 0.f}, oprev = {0.f, 0.f, 0.f, 0.f};
        ScanBig B0, B1, B2, B3; ScanSmall T0, T1;
        ScanOff O; O.q = (unsigned)(((rt * 8 + 4 * kh) * 64 + lane) * 16); O.a = (unsigned)(((rt * 2 + kh) * 64 + lane) * 16); O.k = (unsigned)(((4 * w) * 64 + lane) * 16);
        O.d = (unsigned)((32 * w + 4 * quad) * 4); O.v = (unsigned)((((tid - 256) & 127) >> 1) * 4096 + 16 * (tid & 1));
        scan_load_big(B0, 0, bh, qd, kdT, vrow, O, tid); scan_load_small(T0, 0, bh, at, dec, vrow, O, tid);
        scan_load_big(B1, 1, bh, qd, kdT, vrow, O, tid); scan_load_big(B2, 2, bh, qd, kdT, vrow, O, tid);
#define SCAN_STEP(n_, BC, BN, TC, TN) do { const int n = (n_); const int buf = n & 1; \
            scan_load_big_kv(BN, (VAR == 4) ? 0 : ((n + 3 < NCHUNK) ? n + 3 : NCHUNK - 1), bh, kdT, vrow, O, tid);        \
            LAS bf16* st = ST + buf * (16 * 264); LAS bf16* vt = VT + buf * (16 * 72); \
            if (tid >= 256 && tid < 384) { const int tok = (tid - 256) >> 1, hh = tid & 1; const v4u v = BC.v; \
                vt[(8 * hh + 0) * 72 + tok] = (bf16)(v.x & 0xffffu); vt[(8 * hh + 1) * 72 + tok] = (bf16)(v.x >> 16); vt[(8 * hh + 2) * 72 + tok] = (bf16)(v.y & 0xffffu); vt[(8 * hh + 3) * 72 + tok] = (bf16)(v.y >> 16); \
                vt[(8 * hh + 4) * 72 + tok] = (bf16)(v.z & 0xffffu); vt[(8 * hh + 5) * 72 + tok] = (bf16)(v.z >> 16); vt[(8 * hh + 6) * 72 + tok] = (bf16)(v.w & 0xffffu); vt[(8 * hh + 7) * 72 + tok] = (bf16)(v.w >> 16); } \
            { v2u p0, p1; p0.x = pk2(S0[0], S0[1]); p0.y = pk2(S0[2], S0[3]); p1.x = pk2(S1[0], S1[1]); p1.y = pk2(S1[2], S1[3]); \
                *(LAS v2u*)(st + r16 * 264 + 32 * w + 4 * quad) = p0; *(LAS v2u*)(st + r16 * 264 + 32 * w + 16 + 4 * quad) = p1; } \
            SCAN_BAR(); \
            scan_load_small(TN, (VAR == 4) ? 0 : ((n + 1 < NCHUNK) ? n + 1 : NCHUNK - 1), bh, at, dec, vrow, O, tid); \
            if (VAR != 1 && kh == 0 && n > 0) { const f32x4 po = OP[((n - 1) & 1) * 256 + rt * 64 + lane]; const f32x4 of = oprev + po; GAS bf16* op_ = (GAS bf16*)((GAS char*)ob_item + (size_t)(n - 1) * (64 * 4096) + ooff); \
                if (VAR == 3) { if (of[0] + of[1] + of[2] + of[3] == 12345.678f) op_[0] = 1; } else { op_[0] = f2bf(of[0]); op_[2048] = f2bf(of[1]); op_[4096] = f2bf(of[2]); op_[6144] = f2bf(of[3]); } } \
            { f32x4 c0 = S0 * TC.d0, c1 = S1 * TC.d1; \
                _Pragma("unroll") for (int ks = 0; ks < 2; ++ks) { const bf16x8 B = *(const LAS bf16x8*)(vt + r16 * 72 + 32 * ks + 8 * quad); c0 = MFMA16(BC.k0[ks], B, c0); c1 = MFMA16(BC.k1[ks], B, c1); } \
                S0 = c0; S1 = c1; } \
            scan_load_big_q(BN, (VAR == 4) ? 0 : ((n + 3 < NCHUNK) ? n + 3 : NCHUNK - 1), bh, qd, O); \
            if (VAR != 1) { f32x4 o = {0.f, 0.f, 0.f, 0.f}; \
                _Pragma("unroll") for (int ks = 0; ks < 4; ++ks) o = MFMA16(BC.q[ks], *(const LAS bf16x8*)(st + r16 * 264 + 128 * kh + 32 * ks + 8 * quad), o); \
                o = MFMA16(TC.a, *(const LAS bf16x8*)(vt + r16 * 72 + 32 * kh + 8 * quad), o); \
                if (kh) OP[buf * 256 + rt * 64 + lane] = o; else oprev = o; } \
        } while (0)
        for (int n4 = 0; n4 < NCHUNK; n4 += 4) { SCAN_STEP(n4, B0, B3, T0, T1); SCAN_STEP(n4 + 1, B1, B0, T1, T0); SCAN_STEP(n4 + 2, B2, B1, T0, T1); SCAN_STEP(n4 + 3, B3, B2, T1, T0); }
        SCAN_BAR();
        if (kh == 0) { const f32x4 po = OP[(127 & 1) * 256 + rt * 64 + lane]; const f32x4 of = oprev + po; GAS bf16* op_ = (GAS bf16*)((GAS char*)ob_item + (size_t)127 * (64 * 4096) + ooff);
            op_[0] = f2bf(of[0]); op_[2048] = f2bf(of[1]); op_[4096] = f2bf(of[2]); op_[6144] = f2bf(of[3]); }
        SCAN_BAR();
    }
#undef SCAN_STEP
#undef SCAN_BAR
}
__device__ __forceinline__ void gla_g3(Frame& F, const bf16* ob, const bf16* rb, bf16* og) {
    const int gw = F.vcu * NWAVES + F.wave, NGW = F.G * NWAVES, lane = F.lane;
    constexpr int NIT = M * 4;
#define G3_LOAD(OW, RW, OFF, base) do { _Pragma("unroll") for (int j = 0; j < 4; ++j) { const int it = (base) + j * NGW, ic = it < NIT ? it : NIT - 1; OFF[j] = (size_t)(ic >> 2) * 2048 + (ic & 3) * 512 + lane * 8; \
        OW[j] = *(const GAS v4u*)(ob + OFF[j]); RW[j] = *(const GAS v4u*)(rb + OFF[j]); } } while (0)
#define G3_PROC(OW, RW, OFF, base) do { _Pragma("unroll") for (int j = 0; j < 4; ++j) { f32x4 a, b, r0, r1; pg8::unpack8(OW[j], a, b); pg8::unpack8(RW[j], r0, r1); \
        const float s = wave_sum(pg8::dot4(a) + pg8::dot4(b)); const float rstd = 1.0f / sqrtf(s * (1.0f / 512.0f) + pg8::RMS_EPS); \
        if ((base) + j * NGW < NIT) *(GAS v4u*)(og + OFF[j]) = pg8::pack8(a * rstd * r0, b * rstd * r1); } } while (0)
    v4u owA[4], rwA[4], owB[4], rwB[4]; size_t offA[4], offB[4];
    int it0 = gw;
    if (it0 < NIT) G3_LOAD(owA, rwA, offA, it0);
    while (it0 < NIT) {
        const int it1 = it0 + 4 * NGW;
        G3_LOAD(owB, rwB, offB, it1);
        G3_PROC(owA, rwA, offA, it0);
        if (it1 >= NIT) break;
        const int it2 = it1 + 4 * NGW;
        G3_LOAD(owA, rwA, offA, it2);
        G3_PROC(owB, rwB, offB, it1);
        it0 = it2;
    }
#undef G3_LOAD
#undef G3_PROC
}

template <int VAR = 0  > __device__ __forceinline__ void swa_attn(Frame& F, const bf16* qn, const bf16* kx, const bf16* vx, const float* biasT, const float* sinks, bf16* ao) {
    LAS bf16* KS = (LAS bf16*)(F.lds);
    LAS bf16* VT = (LAS bf16*)(F.lds + 36864);
    const int tid = F.tid, lane = F.lane, g = F.wave, r16 = lane & 15, quad = lane >> 4;
    const int per = (512 + F.G - 1) / F.G;
    for (int i0 = 0; i0 < per; ++i0) {
        const int u = F.vcu * per + i0; if (u >= 512) break;
        const int b = u >> 8, kvh = (u >> 6) & 3, nb = u & 63;
        const int hq = kvh * 8 + g;
        const bf16* qp = qn + ((size_t)b * SEQ + 128 * nb + r16) * 2048 + hq * 64 + 8 * quad;
        bf16x8 Qa[8], Qb[8];
#pragma unroll
        for (int t = 0; t < 8; ++t) { Qa[t] = *(const GAS bf16x8*)(qp + (size_t)(16 * t) * 2048); Qb[t] = *(const GAS bf16x8*)(qp + (size_t)(16 * t) * 2048 + 32); }
        { const int key = tid >> 1, hh = tid & 1, kpos = 128 * (nb - 1) + key;
            v4u kv[4], vv[4];
            if (kpos >= 0) { const GAS v4u* kp = (const GAS v4u*)(kx + ((size_t)b * SEQ + kpos) * 256 + kvh * 64 + 32 * hh); const GAS v4u* vp = (const GAS v4u*)(vx + ((size_t)b * SEQ + kpos) * 256 + kvh * 64 + 32 * hh);
#pragma unroll
                for (int e = 0; e < 4; ++e) { kv[e] = kp[e]; vv[e] = vp[e]; } }
            else {
#pragma unroll
                for (int e = 0; e < 4; ++e) { kv[e] = (v4u){0u, 0u, 0u, 0u}; vv[e] = (v4u){0u, 0u, 0u, 0u}; } }
#pragma unroll
            for (int e = 0; e < 4; ++e) { *(LAS v4u*)(KS + key * 72 + 32 * hh + 8 * e) = kv[e];
                LAS bf16* vtp = VT + (32 * hh + 8 * e) * 264 + key;
                vtp[0 * 264] = (bf16)(vv[e].x & 0xffffu); vtp[1 * 264] = (bf16)(vv[e].x >> 16); vtp[2 * 264] = (bf16)(vv[e].y & 0xffffu); vtp[3 * 264] = (bf16)(vv[e].y >> 16);
                vtp[4 * 264] = (bf16)(vv[e].z & 0xffffu); vtp[5 * 264] = (bf16)(vv[e].z >> 16); vtp[6 * 264] = (bf16)(vv[e].w & 0xffffu); vtp[7 * 264] = (bf16)(vv[e].w >> 16); } }
        const float sink = sinks[hq];
        float bm[9][4];
#pragma unroll
        for (int t9 = 0; t9 < 9; ++t9)
#pragma unroll
            for (int j = 0; j < 4; ++j) { const int dist = r16 + 128 - 16 * t9 - 4 * quad - j; bm[t9][j] = (dist >= 0 && dist < 128) ? biasT[hq * 128 + (dist & 127)] : -INFINITY; }
        LDS_BAR();
#pragma unroll
        for (int qt = 0; qt < (VAR == 1 ? 0 : 8); ++qt) {
            __builtin_amdgcn_sched_barrier(0);
            const bf16x8 Q0 = Qa[qt], Q1 = Qb[qt];
            f32x4 S[9];
#pragma unroll
            for (int t9 = 0; t9 < 9; ++t9) { const LAS bf16* kp = KS + (16 * (qt + t9) + r16) * 72 + 8 * quad;
                f32x4 z = {0.f, 0.f, 0.f, 0.f}; z = MFMA16(*(const LAS bf16x8*)kp, Q0, z); S[t9] = MFMA16(*(const LAS bf16x8*)(kp + 32), Q1, z); }
            if (VAR == 3) { bf16* op3 = ao + ((size_t)b * SEQ + 128 * nb + 16 * qt + r16) * 2048 + hq * 64 + 4 * quad; float t3 = 0.f;
#pragma unroll
                for (int t9 = 0; t9 < 9; ++t9) t3 += S[t9][0] + S[t9][1] + S[t9][2] + S[t9][3];
                v2u w3; w3.x = pk2(t3, t3); w3.y = w3.x; *(GAS v2u*)op3 = w3; continue; }
            float mx = sink;
            if (nb > 0) {
#pragma unroll
                for (int t9 = 0; t9 < 9; ++t9)
#pragma unroll
                    for (int j = 0; j < 4; ++j) { const float s = S[t9][j] + bm[t9][j]; S[t9][j] = s; mx = fmaxf(mx, s); }
            } else {
#pragma unroll
                for (int t9 = 0; t9 < 9; ++t9)
#pragma unroll
                    for (int j = 0; j < 4; ++j) { const int sj = 16 * (qt + t9) + 4 * quad + j; const float s = (sj >= 128) ? S[t9][j] + bm[t9][j] : -INFINITY; S[t9][j] = s; mx = fmaxf(mx, s); }
            }
            mx = fmaxf(mx, __shfl_xor(mx, 16)); mx = fmaxf(mx, __shfl_xor(mx, 32));
            float l = 0.f;
#pragma unroll
            for (int t9 = 0; t9 < 9; ++t9)
#pragma unroll
                for (int j = 0; j < 4; ++j) { const float p = __expf(S[t9][j] - mx); S[t9][j] = p; l += p; }
            l += __shfl_xor(l, 16); l += __shfl_xor(l, 32); l += __expf(sink - mx);
            const float inv = 1.0f / l;
            f32x4 O[4];
#pragma unroll
            for (int dt = 0; dt < 4; ++dt) O[dt] = (VAR == 2) ? (f32x4){inv + S[0][0] + S[8][3], l, mx, 0.f} : (f32x4){0.f, 0.f, 0.f, 0.f};
#pragma unroll
            for (int kp5 = 0; kp5 < (VAR == 2 ? 0 : 5); ++kp5) { const int ta = 2 * kp5, tb = (2 * kp5 + 1 < 9) ? 2 * kp5 + 1 : 8;
                v4u pw; pw.x = pk2(S[ta][0] * inv, S[ta][1] * inv); pw.y = pk2(S[ta][2] * inv, S[ta][3] * inv);
                if (2 * kp5 + 1 < 9) { pw.z = pk2(S[tb][0] * inv, S[tb][1] * inv); pw.w = pk2(S[tb][2] * inv, S[tb][3] * inv); } else { pw.z = 0u; pw.w = 0u; }
                const bf16x8 P = __builtin_bit_cast(bf16x8, pw);
                const int kta = qt + ta, ktb = (qt + 2 * kp5 + 1) < 15 ? (qt + 2 * kp5 + 1) : 15;
#pragma unroll
                for (int dt = 0; dt < 4; ++dt) { const v2u lo = *(const LAS v2u*)(VT + (16 * dt + r16) * 264 + 16 * kta + 4 * quad), hi = *(const LAS v2u*)(VT + (16 * dt + r16) * 264 + 16 * ktb + 4 * quad);
                    v4u bw; bw.x = lo.x; bw.y = lo.y; bw.z = hi.x; bw.w = hi.y; O[dt] = MFMA16(__builtin_bit_cast(bf16x8, bw), P, O[dt]); } }
            bf16* op = ao + ((size_t)b * SEQ + 128 * nb + 16 * qt + r16) * 2048 + hq * 64 + 4 * quad;
#pragma unroll
            for (int dt = 0; dt < 4; ++dt) { v2u w2; w2.x = pk2(O[dt][0], O[dt][1]); w2.y = pk2(O[dt][2], O[dt][3]); *(GAS v2u*)(op + 16 * dt) = w2; }
            __builtin_amdgcn_sched_barrier(0);
        }
        LDS_BAR();
    }
}

__device__ __forceinline__ void rstd_table_fill(Frame& F, const float* ss, const pg8::StaticOrder& S) {
    pg8::Unit u0; const bool has = S.next(0, u0);
    LAS float* tab = (LAS float*)(F.lds + pg8::RSTD_LDS_OFF); LAS int* tag = (LAS int*)(F.lds + pg8::RSTD_TAG_OFF);
    if (has && F.tid < 256) { const GAS f32x4* p = (const GAS f32x4*)(ss + (size_t)(u0.pm * 256 + F.tid) * 32); float s = 0.f;
#pragma unroll
        for (int e = 0; e < 8; ++e) { const f32x4 v = p[e]; s += (v[0] + v[1]) + (v[2] + v[3]); }
        tab[F.tid] = 1.0f / sqrtf(s * (1.0f / (float)D) + pg8::RMS_EPS); }
    if (F.tid == 0) *tag = has ? u0.pm + 1 : 0;
    __syncthreads();
}
#ifndef MK_ONE_LAUNCH
#define MK_ONE_LAUNCH 1
#endif
#ifndef STREAM_BF16
#define STREAM_BF16 0
#endif
__device__ __forceinline__ bool wg_leader(int wave_s) { int l; asm volatile("v_mbcnt_lo_u32_b32 %0, -1, 0\n\tv_mbcnt_hi_u32_b32 %0, -1, %0" : "=v"(l)); return wave_s == 0 && l == 0; }
template <class T> __device__ __forceinline__ T* opq(T* p) { asm volatile("" : "+s"(p)); return p; }
__device__ __forceinline__ int opqi(int v) { asm volatile("" : "+s"(v)); return v; }
struct Args { const float* in[21]; float* out; unsigned char* ws; int ph_lo, ph_hi; };
#define HB0_ ((bf16*)(ws + WS_HB))
#define HB1_ ((bf16*)(ws + WS_HB) + (size_t)M * D)
#define SS0_ ((float*)(ws + WS_SS))
#define SS1_ ((float*)(ws + WS_SS) + (size_t)M * 32)
typedef const __attribute__((address_space(4))) Args* KArgs;
__device__ __forceinline__ KArgs kargs() { KArgs p = (KArgs)__builtin_amdgcn_kernarg_segment_ptr(); asm volatile("" : "+s"(p)); return p; }
#if MK_ONE_LAUNCH
#define SEAM(p) do { if ((p) + 1 < hi) { XcdBarrier bar_; bar_.bar = (unsigned*)((gu32*)(kargs()->ws + WS_CTL) + CW_BAR); bar_.x = xb_xcc_id(); bar_.lead = wg_leader(wv_); bar_.st = (volatile LAS unsigned*)((LAS unsigned char*)lds + MISC_OFF) + 8; xcd_barrier(bar_); } } while (0)
#define FORCE_BAR2() do { XcdBarrier bar_; bar_.bar = (unsigned*)((gu32*)(kargs()->ws + WS_CTL) + CW_BAR); bar_.x = xb_xcc_id(); bar_.lead = wg_leader(wv_); bar_.st = (volatile LAS unsigned*)((LAS unsigned char*)lds + MISC_OFF) + 8; xcd_barrier(bar_); } while (0)
#else
#define SEAM(p) do { } while (0)
#endif
#define IN(k) (lo <= (k) && (k) < hi)
#define PH_LOCALS const KArgs ap = kargs(); unsigned char* const ws = ap->ws; float* const out = ap->out; const int G_ = opqi((int)gridDim.x); const int bx_ = opqi((int)blockIdx.x); (void)out; (void)G_; (void)bx_; \
    Frame Fp; { int t_ = (wv_ << 6) | pg8::stg_lane(); asm volatile("" : "+v"(t_)); Fp.lds = (LAS unsigned char*)lds; Fp.MISC = nullptr; Fp.ctl = nullptr; Fp.tid = t_; Fp.lane = t_ & 63; Fp.wave = __builtin_amdgcn_readfirstlane(t_ >> 6); Fp.G = G_; Fp.vcu = (G_ % 8 == 0) ? (bx_ % 8) * (G_ / 8) + bx_ / 8 : bx_; } \
    const pg8::Stg SG_ = (LAS unsigned*)((LAS unsigned char*)lds + STG_OFF + Fp.wave * pg8::STG_BYTES); (void)SG_

template <int L, bool RR = false> __device__ __forceinline__ void layer_body(const int lo, const int hi, const int wv_) {
    extern __shared__ __attribute__((aligned(16))) unsigned char lds[];
#ifndef PROBE_DBLBAR
#define PROBE_DBLBAR 0
#endif
#ifndef PROBE_G1_VAR
#define PROBE_G1_VAR 0
#endif
#ifndef PROBE_SCAN_VAR
#define PROBE_SCAN_VAR 0
#endif
#ifndef PROBE_ATTN_VAR
#define PROBE_ATTN_VAR 0
#endif
#ifndef MK_KS
#define MK_KS 0
#endif
#if MK_KS
#define GEMM_SEL(EPI, DIAGV) pg8::gemm_phase_ks<EPI, pg8::StaticOrder, AL>
#else
#define GEMM_SEL(EPI, DIAGV) pg8::gemm_phase<EPI, pg8::StaticOrder, AL, SP, DIAGV>
#endif
#ifndef MK_WGM_SQ
#define MK_WGM_SQ 8
#endif
#ifndef MK_WGM_UP
#define MK_WGM_UP 8
#endif
#ifndef MK_DOWN_DIAG
#define MK_DOWN_DIAG 0
#endif
#ifndef MK_AL
#define MK_AL true
#endif
#ifndef MK_SP
#define MK_SP true
#endif
    constexpr bool AL = MK_AL, SP = MK_SP;
        const int p0 = 1 + 10 * L;
        if (IN(p0 + 0)) { PH_LOCALS;
            { pg8::Gemm g{HB0_, (const bf16*)(ws + WS_WUP) + (size_t)(2 * L) * NUP * D, M, NUP, D, D}; pg8::StaticOrder S; S.init(M, NUP, G_, bx_, MK_WGM_UP); auto pre_ = [&]() { rstd_table_fill(Fp, SS0_, S); };
              pg8::EpiSwiGLU E{(bf16*)(ws + WS_ACT), SS0_};
              GEMM_SEL(pg8::EpiSwiGLU, 0)(Fp.lds + RING_OFF, g, S, E, Fp.tid, pre_); }
            if (L == 2) { pg8::Gemm g{HB0_, (const bf16*)(ws + WS_WKV), M, 512, D, D}; pg8::StaticOrder S; S.init(M, 512, G_, bx_); auto pre_ = [&]() { rstd_table_fill(Fp, SS0_, S); };
              pg8::EpiHeadNorm E{(bf16*)(ws + WS_KX), (bf16*)(ws + WS_VX), 256, SS0_, (ap->in[15]), 1.0f, 1};
              GEMM_SEL(pg8::EpiHeadNorm, 0)(Fp.lds + RING_OFF, g, S, E, Fp.tid, pre_); }
            if (L == 2 && G_ == 256 && bx_ >= 128) { pg8::Gemm g{(const bf16*)(ws + WS_PB) + (size_t)L * M * PLE, (const bf16*)(ws + WS_WPLE) + (size_t)L * D * PLE, M, D, opqi(PLE), PLE}; pg8::StaticOrder S; S.init(M, D, 128, bx_ - 128, MK_WGM_SQ);
              pg8::EpiPlainBf16 E{(bf16*)(ws + WS_PP), D};
              GEMM_SEL(pg8::EpiPlainBf16, 0)(Fp.lds + RING_OFF, g, S, E, Fp.tid); }
            SEAM(p0 + 0);
        }
        if (IN(p0 + 1)) { PH_LOCALS;
            pg8::Gemm g{(const bf16*)(ws + WS_ACT), (const bf16*)(ws + WS_WDN) + (size_t)(2 * L) * D * LDF, M, D, FF, LDF}; pg8::StaticOrder S; S.init(M, D, G_, bx_, 4);
#ifdef PROBE_AMASK
            if (RR) { g.pm_mask = PROBE_AMASK; g.pn_mask = PROBE_BMASK; }
#endif
#if STREAM_BF16
            typedef pg8::EpiResid_T<(L > 0) || RR, false> EpiD1;
#else
            typedef pg8::EpiResid EpiD1;
#endif
            EpiD1 E{(L == 0 && !RR) ? (ap->in[0]) : out, out, HB1_, SS1_, HB0_, RR ? 0.f : 0.5f};
            GEMM_SEL(EpiD1, MK_DOWN_DIAG)(Fp.lds + RING_OFF, g, S, E, Fp.tid);
            SEAM(p0 + 1);
        }
        if (L < 2) {
            if (IN(p0 + 2)) { PH_LOCALS;
                pg8::Gemm g{HB1_, (const bf16*)(ws + WS_WIN) + (size_t)L * NIN * D, M, NIN, D, D}; pg8::StaticOrder S; S.init(M, NIN, G_, bx_); auto pre_ = [&]() { rstd_table_fill(Fp, SS1_, S); };
                pg8::EpiInProj E{(bf16*)(ws + WS_QB), (bf16*)(ws + WS_KB), (bf16*)(ws + WS_VB), (bf16*)(ws + WS_RB), SS1_};
                GEMM_SEL(pg8::EpiInProj, 0)(Fp.lds + RING_OFF, g, S, E, Fp.tid, pre_);
                gla_a1(Fp, HB1_, SS1_, (const bf16*)(ws + WS_WA1) + (size_t)L * 16 * D, (float*)(ws + WS_A1));
                SEAM(p0 + 2);
            }
            if (IN(p0 + 3)) { PH_LOCALS; gla_g1<RR ? PROBE_G1_VAR : 0>(Fp, (const bf16*)(ws + WS_QB), (const bf16*)(ws + WS_KB), (const float*)(ws + WS_A1), (ap->in[9]) + (size_t)L * 16 * 1024, (ap->in[10]) + L * 1024, (bf16*)(ws + WS_QD), (bf16*)(ws + WS_KDT), (bf16*)(ws + WS_AT), (float*)(ws + WS_DEC)); SEAM(p0 + 3); }
            if (IN(p0 + 4)) { PH_LOCALS; gla_scan<RR ? PROBE_SCAN_VAR : 0>(Fp, (const bf16*)(ws + WS_QD), (const bf16*)(ws + WS_KDT), (const bf16*)(ws + WS_AT), (const float*)(ws + WS_DEC), (const bf16*)(ws + WS_VB), (bf16*)(ws + WS_OB)); SEAM(p0 + 4); }
            if (IN(p0 + 5)) { PH_LOCALS; gla_g3(Fp, (const bf16*)(ws + WS_OB), (const bf16*)(ws + WS_RB), (bf16*)(ws + WS_OG)); SEAM(p0 + 5); }
        } else {
            if (IN(p0 + 2)) { PH_LOCALS;
                pg8::Gemm g{HB1_, (const bf16*)(ws + WS_WQ) + (size_t)(L - 2) * D * D, M, D, D, D}; pg8::StaticOrder S; S.init(M, D, G_, bx_, MK_WGM_SQ); auto pre_ = [&]() { rstd_table_fill(Fp, SS1_, S); };
                pg8::EpiHeadNorm E{(bf16*)(ws + WS_QN), nullptr, 2048, SS1_, (ap->in[18]) + (L - 2) * 64, 0.125f, 8};
                GEMM_SEL(pg8::EpiHeadNorm, 0)(Fp.lds + RING_OFF, g, S, E, Fp.tid, pre_);
                SEAM(p0 + 2);
            }
            if (IN(p0 + 3)) { PH_LOCALS; swa_attn<RR ? PROBE_ATTN_VAR : 0>(Fp, (const bf16*)(ws + WS_QN), (const bf16*)(ws + WS_KX), (const bf16*)(ws + WS_VX), (const float*)(ws + WS_BIAST), (ap->in[19]) + (L - 2) * 32, (bf16*)(ws + WS_AO)); SEAM(p0 + 3); }
        }
        if (IN(p0 + 6)) { PH_LOCALS;
            pg8::Gemm g{L < 2 ? (const bf16*)(ws + WS_OG) : (const bf16*)(ws + WS_AO), L < 2 ? (const bf16*)(ws + WS_WGO) + (size_t)L * D * D : (const bf16*)(ws + WS_WSO) + (size_t)(L - 2) * D * D, M, D, D, D};
            pg8::StaticOrder S; S.init(M, D, G_, bx_, MK_WGM_SQ);
#if STREAM_BF16
            typedef pg8::EpiResid_T<true, false> EpiO;
#else
            typedef pg8::EpiResid EpiO;
#endif
            EpiO E{out, out, HB0_, SS0_, HB1_, RR ? 0.f : 1.0f};
            GEMM_SEL(EpiO, 0)(Fp.lds + RING_OFF, g, S, E, Fp.tid);
            SEAM(p0 + 6);
        }
        if (IN(p0 + 7)) { PH_LOCALS;
#ifdef PROBE_CLOCK
            unsigned long long pc_t0 = 0, pc_r0 = 0; if (L == 0) { pc_t0 = __builtin_readcyclecounter(); pc_r0 = __builtin_amdgcn_s_memrealtime(); }
#endif
            pg8::Gemm g{HB0_, (const bf16*)(ws + WS_WUP) + (size_t)(2 * L + 1) * NUP * D, M, NUP, D, D}; pg8::StaticOrder S; S.init(M, NUP, G_, bx_, MK_WGM_UP); auto pre_ = [&]() { rstd_table_fill(Fp, SS0_, S); };
#ifdef PROBE_NOEPI
            typedef pg8::EpiSwiGLU_T<RR> EpiUp2;
#else
            typedef pg8::EpiSwiGLU EpiUp2;
#endif
            EpiUp2 E{(bf16*)(ws + WS_ACT), SS0_};
#ifdef PROBE_SPLITUP
            { pg8::OffsetOrder S1; S1.init(M, NUP, G_, bx_, MK_WGM_UP); S1.off = 0; S1.cnt = 6; pg8::gemm_phase<EpiUp2, pg8::OffsetOrder, AL, SP>(Fp.lds + RING_OFF, g, S1, E, Fp.tid);
              FORCE_BAR2();
              pg8::OffsetOrder S2; S2.init(M, NUP, G_, bx_, MK_WGM_UP); S2.off = 6; S2.cnt = 5; pg8::gemm_phase<EpiUp2, pg8::OffsetOrder, AL, SP>(Fp.lds + RING_OFF, g, S2, E, Fp.tid); }
#elif defined(PROBE_DIAG)
            GEMM_SEL(EpiUp2, RR ? PROBE_DIAG : 0)(Fp.lds + RING_OFF, g, S, E, Fp.tid);
#else
            GEMM_SEL(EpiUp2, 0)(Fp.lds + RING_OFF, g, S, E, Fp.tid, pre_);
#endif
#ifdef PROBE_CLOCK
            if (L == 0 && bx_ == 0 && Fp.tid == 0) { const unsigned long long dt = __builtin_readcyclecounter() - pc_t0, dr = __builtin_amdgcn_s_memrealtime() - pc_r0;
                ((float*)(ws + WS_CTL))[200000] = (float)dt / (float)dr * 0.1f; }
#endif
            SEAM(p0 + 7);
        }
        if (IN(p0 + 8)) {
            { PH_LOCALS; pg8::Gemm g{(const bf16*)(ws + WS_ACT), (const bf16*)(ws + WS_WDN) + (size_t)(2 * L + 1) * D * LDF, M, D, FF, LDF}; pg8::StaticOrder S; S.init(M, D, G_, bx_, 4);
#if STREAM_BF16
              typedef pg8::EpiResid_T<true, false> EpiD2;
#else
              typedef pg8::EpiResid EpiD2;
#endif
              EpiD2 E{out, out, HB1_, SS1_, HB0_, RR ? 0.f : 0.5f};
              GEMM_SEL(EpiD2, MK_DOWN_DIAG)(Fp.lds + RING_OFF, g, S, E, Fp.tid); }
            SEAM(p0 + 8);
        }
        if (IN(p0 + 9)) {
            { PH_LOCALS; if (!(L == 2 && G_ == 256)) {
              pg8::Gemm g{(const bf16*)(ws + WS_PB) + (size_t)L * M * PLE, (const bf16*)(ws + WS_WPLE) + (size_t)L * D * PLE, M, D, opqi(PLE), PLE}; pg8::StaticOrder S; S.init(M, D, G_, bx_, MK_WGM_SQ);
              pg8::EpiPlainBf16 E{(bf16*)(ws + WS_PP), D};
              GEMM_SEL(pg8::EpiPlainBf16, 0)(Fp.lds + RING_OFF, g, S, E, Fp.tid); } }
          { PH_LOCALS;
            pg8::Gemm g{HB1_, (const bf16*)(ws + WS_WGATE) + (size_t)L * D * D, M, D, D, D}; pg8::StaticOrder S; S.init(M, D, G_, bx_, MK_WGM_SQ); auto pre_ = [&]() { rstd_table_fill(Fp, SS1_, S); };
#if STREAM_BF16
            typedef pg8::EpiPleGate_T<true, L == DEPTH - 1> EpiG;
#else
            typedef pg8::EpiPleGate EpiG;
#endif
            EpiG E{out, HB0_, SS1_, SS0_, (const bf16*)(ws + WS_PP), HB1_};
            GEMM_SEL(EpiG, 0)(Fp.lds + RING_OFF, g, S, E, Fp.tid, pre_); }
            SEAM(p0 + 9);
        }
    }

__global__ void __launch_bounds__(NWAVES * 64, 2) yoco_fwd(Args args_unused_) {
    extern __shared__ __attribute__((aligned(16))) unsigned char lds[];
    Frame F;
    F.lds = (LAS unsigned char*)lds;
    F.MISC = (volatile LAS unsigned*)(F.lds + MISC_OFF);
    F.tid = threadIdx.x; F.lane = F.tid & 63; F.wave = __builtin_amdgcn_readfirstlane(F.tid >> 6);
    const int wv_ = F.wave;
    F.G = gridDim.x; { const int bx = blockIdx.x; F.vcu = (F.G % 8 == 0) ? (bx % 8) * (F.G / 8) + bx / 8 : bx; }
    F.ctl = nullptr;
    for (int u = F.tid; u < (LDS_BYTES - LDSCTL_OFF) / 4; u += NWAVES * 64) ((LAS unsigned*)(F.lds + LDSCTL_OFF))[u] = 0u;
    __syncthreads();
    const int lo = kargs()->ph_lo, hi = kargs()->ph_hi;
#if MK_ONE_LAUNCH
    { unsigned char* ws0 = kargs()->ws; (void)xcd_barrier_post((unsigned*)((gu32*)(ws0 + WS_CTL) + CW_BAR), (volatile LAS unsigned*)((LAS unsigned char*)lds + MISC_OFF) + 8, wg_leader(wv_)); }
#endif
#ifndef PROBE_DBLBAR
#define PROBE_DBLBAR 0
#endif
#ifndef PROBE_SCAN_VAR
#define PROBE_SCAN_VAR 0
#endif
#ifndef PROBE_ATTN_VAR
#define PROBE_ATTN_VAR 0
#endif
#ifndef MK_WGM_SQ
#define MK_WGM_SQ 8
#endif
#ifndef MK_WGM_UP
#define MK_WGM_UP 8
#endif
#ifndef MK_DOWN_DIAG
#define MK_DOWN_DIAG 0
#endif
#ifndef MK_AL
#define MK_AL true
#endif
#ifndef MK_SP
#define MK_SP true
#endif
    constexpr bool AL = MK_AL, SP = MK_SP;

    if (IN(0)) { PH_LOCALS;
        In I; I.x = ap->in[0]; I.p = ap->in[1]; I.norm_g = ap->in[2]; I.ffn_wg = ap->in[3]; I.ffn_wu = ap->in[4]; I.ffn_wd = ap->in[5]; I.ple_w = ap->in[6]; I.ple_gate_w = ap->in[7];
        I.gla_w_in = ap->in[8]; I.gla_w_a2 = ap->in[9]; I.gla_b_a = ap->in[10]; I.gla_norm_g = ap->in[11]; I.gla_w_o = ap->in[12]; I.kv_norm_g = ap->in[13]; I.w_kv = ap->in[14]; I.k_norm_g = ap->in[15];
        I.rel_bias = ap->in[16]; I.swa_w_q = ap->in[17]; I.q_norm_g = ap->in[18]; I.sinks = ap->in[19]; I.swa_w_o = ap->in[20];
        p0_prologue(Fp, I, ws); SEAM(0); }

#ifndef PROBE_SLOT
#define PROBE_SLOT (-1)
#endif
#ifndef PROBE_LAYERS
#define PROBE_LAYERS 0
#endif
#ifndef PROBE_PROLOGUE
#define PROBE_PROLOGUE 0
#endif
#define FORCE_BAR() do { XcdBarrier bar_; bar_.bar = (unsigned*)((gu32*)(kargs()->ws + WS_CTL) + CW_BAR); bar_.x = xb_xcc_id(); bar_.lead = wg_leader(wv_); bar_.st = (volatile LAS unsigned*)((LAS unsigned char*)lds + MISC_OFF) + 8; xcd_barrier(bar_); } while (0)
#define LAYER(L_) do { layer_body<L_>(lo, hi, wv_); \
    if (PROBE_SLOT >= 0 && ((PROBE_LAYERS >> L_) & 1)) { FORCE_BAR(); layer_body<L_, true>(1 + 10 * L_ + PROBE_SLOT, 1 + 10 * L_ + PROBE_SLOT + 1, wv_); FORCE_BAR(); } } while (0)
    if (PROBE_PROLOGUE) { PH_LOCALS;
        In I; I.x = ap->in[0]; I.p = ap->in[1]; I.norm_g = ap->in[2]; I.ffn_wg = ap->in[3]; I.ffn_wu = ap->in[4]; I.ffn_wd = ap->in[5]; I.ple_w = ap->in[6]; I.ple_gate_w = ap->in[7];
        I.gla_w_in = ap->in[8]; I.gla_w_a2 = ap->in[9]; I.gla_b_a = ap->in[10]; I.gla_norm_g = ap->in[11]; I.gla_w_o = ap->in[12]; I.kv_norm_g = ap->in[13]; I.w_kv = ap->in[14]; I.k_norm_g = ap->in[15];
        I.rel_bias = ap->in[16]; I.swa_w_q = ap->in[17]; I.q_norm_g = ap->in[18]; I.sinks = ap->in[19]; I.swa_w_o = ap->in[20];
        p0_prologue(Fp, I, ws); FORCE_BAR(); }
    LAYER(0); LAYER(1); LAYER(2); LAYER(3);
#ifdef PROBE_CLOCK
    FORCE_BAR();
    if (blockIdx.x == 0 && wg_leader(wv_)) { unsigned char* ws = kargs()->ws; float* out = kargs()->out; out[0] += ((const float*)(ws + WS_CTL))[200000] * 0.125f; }
#endif
#undef IN
#undef SEAM
}

extern "C" void kernel_launch(void* const* d_in, const int* in_sizes, int n_in, void* d_out, int out_size, void* d_ws, size_t ws_size, hipStream_t stream) {
    static int grid = 0;
    if (grid == 0) {
        if (n_in != 21 || in_sizes[0] != M * D || out_size != M * D || ws_size < WS_END) { fprintf(stderr, "kernel_launch: unexpected shapes (n_in %d, in0 %d, out %d, ws %zu < %zu); nothing launched\n", n_in, n_in > 0 ? in_sizes[0] : -1, out_size, ws_size, (size_t)WS_END); grid = -1; return; }
        int dev = 0, cus = 0, per_cu = 0;
        if (hipGetDevice(&dev) != hipSuccess || hipDeviceGetAttribute(&cus, hipDeviceAttributeMultiprocessorCount, dev) != hipSuccess) { grid = -1; return; }
        if (hipFuncSetAttribute((const void*)yoco_fwd, hipFuncAttributeMaxDynamicSharedMemorySize, LDS_BYTES) != hipSuccess) { fprintf(stderr, "kernel_launch: hipFuncSetAttribute failed\n"); grid = -1; return; }
        if (hipOccupancyMaxActiveBlocksPerMultiprocessor(&per_cu, (const void*)yoco_fwd, NWAVES * 64, LDS_BYTES) != hipSuccess || per_cu < 1) fprintf(stderr, "kernel_launch: occupancy query reports %d blocks per CU\n", per_cu);
        (void)hipGetLastError();
        grid = cus;
    }
    if (grid < 0) return;
    if (hipMemsetAsync((char*)d_ws + WS_CTL, 0, CTL_ZERO_BYTES, stream) != hipSuccess) return;
    Args a{};
    for (int i = 0; i < 21; ++i) a.in[i] = (const float*)d_in[i];
    a.out = (float*)d_out; a.ws = (unsigned char*)d_ws;
#if MK_ONE_LAUNCH
    a.ph_lo = 0; a.ph_hi = NPH;
    hipLaunchKernelGGL(yoco_fwd, dim3(grid), dim3(NWAVES * 64), LDS_BYTES, stream, a);
#else
    for (int ph = 0; ph < NPH; ++ph) {
        const int k = (ph - 1) % 10, L = (ph - 1) / 10;
        if (ph > 0 && L >= 2 && (k == 4 || k == 5)) continue;
        a.ph_lo = ph; a.ph_hi = ph + 1;
        hipLaunchKernelGGL(yoco_fwd, dim3(grid), dim3(NWAVES * 64), LDS_BYTES, stream, a);
    }
#endif
}
```

```cpp
#include <hip/hip_runtime.h>
#include <cstdio>
#include <cstdint>
#ifndef MK_PRIO
#define MK_PRIO 1
#endif
#ifndef MK_FULLLINE
#define MK_FULLLINE 0
#endif
#ifndef MK_KOUTER
#define MK_KOUTER 1
#endif
#ifndef MK_SP4
#define MK_SP4 0
#endif
#ifndef MK_EARLY
#define MK_EARLY 0
#endif
#ifndef MK_KSR
#define MK_KSR 0
#endif
#ifndef MK_LPRIO
#define MK_LPRIO 0
#endif
#define MK_ONE_LAUNCH 1
#define STREAM_BF16 1
#define MK_HOOK_IN 1
namespace pg8 {
#define PG8_LAS __attribute__((address_space(3)))
typedef unsigned short bf16_t;
typedef short bf16x8 __attribute__((ext_vector_type(8)));
typedef float f32x4 __attribute__((ext_vector_type(4)));
typedef unsigned u32x4 __attribute__((ext_vector_type(4)));
constexpr int BM = 256, BK = 64, HALF = 128, HTB = HALF * BK * 2  , STAGE_BYTES = 8 * HTB, NXCD = 8, WGM = 8;

__host__ __device__ __forceinline__ int lds_byte(int r, int c) { const int st = (r >> 4) * 2 + (c >> 5), rr = r & 15, cc = c & 31, ob = rr * 64 + cc * 2; return st * 1024 + (ob ^ (((ob >> 9) & 1) << 5)); }
__host__ __device__ __forceinline__ void stage_rc(int b, int& R, int& C) { const int st = b / 1024, sb = b % 1024, swz = sb ^ (((sb >> 9) & 1) << 5); R = (st >> 1) * 16 + swz / 64; C = (st & 1) * 32 + (swz % 64) / 2; }
__host__ __device__ __forceinline__ int perm32(int rho) { const int n = rho >> 4, i = rho & 15; return 8 * (i >> 2) + 4 * n + (i & 3); }

struct Unit { int pm, pn; };
struct Gemm { const bf16_t* A; const bf16_t* Bt; int M, N, K, ld; int pm_mask = -1, pn_mask = -1; };

struct StaticOrder {
    int nM, nN, nwg, G, c, wgm;
    __host__ __device__ void init(int M, int N, int G_, int c_, int wgm_ = WGM) { nM = M / BM; nN = N / BM; nwg = nM * nN; G = G_; c = c_; wgm = wgm_; }
    __host__ __device__ bool next(int i, Unit& u) const {
        const long L = (long)i * G + c; if (L >= nwg) return false;
        int wgid = (int)L; { const int q = nwg / NXCD, r = nwg % NXCD, xcd = wgid % NXCD, off = wgid / NXCD; wgid = (xcd < r ? xcd * (q + 1) : r * (q + 1) + (xcd - r) * q) + off; }
        const int nig = wgm * nN, gid = wgid / nig, fm = gid * wgm, gsz = (nM - fm) < wgm ? (nM - fm) : wgm;
        u.pm = fm + ((wgid % nig) % gsz); u.pn = (wgid % nig) / gsz; return true;
    }
    __device__ __forceinline__ void a_ready(const Unit&) const {}
    __device__ __forceinline__ void done(const Unit&) const {}
};
typedef float cvt_f32x2_t __attribute__((ext_vector_type(2))); typedef __bf16 cvt_bf16x2_t __attribute__((ext_vector_type(2)));
__device__ __forceinline__ unsigned cvt_pk_bf16(float lo, float hi) { cvt_f32x2_t v = {lo, hi}; cvt_bf16x2_t b = __builtin_convertvector(v, cvt_bf16x2_t); return __builtin_bit_cast(unsigned, b); }
typedef float f32x2 __attribute__((ext_vector_type(2)));
struct OffsetOrder : StaticOrder { int off, cnt; __host__ __device__ bool next(int i, Unit& u) const { if (i >= cnt) return false; return StaticOrder::next(i + off, u); } };
constexpr float RMS_EPS = 1e-6f;
constexpr int DM = 2048, DFF = 5632 + 64;
typedef unsigned u32x2 __attribute__((ext_vector_type(2)));
__device__ __forceinline__ float bf2f(unsigned short b) { return __uint_as_float((unsigned)b << 16); }
__device__ __forceinline__ float sigmoid_f(float x) { return __builtin_amdgcn_rcpf(1.0f + __builtin_amdgcn_exp2f(-1.4426950408889634f * x)); }
__device__ __forceinline__ u32x4 pack8(const f32x4& a, const f32x4& b) { u32x4 w; w.x = cvt_pk_bf16(a[0], a[1]); w.y = cvt_pk_bf16(a[2], a[3]); w.z = cvt_pk_bf16(b[0], b[1]); w.w = cvt_pk_bf16(b[2], b[3]); return w; }
__device__ __forceinline__ void unpack8(const u32x4& w, f32x4& a, f32x4& b) {
    a[0] = __uint_as_float(w.x << 16); a[1] = __uint_as_float(w.x & 0xffff0000u); a[2] = __uint_as_float(w.y << 16); a[3] = __uint_as_float(w.y & 0xffff0000u);
    b[0] = __uint_as_float(w.z << 16); b[1] = __uint_as_float(w.z & 0xffff0000u); b[2] = __uint_as_float(w.w << 16); b[3] = __uint_as_float(w.w & 0xffff0000u); }
__device__ __forceinline__ float dot4(const f32x4& a) { return (a[0] * a[0] + a[1] * a[1]) + (a[2] * a[2] + a[3] * a[3]); }
__device__ __forceinline__ void row_rstd8(const float* ss, const Unit& u, int wr, int fr, int fq, float (&rs)[2][4]) {
#pragma unroll
    for (int ai = 0; ai < 2; ++ai)
#pragma unroll
        for (int m = 0; m < 4; ++m) {
            const int row = u.pm * BM + ai * HALF + wr * 64 + m * 16 + fr;
            const f32x4* p = (const f32x4*)(ss + (size_t)row * 32 + fq * 8);
            const f32x4 a = p[0], b = p[1];
            float s = ((a[0] + a[1]) + (a[2] + a[3])) + ((b[0] + b[1]) + (b[2] + b[3]));
            s += __shfl_xor(s, 16); s += __shfl_xor(s, 32);
            rs[ai][m] = 1.0f / sqrtf(s * (1.0f / (float)DM) + RMS_EPS);
        }
}
constexpr int STG_PITCH_B = 20, STG_PITCH_F = 36, STG_BYTES = 16 * STG_PITCH_F * 4;
typedef PG8_LAS unsigned* Stg;
constexpr int RSTD_LDS_OFF = STAGE_BYTES + 1024;
constexpr int RSTD_TAG_OFF = STAGE_BYTES + 448;
constexpr int HSC_LDS_OFF = STAGE_BYTES + 2048 + 8 * 2304;
constexpr int STG_LDS_OFF = STAGE_BYTES + 2048;
__device__ __forceinline__ Stg stg_ptr(int wr, int wc) { extern __shared__ __attribute__((aligned(16))) unsigned char pg8_dyn_lds[]; return (Stg)((PG8_LAS unsigned char*)pg8_dyn_lds + STG_LDS_OFF + (wr * 4 + wc) * (16 * 36 * 4)); }
__device__ __forceinline__ int stg_lane() { int l; asm volatile("v_mbcnt_lo_u32_b32 %0, -1, 0\n\tv_mbcnt_hi_u32_b32 %0, -1, %0" : "=v"(l)); return l; }
__device__ __forceinline__ void st_bf16_patch(const Stg S, int ln, int fr, int fq, const u32x4& w, bf16_t* dst, int ld) {
    *(PG8_LAS u32x4*)(S + fr * STG_PITCH_B + 4 * fq) = w;
    const u32x4 t = *(const PG8_LAS u32x4*)(S + (ln >> 2) * STG_PITCH_B + 4 * (ln & 3));
    *(u32x4*)(dst + (size_t)(ln >> 2) * ld + 8 * (ln & 3)) = t;
}
__device__ __forceinline__ void xp_f32_patch(const Stg S, int ln, int fr, int fq, const f32x4& v0, const f32x4& v1, f32x4 (&t)[2]) {
    PG8_LAS float* f = (PG8_LAS float*)S;
    *(PG8_LAS f32x4*)(f + fr * STG_PITCH_F + 8 * fq) = v0; *(PG8_LAS f32x4*)(f + fr * STG_PITCH_F + 8 * fq + 4) = v1;
#pragma unroll
    for (int hf = 0; hf < 2; ++hf) t[hf] = *(const PG8_LAS f32x4*)(f + ((ln >> 3) + 8 * hf) * STG_PITCH_F + 4 * (ln & 7));
}
__device__ __forceinline__ void row_rstd8_cached(const float* ss, const Unit& u, int wr, int fr, int fq, float (&rs)[2][4]) {
    extern __shared__ __attribute__((aligned(16))) unsigned char pg8_dyn_lds2[];
    const PG8_LAS float* tab = (const PG8_LAS float*)((PG8_LAS unsigned char*)pg8_dyn_lds2 + RSTD_LDS_OFF);
    const int tag = *(const PG8_LAS int*)((PG8_LAS unsigned char*)pg8_dyn_lds2 + RSTD_TAG_OFF);
    if (tag == u.pm + 1) {
#pragma unroll
        for (int ai = 0; ai < 2; ++ai)
#pragma unroll
            for (int m = 0; m < 4; ++m) rs[ai][m] = tab[ai * HALF + wr * 64 + m * 16 + fr];
    } else row_rstd8(ss, u, wr, fr, fq, rs);
}
template <bool NOEPI = false> struct EpiSwiGLU_T {
    static constexpr bool PERM = true, AFTER_DRAIN = false, KHOOK = false;
    bf16_t* O; const float* ss;;
    __device__ __forceinline__ void operator()(const f32x4 (&acc)[2][2][4][2], const Unit& u, int wr, int wc, int fr, int fq) const {
        if (NOEPI) {
            f32x4 t = {0.f, 0.f, 0.f, 0.f};
#pragma unroll
            for (int ai = 0; ai < 2; ++ai)
#pragma unroll
                for (int bj = 0; bj < 2; ++bj)
#pragma unroll
                    for (int m = 0; m < 4; ++m) { t += acc[ai][bj][m][0]; t += acc[ai][bj][m][1]; }
            if (t[0] + t[1] + t[2] + t[3] == 12345.678f) O[0] = 1;
            return; }
        const int ln = stg_lane(); const Stg sg = stg_ptr(wr, wc);
        float rs[2][4]; row_rstd8_cached(ss, u, wr, fr, fq, rs);
        const int col0 = u.pn * HALF + wc * 32;
#pragma unroll
        for (int ai = 0; ai < 2; ++ai)
#pragma unroll
            for (int m = 0; m < 4; ++m) {
                const int row0 = u.pm * BM + ai * HALF + wr * 64 + m * 16; const float r = rs[ai][m];
                f32x4 o[2];
#pragma unroll
                for (int n = 0; n < 2; ++n) { const f32x4 g = acc[ai][0][m][n] * r, uu = acc[ai][1][m][n] * r;
#pragma unroll
                    for (int i = 0; i < 4; ++i) o[n][i] = g[i] * sigmoid_f(g[i]) * uu[i]; }
                st_bf16_patch(sg, ln, fr, fq, pack8(o[0], o[1]), O + (size_t)row0 * DFF + col0, DFF);
            }
    }
};
typedef EpiSwiGLU_T<false> EpiSwiGLU;
template <bool BASE16 = false, bool OUT32 = true, bool HSC = false> struct EpiResid_T {
    static constexpr bool PERM = true, AFTER_DRAIN = false, KHOOK = HSC;
    const float* base; float* out; bf16_t* hb; float* sso; const bf16_t* hbi; float scale; int pad_;
    static __device__ __forceinline__ void khook(f32x4 (&acc)[2][2][4][2], int ui, int hidx, int wr) {
        extern __shared__ __attribute__((aligned(16))) unsigned char pg8_dyn_lds3[];
        const int fr = stg_lane() & 15;
        const PG8_LAS float* tab = (const PG8_LAS float*)((PG8_LAS unsigned char*)pg8_dyn_lds3 + HSC_LDS_OFF) + (ui & 1) * 1024 + (hidx - 1);
        __builtin_amdgcn_sched_barrier(0);
#pragma unroll
        for (int ai = 0; ai < 2; ++ai)
#pragma unroll
            for (int mh = 0; mh < 2; ++mh) {
                const float f0 = tab[(ai * HALF + wr * 64 + (2 * mh) * 16 + fr) * 4], f1 = tab[(ai * HALF + wr * 64 + (2 * mh + 1) * 16 + fr) * 4];
#pragma unroll
                for (int bj = 0; bj < 2; ++bj)
#pragma unroll
                    for (int n = 0; n < 2; ++n) { acc[ai][bj][2 * mh][n] *= f0; acc[ai][bj][2 * mh + 1][n] *= f1; }
                __builtin_amdgcn_sched_barrier(0);
            }
    }
    __device__ __forceinline__ void operator()(const f32x4 (&acc)[2][2][4][2], const Unit& u, int wr, int wc, int fr, int fq) const {
        const int ln = stg_lane(); const Stg sg = stg_ptr(wr, wc);
        const int colw = u.pn * BM + wc * 32 + 4 * (ln & 7);
        if (BASE16) {
#pragma unroll
            for (int ai = 0; ai < 2; ++ai) {
                const int rowa = u.pm * BM + ai * HALF + wr * 64 + (ln >> 3);
                u32x2 braw[4][2][2];
#pragma unroll
                for (int m = 0; m < 4; ++m)
#pragma unroll
                    for (int bj = 0; bj < 2; ++bj)
#pragma unroll
                        for (int hf = 0; hf < 2; ++hf) braw[m][bj][hf] = *(const u32x2*)(hbi + (size_t)(rowa + m * 16 + 8 * hf) * DM + colw + bj * HALF);
#pragma unroll
                for (int m = 0; m < 4; ++m) { const int row0 = rowa + m * 16; float s[2] = {0.f, 0.f};
#pragma unroll
                    for (int bj = 0; bj < 2; ++bj) {
                        f32x4 t[2]; xp_f32_patch(sg, ln, fr, fq, acc[ai][bj][m][0] * scale, acc[ai][bj][m][1] * scale, t);
#pragma unroll
                        for (int hf = 0; hf < 2; ++hf) { const size_t off = (size_t)(row0 + 8 * hf) * DM + colw + bj * HALF; const u32x2 bw = braw[m][bj][hf];
                            const f32x4 h = (f32x4){__uint_as_float(bw.x << 16), __uint_as_float(bw.x & 0xffff0000u), __uint_as_float(bw.y << 16), __uint_as_float(bw.y & 0xffff0000u)} + t[hf];
                            if (OUT32) *(f32x4*)(out + off) = h; u32x2 w; w.x = cvt_pk_bf16(h[0], h[1]); w.y = cvt_pk_bf16(h[2], h[3]); *(u32x2*)(hb + off) = w;
                            s[hf] += dot4(h); }
                    }
#pragma unroll
                    for (int hf = 0; hf < 2; ++hf) { float q = s[hf]; q += __shfl_xor(q, 1); q += __shfl_xor(q, 2); q += __shfl_xor(q, 4);
                        if ((ln & 7) == 0) sso[(size_t)(row0 + 8 * hf) * 32 + u.pn * 4 + wc] = q; }
                }
                asm volatile("" ::: "memory");
            }
            return;
        }
#pragma unroll
        for (int ai = 0; ai < 2; ++ai)
#pragma unroll
            for (int mh = 0; mh < 2; ++mh) {
                const int rowa = u.pm * BM + ai * HALF + wr * 64 + (ln >> 3);
                f32x4 bs[2][2][2];
#pragma unroll
                for (int mm = 0; mm < 2; ++mm)
#pragma unroll
                    for (int bj = 0; bj < 2; ++bj)
#pragma unroll
                        for (int hf = 0; hf < 2; ++hf) bs[mm][bj][hf] = *(const f32x4*)(base + (size_t)(rowa + (2 * mh + mm) * 16 + 8 * hf) * DM + colw + bj * HALF);
#pragma unroll
                for (int mm = 0; mm < 2; ++mm) { const int m = 2 * mh + mm;
                    const int row0 = rowa + m * 16; float s[2] = {0.f, 0.f};
#pragma unroll
                    for (int bj = 0; bj < 2; ++bj) {
                        f32x4 t[2]; xp_f32_patch(sg, ln, fr, fq, acc[ai][bj][m][0] * scale, acc[ai][bj][m][1] * scale, t);
#pragma unroll
                        for (int hf = 0; hf < 2; ++hf) { const size_t off = (size_t)(row0 + 8 * hf) * DM + colw + bj * HALF;
                            const f32x4 h = bs[mm][bj][hf] + t[hf];
                            if (OUT32) *(f32x4*)(out + off) = h; u32x2 w; w.x = cvt_pk_bf16(h[0], h[1]); w.y = cvt_pk_bf16(h[2], h[3]); *(u32x2*)(hb + off) = w;
                            s[hf] += dot4(h); }
                    }
#pragma unroll
                    for (int hf = 0; hf < 2; ++hf) { float q = s[hf]; q += __shfl_xor(q, 1); q += __shfl_xor(q, 2); q += __shfl_xor(q, 4);
                        if ((ln & 7) == 0) sso[(size_t)(row0 + 8 * hf) * 32 + u.pn * 4 + wc] = q; }
                }
                asm volatile("" ::: "memory");
            }
    }
};
typedef EpiResid_T<false, true> EpiResid;
template <bool BASE16 = false, bool OUT32 = true> struct EpiPleGate_T {
    static constexpr bool PERM = true, AFTER_DRAIN = false, KHOOK = false;
    float* h; bf16_t* hb; const float* ssi; float* sso; const bf16_t* pp; const bf16_t* hbi;
    __device__ __forceinline__ void operator()(const f32x4 (&acc)[2][2][4][2], const Unit& u, int wr, int wc, int fr, int fq) const {
        const int ln = stg_lane(); const Stg sg = stg_ptr(wr, wc);
        float rs[2][4]; row_rstd8_cached(ssi, u, wr, fr, fq, rs);
        const int colw = u.pn * BM + wc * 32 + 4 * (ln & 7);
        if (BASE16) {
#pragma unroll
            for (int ai = 0; ai < 2; ++ai)
#pragma unroll
                for (int mh = 0; mh < 2; ++mh) {
                const int rowa = u.pm * BM + ai * HALF + wr * 64 + (ln >> 3);
                u32x2 braw[2][2][2], praw[2][2][2];
#pragma unroll
                for (int mm = 0; mm < 2; ++mm)
#pragma unroll
                    for (int bj = 0; bj < 2; ++bj)
#pragma unroll
                        for (int hf = 0; hf < 2; ++hf) { const size_t off = (size_t)(rowa + (2 * mh + mm) * 16 + 8 * hf) * DM + colw + bj * HALF; braw[mm][bj][hf] = *(const u32x2*)(hbi + off); praw[mm][bj][hf] = *(const u32x2*)(pp + off); }
#pragma unroll
                for (int mm = 0; mm < 2; ++mm) { const int m = 2 * mh + mm; const int row0 = rowa + m * 16; const float r = rs[ai][m]; float s[2] = {0.f, 0.f};
#pragma unroll
                    for (int bj = 0; bj < 2; ++bj) {
                        f32x4 g0, g1;
#pragma unroll
                        for (int i = 0; i < 4; ++i) { g0[i] = sigmoid_f(acc[ai][bj][m][0][i] * r); g1[i] = sigmoid_f(acc[ai][bj][m][1][i] * r); }
                        f32x4 t[2]; xp_f32_patch(sg, ln, fr, fq, g0, g1, t);
#pragma unroll
                        for (int hf = 0; hf < 2; ++hf) { const size_t off = (size_t)(row0 + 8 * hf) * DM + colw + bj * HALF; const u32x2 bw = braw[mm][bj][hf], pw = praw[mm][bj][hf];
                            const f32x4 bv = {__uint_as_float(bw.x << 16), __uint_as_float(bw.x & 0xffff0000u), __uint_as_float(bw.y << 16), __uint_as_float(bw.y & 0xffff0000u)};
                            const f32x4 pv = {__uint_as_float(pw.x << 16), __uint_as_float(pw.x & 0xffff0000u), __uint_as_float(pw.y << 16), __uint_as_float(pw.y & 0xffff0000u)};
                            const f32x4 hn = bv + t[hf] * pv;
                            if (OUT32) *(f32x4*)(h + off) = hn; u32x2 w; w.x = cvt_pk_bf16(hn[0], hn[1]); w.y = cvt_pk_bf16(hn[2], hn[3]); *(u32x2*)(hb + off) = w;
                            s[hf] += dot4(hn); }
                    }
#pragma unroll
                    for (int hf = 0; hf < 2; ++hf) { float q = s[hf]; q += __shfl_xor(q, 1); q += __shfl_xor(q, 2); q += __shfl_xor(q, 4);
                        if ((ln & 7) == 0) sso[(size_t)(row0 + 8 * hf) * 32 + u.pn * 4 + wc] = q; }
                }
                asm volatile("" ::: "memory");
            }
            return;
        }
#pragma unroll
        for (int ai = 0; ai < 2; ++ai)
#pragma unroll
            for (int m = 0; m < 4; ++m) {
                const int row0 = u.pm * BM + ai * HALF + wr * 64 + m * 16 + (ln >> 3); const float r = rs[ai][m]; float s[2] = {0.f, 0.f};
                f32x4 bs[2][2]; u32x2 pq[2][2];
#pragma unroll
                for (int bj = 0; bj < 2; ++bj)
#pragma unroll
                    for (int hf = 0; hf < 2; ++hf) { const size_t off = (size_t)(row0 + 8 * hf) * DM + colw + bj * HALF; pq[bj][hf] = *(const u32x2*)(pp + off);
                        if (BASE16) { const u32x2 w = *(const u32x2*)(hbi + off); bs[bj][hf] = (f32x4){__uint_as_float(w.x << 16), __uint_as_float(w.x & 0xffff0000u), __uint_as_float(w.y << 16), __uint_as_float(w.y & 0xffff0000u)}; }
                        else bs[bj][hf] = *(const f32x4*)(h + off); }
#pragma unroll
                for (int bj = 0; bj < 2; ++bj) {
                    f32x4 g0, g1;
#pragma unroll
                    for (int i = 0; i < 4; ++i) { g0[i] = sigmoid_f(acc[ai][bj][m][0][i] * r); g1[i] = sigmoid_f(acc[ai][bj][m][1][i] * r); }
                    f32x4 t[2]; xp_f32_patch(sg, ln, fr, fq, g0, g1, t);
#pragma unroll
                    for (int hf = 0; hf < 2; ++hf) { const size_t off = (size_t)(row0 + 8 * hf) * DM + colw + bj * HALF;
                        const u32x2 pw = pq[bj][hf]; f32x4 pv; pv[0] = __uint_as_float(pw.x << 16); pv[1] = __uint_as_float(pw.x & 0xffff0000u); pv[2] = __uint_as_float(pw.y << 16); pv[3] = __uint_as_float(pw.y & 0xffff0000u);
                        const f32x4 hn = bs[bj][hf] + t[hf] * pv;
                        if (OUT32) *(f32x4*)(h + off) = hn; u32x2 w; w.x = cvt_pk_bf16(hn[0], hn[1]); w.y = cvt_pk_bf16(hn[2], hn[3]); *(u32x2*)(hb + off) = w;
                        s[hf] += dot4(hn); }
                }
#pragma unroll
                for (int hf = 0; hf < 2; ++hf) { float q = s[hf]; q += __shfl_xor(q, 1); q += __shfl_xor(q, 2); q += __shfl_xor(q, 4);
                    if ((ln & 7) == 0) sso[(size_t)(row0 + 8 * hf) * 32 + u.pn * 4 + wc] = q; }
                asm volatile("" ::: "memory");
            }
    }
};
typedef EpiPleGate_T<false, true> EpiPleGate;
struct EpiInProj {
    static constexpr bool PERM = true, AFTER_DRAIN = false, KHOOK = false;
    bf16_t *qb, *kb, *vb, *rb; const float* ss;
    __device__ __forceinline__ void operator()(const f32x4 (&acc)[2][2][4][2], const Unit& u, int wr, int wc, int fr, int fq) const {
        const int ln = stg_lane(); const Stg sg = stg_ptr(wr, wc);
        float rs[2][4]; row_rstd8_cached(ss, u, wr, fr, fq, rs);
        const int pn = u.pn; int mode, ld, colt; bf16_t* O;
        if (pn < 4) { mode = 0; O = qb; ld = 1024; colt = pn * BM; } else if (pn < 8) { mode = 1; O = kb; ld = 1024; colt = (pn - 4) * BM; }
        else if (pn < 16) { mode = 2; O = vb; ld = 2048; colt = (pn - 8) * BM; } else { mode = 3; O = rb; ld = 2048; colt = (pn - 16) * BM; }
        const int colp = colt + wc * 32;
#pragma unroll
        for (int ai = 0; ai < 2; ++ai)
#pragma unroll
            for (int m = 0; m < 4; ++m) {
                const int row0 = u.pm * BM + ai * HALF + wr * 64 + m * 16; const float r = rs[ai][m];
#pragma unroll
                for (int bj = 0; bj < 2; ++bj) {
                    f32x4 v0 = acc[ai][bj][m][0] * r, v1 = acc[ai][bj][m][1] * r;
                    if (mode == 0) { v0 = v0 * 0.0625f; v1 = v1 * 0.0625f; }
                    if (mode == 3) {
#pragma unroll
                        for (int i = 0; i < 4; ++i) { v0[i] = v0[i] * sigmoid_f(v0[i]); v1[i] = v1[i] * sigmoid_f(v1[i]); } }
                    st_bf16_patch(sg, ln, fr, fq, pack8(v0, v1), O + (size_t)row0 * ld + colp + bj * HALF, ld);
                }
            }
    }
};
struct EpiHeadNorm {
    static constexpr bool PERM = true, AFTER_DRAIN = false, KHOOK = false;
    bf16_t* O0; bf16_t* O1; int ld; const float* ss; const float* g; float oscale; int norm_tiles;;
    __device__ __forceinline__ void operator()(const f32x4 (&acc)[2][2][4][2], const Unit& u, int wr, int wc, int fr, int fq) const {
        const int ln = stg_lane(); const Stg sg = stg_ptr(wr, wc);
        float rs[2][4]; row_rstd8_cached(ss, u, wr, fr, fq, rs);
        const bool nrm = u.pn < norm_tiles; bf16_t* O = nrm ? O0 : O1; const int colp = (nrm ? u.pn : u.pn - norm_tiles) * BM + 64 * wc;
        f32x4 gv[2][2];
#pragma unroll
        for (int bj = 0; bj < 2; ++bj)
#pragma unroll
            for (int n = 0; n < 2; ++n) gv[bj][n] = *(const f32x4*)(g + 32 * bj + 8 * fq + 4 * n) * oscale;
#pragma unroll
        for (int ai = 0; ai < 2; ++ai)
#pragma unroll
            for (int m = 0; m < 4; ++m) {
                const int row0 = u.pm * BM + ai * HALF + wr * 64 + m * 16; const float r = rs[ai][m];
                f32x4 v[2][2]; float s = 0.f;
#pragma unroll
                for (int bj = 0; bj < 2; ++bj)
#pragma unroll
                    for (int n = 0; n < 2; ++n) { v[bj][n] = acc[ai][bj][m][n] * r; s += dot4(v[bj][n]); }
                s += __shfl_xor(s, 16); s += __shfl_xor(s, 32);
                const float hn = 1.0f / sqrtf(s * (1.0f / 64.0f) + RMS_EPS);
#pragma unroll
                for (int bj = 0; bj < 2; ++bj) {
                    f32x4 o0 = v[bj][0], o1 = v[bj][1];
                    if (nrm) { o0 = o0 * hn * gv[bj][0]; o1 = o1 * hn * gv[bj][1]; }
                    st_bf16_patch(sg, ln, fr, fq, pack8(o0, o1), O + (size_t)row0 * ld + colp + 32 * bj, ld);
                }
            }
    }
};
struct EpiPlainBf16 {
    static constexpr bool PERM = true, AFTER_DRAIN = false, KHOOK = false;
    bf16_t* O; int ld;;
    __device__ __forceinline__ void operator()(const f32x4 (&acc)[2][2][4][2], const Unit& u, int wr, int wc, int fr, int fq) const {
        const int ln = stg_lane(); const Stg sg = stg_ptr(wr, wc);
        const int colp = u.pn * BM + wc * 32;
#pragma unroll
        for (int ai = 0; ai < 2; ++ai)
#pragma unroll
            for (int m = 0; m < 4; ++m) {
                const int row0 = u.pm * BM + ai * HALF + wr * 64 + m * 16;
#pragma unroll
                for (int bj = 0; bj < 2; ++bj) { st_bf16_patch(sg, ln, fr, fq, pack8(acc[ai][bj][m][0], acc[ai][bj][m][1]), O + (size_t)row0 * ld + colp + bj * HALF, ld); asm volatile("" ::: "memory"); }
            }
    }
};
struct NoPre { __device__ __forceinline__ void operator()() const {} };
template <class Epi, class Sched, bool ALIGN_EPI = false, bool SP2 = false, int DIAG = 0  , class Pre = NoPre>
__device__ __forceinline__ void gemm_phase(PG8_LAS unsigned char* lds, const Gemm g, const Sched& S, const Epi& E, const int tid_in, const Pre& pre = Pre()) {
    int tid_l_ = tid_in; asm volatile("" : "+v"(tid_l_));
    const int tid = tid_l_, wid = __builtin_amdgcn_readfirstlane(tid >> 6), lane = tid & 63, wr = wid >> 2, wc = wid & 3, fr = lane & 15, fq = lane >> 4;
    const int K = g.K, nt = K / BK, ld = g.ld;
    unsigned voffA[2], voffB[2];
#pragma unroll
    for (int i = 0; i < 2; ++i) { int R, C;
#if MK_FULLLINE
        { const int b = tid * 16 + i * 8192, st = b >> 10, rr = (b & 1023) >> 7, cp = (b & 127) >> 4; R = st * 8 + rr; C = (cp ^ (((st & 1) << 2) + (rr >> 1))) * 8; }
#else
        stage_rc(tid * 16 + i * 8192, R, C);
#endif
        const int Rb = Epi::PERM ? ((R & ~31) + perm32(R & 31)) : R;
        voffA[i] = (unsigned)(R * ld + C) * 2u; voffB[i] = (unsigned)(Rb * ld + C) * 2u; }
    const ptrdiff_t kstep = (DIAG == 4) ? -(ptrdiff_t)(BK * 2) : (ptrdiff_t)(BK * 2);
    const size_t kfirst = (DIAG == 4) ? (size_t)(nt - 1) * (BK * 2) : 0;
    const unsigned hstep = (unsigned)(HALF * ld * 2);
    const size_t tstep = (size_t)2 * hstep;
    const unsigned ldsw = (unsigned)wid * 1024u;
#if MK_FULLLINE
    int aoffk[2], boffk[2];
#pragma unroll
    for (int k = 0; k < 2; ++k) { const int ra = wr * 64 + fr, rb = wc * 32 + fr; aoffk[k] = (ra >> 3) * 1024 + (ra & 7) * 128 + (((k * 4 + fq) ^ (fr >> 1)) << 4); boffk[k] = (rb >> 3) * 1024 + (rb & 7) * 128 + (((k * 4 + fq) ^ (fr >> 1)) << 4); }
#define PG8_AOFF(m, k) (aoffk[k] + (m) * 2048)
#define PG8_BOFF(n, k) (boffk[k] + (n) * 2048)
#else
    const int aoff = lds_byte(wr * 64 + fr, fq * 8), boff = lds_byte(wc * 32 + fr, fq * 8);
#define PG8_AOFF(m, k) (aoff + (m) * 2048 + (k) * 1024)
#define PG8_BOFF(n, k) (boff + (n) * 2048 + (k) * 1024)
#endif
#define PG8_SA(b, h) (((b) * 2 + (h)) * HTB)
#define PG8_SB(b, h) ((4 + (b) * 2 + (h)) * HTB)
#define PG8_STAGE(bufoff, gbase, voff) do { _Pragma("unroll") for (int _i = 0; _i < 2; ++_i) \
        __builtin_amdgcn_global_load_lds((const unsigned*)((const char*)(gbase) + (voff)[_i]), (PG8_LAS unsigned*)(lds + (bufoff) + ldsw + _i * 8192), 16, 0, 0); } while (0)
#define PG8_STAGEA(bufoff, gbase, voff) do { _Pragma("unroll") for (int _i = 0; _i < 2; ++_i) \
        __builtin_amdgcn_global_load_lds((const unsigned*)((const char*)(gbase) + (voff)[_i]), (PG8_LAS unsigned*)(lds + (bufoff) + ldsw + _i * 8192), 16, 0, (DIAG == 3) ? 2 : 0); } while (0)
#define PG8_LDA(dst, b, h) do { _Pragma("unroll") for (int m = 0; m < 4; ++m) _Pragma("unroll") for (int k = 0; k < 2; ++k) dst[m][k] = *(const PG8_LAS bf16x8*)(lds + PG8_SA(b, h) + PG8_AOFF(m, k)); } while (0)
#define PG8_LDB(dst, b, h) do { _Pragma("unroll") for (int n = 0; n < 2; ++n) _Pragma("unroll") for (int k = 0; k < 2; ++k) dst[n][k] = *(const PG8_LAS bf16x8*)(lds + PG8_SB(b, h) + PG8_BOFF(n, k)); } while (0)
#define PG8_MMA(ai, bj, At, Bt) do { if (DIAG == 1 && (ai) == 1) break; __builtin_amdgcn_s_setprio(MK_PRIO); _Pragma("unroll") for (int m = 0; m < 4; ++m) _Pragma("unroll") for (int n = 0; n < 2; ++n) _Pragma("unroll") for (int k = 0; k < 2; ++k) \
        acc[ai][bj][m][n] = __builtin_amdgcn_mfma_f32_16x16x32_bf16(Bt[n][k], At[m][k], acc[ai][bj][m][n], 0, 0, 0); __builtin_amdgcn_s_setprio(MK_LPRIO); } while (0)
#define PG8_MMA_PAIR_BAR(ai, At, Ba, Bb) do { if (DIAG == 1 && (ai) == 1) { PG8_BAR; break; } __builtin_amdgcn_s_setprio(MK_PRIO); \
        _Pragma("unroll") for (int m = 0; m < 4; ++m) _Pragma("unroll") for (int n = 0; n < 2; ++n) _Pragma("unroll") for (int k = 0; k < 2; ++k) \
            acc[ai][0][m][n] = __builtin_amdgcn_mfma_f32_16x16x32_bf16(Ba[n][k], At[m][k], acc[ai][0][m][n], 0, 0, 0); \
        _Pragma("unroll") for (int m = 0; m < 4; ++m) _Pragma("unroll") for (int n = 0; n < 2; ++n) _Pragma("unroll") for (int k = 0; k < 2; ++k) { \
            if ((m * 4 + n * 2 + k) == 16 - MK_EARLY) { __builtin_amdgcn_sched_barrier(0); __builtin_amdgcn_s_barrier(); __builtin_amdgcn_sched_barrier(0); } \
            acc[ai][1][m][n] = __builtin_amdgcn_mfma_f32_16x16x32_bf16(Bb[n][k], At[m][k], acc[ai][1][m][n], 0, 0, 0); } \
        __builtin_amdgcn_s_setprio(0); } while (0)
#define PG8_WAIT_V(n) asm volatile("s_waitcnt vmcnt(" #n ")" ::: "memory")
#define PG8_WAIT_L(n) asm volatile("s_waitcnt lgkmcnt(" #n ")" ::: "memory")
#define PG8_BAR __builtin_amdgcn_s_barrier()
#define PG8_SCHED __builtin_amdgcn_sched_barrier(0)
    Unit cur, nxt; int ui = 0;
    if (!S.next(0, cur)) return;
    f32x4 acc[2][2][4][2];
#pragma unroll
    for (int a = 0; a < 2; ++a)
#pragma unroll
        for (int b = 0; b < 2; ++b)
#pragma unroll
            for (int m = 0; m < 4; ++m)
#pragma unroll
                for (int n = 0; n < 2; ++n) acc[a][b][m][n] = (f32x4){0.f, 0.f, 0.f, 0.f};
    bf16x8 At[4][2], B0[2][2], B1[2][2];
    const char* cA = (const char*)g.A + (size_t)(cur.pm & g.pm_mask) * tstep + kfirst; const char* cB = (const char*)g.Bt + (size_t)(cur.pn & g.pn_mask) * tstep + kfirst;
    S.a_ready(cur);
#if MK_KSR
    if constexpr (SP2) {
        PG8_STAGE(PG8_SB(0, 0), cB, voffB); PG8_STAGE(PG8_SB(0, 1), cB + hstep, voffB); PG8_STAGEA(PG8_SA(0, 0), cA, voffA); PG8_STAGEA(PG8_SA(0, 1), cA + hstep, voffA);
        if (wr == 1) { PG8_STAGE(PG8_SB(1, 0), cB + kstep, voffB); PG8_STAGE(PG8_SB(1, 1), cB + hstep + kstep, voffB); PG8_STAGEA(PG8_SA(1, 0), cA + kstep, voffA); PG8_STAGEA(PG8_SA(1, 1), cA + hstep + kstep, voffA); }
        PG8_WAIT_V(0); PG8_BAR;
        if (wr == 1) PG8_BAR;
    } else
#endif
#if MK_SP4
    if constexpr (SP2) {
        PG8_STAGE(PG8_SB(0, 0), cB, voffB); PG8_STAGE(PG8_SB(0, 1), cB + hstep, voffB); PG8_STAGEA(PG8_SA(0, 0), cA, voffA); PG8_STAGEA(PG8_SA(0, 1), cA + hstep, voffA);
        if (wr == 1) { PG8_STAGE(PG8_SB(1, 0), cB + kstep, voffB); PG8_STAGE(PG8_SB(1, 1), cB + hstep + kstep, voffB); PG8_STAGEA(PG8_SA(1, 0), cA + kstep, voffA); }
        PG8_WAIT_V(0); PG8_BAR;
        if (wr == 1) PG8_BAR;
    } else
#endif
    if constexpr (SP2) {
        PG8_STAGE(PG8_SB(0, 0), cB, voffB); PG8_STAGE(PG8_SB(0, 1), cB + hstep, voffB); PG8_STAGEA(PG8_SA(0, 0), cA, voffA); PG8_STAGEA(PG8_SA(0, 1), cA + hstep, voffA);
        pre();
        if (wr == 1) PG8_BAR;
        PG8_WAIT_V(2); PG8_BAR;
        PG8_STAGE(PG8_SB(1, 0), cB + kstep, voffB); PG8_STAGEA(PG8_SA(1, 0), cA + kstep, voffA); PG8_STAGE(PG8_SB(1, 1), cB + hstep + kstep, voffB);
        PG8_WAIT_V(6); PG8_BAR;
    } else {
        PG8_STAGE(PG8_SB(0, 0), cB, voffB); PG8_STAGEA(PG8_SA(0, 0), cA, voffA); PG8_STAGE(PG8_SB(0, 1), cB + hstep, voffB); PG8_STAGEA(PG8_SA(0, 1), cA + hstep, voffA);
        if (wr == 1) PG8_BAR;
        PG8_WAIT_V(4); PG8_BAR;
        PG8_STAGE(PG8_SB(1, 0), cB + kstep, voffB); PG8_STAGEA(PG8_SA(1, 0), cA + kstep, voffA); PG8_STAGE(PG8_SB(1, 1), cB + hstep + kstep, voffB);
        PG8_WAIT_V(6); PG8_BAR;
    }
    for (;;) {
        const bool has_next = S.next(ui + 1, nxt);
        const char* nA = has_next ? (const char*)g.A + (size_t)(nxt.pm & g.pm_mask) * tstep + kfirst : cA + (ptrdiff_t)(nt - 2) * kstep; const char* nB = has_next ? (const char*)g.Bt + (size_t)(nxt.pn & g.pn_mask) * tstep + kfirst : cB + (ptrdiff_t)(nt - 2) * kstep;
        for (int t = 0; t < nt; t += 2) {
            const bool last = (t == nt - 2);
            const char* a1 = cA + (ptrdiff_t)(t + 1) * kstep;
            const char* a2 = last ? nA : cA + (ptrdiff_t)(t + 2) * kstep; const char* b2 = last ? nB : cB + (ptrdiff_t)(t + 2) * kstep;
            const char* a3 = a2 + kstep; const char* b3 = b2 + kstep;
            if (last && has_next) S.a_ready(nxt);
            if constexpr (Epi::KHOOK && MK_HOOK_IN) { if (t > 0 && (t & 7) == 0) Epi::khook(acc, ui, t >> 3, wr); }
#if MK_KSR
            if constexpr (SP2) {
            const char* b1 = cB + (ptrdiff_t)(t + 1) * kstep;
#define PG8_DMA1(bufoff, gbase, voff, i_) do { unsigned vo_ = (voff)[i_]; asm volatile("" : "+v"(vo_)); \
        __builtin_amdgcn_global_load_lds((const unsigned*)((const char*)(gbase) + vo_), (PG8_LAS unsigned*)(lds + (bufoff) + ldsw + (i_) * 8192), 16, 0, 0); } while (0)
#define PG8_KDMA(j, b, pa, pb) do { if ((j) == 0) PG8_DMA1(PG8_SB(b, 0), pb, voffB, 0); else if ((j) == 1) PG8_DMA1(PG8_SB(b, 0), pb, voffB, 1); else if ((j) == 2) PG8_DMA1(PG8_SB(b, 1), (pb) + hstep, voffB, 0); else if ((j) == 3) PG8_DMA1(PG8_SB(b, 1), (pb) + hstep, voffB, 1); \
        else if ((j) == 4) PG8_DMA1(PG8_SA(b, 0), pa, voffA, 0); else if ((j) == 5) PG8_DMA1(PG8_SA(b, 0), pa, voffA, 1); else if ((j) == 6) PG8_DMA1(PG8_SA(b, 1), (pa) + hstep, voffA, 0); else PG8_DMA1(PG8_SA(b, 1), (pa) + hstep, voffA, 1); } while (0)
#define PG8_G8(b, pa, pb) do { _Pragma("unroll") for (int j_ = 0; j_ < 8; ++j_) PG8_KDMA(j_, b, pa, pb); } while (0)
#define PG8_KLD(b, k) do { _Pragma("unroll") for (int n = 0; n < 2; ++n) { B0[n][0] = *(const PG8_LAS bf16x8*)(lds + PG8_SB(b, 0) + PG8_BOFF(n, k)); B1[n][0] = *(const PG8_LAS bf16x8*)(lds + PG8_SB(b, 1) + PG8_BOFF(n, k)); } PG8_SCHED; \
        _Pragma("unroll") for (int m = 0; m < 4; ++m) { At[m][0] = *(const PG8_LAS bf16x8*)(lds + PG8_SA(b, 0) + PG8_AOFF(m, k)); At[m][1] = *(const PG8_LAS bf16x8*)(lds + PG8_SA(b, 1) + PG8_AOFF(m, k)); } } while (0)
#define PG8_KMMA(DMAT, b, pa, pb) do { __builtin_amdgcn_s_setprio(MK_PRIO); \
        _Pragma("unroll") for (int ai = 0; ai < 2; ++ai) _Pragma("unroll") for (int m = 0; m < 4; ++m) { _Pragma("unroll") for (int n = 0; n < 2; ++n) { \
            acc[ai][0][m][n] = __builtin_amdgcn_mfma_f32_16x16x32_bf16(B0[n][0], At[m][ai], acc[ai][0][m][n], 0, 0, 0); acc[ai][1][m][n] = __builtin_amdgcn_mfma_f32_16x16x32_bf16(B1[n][0], At[m][ai], acc[ai][1][m][n], 0, 0, 0); } \
            if (DMAT && MK_KSR_TDMA) { if (wr == 1) PG8_KDMA(ai * 4 + m, b, pa, pb); } PG8_SCHED; } \
        __builtin_amdgcn_s_setprio(0); } while (0)
            PG8_KLD(0, 0); PG8_SCHED; if (wr == 0) PG8_G8(1, a1, b1);
            PG8_WAIT_L(0); PG8_BAR; PG8_KMMA(0, 0, a2, b2); PG8_BAR; PG8_SCHED;
            PG8_KLD(0, 1); if (wr == 1) PG8_WAIT_V(0);
            PG8_WAIT_L(0); PG8_BAR; PG8_KMMA(1, 0, a2, b2); if (wr == 0) PG8_WAIT_V(0); PG8_BAR; PG8_SCHED;
            PG8_KLD(1, 0); PG8_SCHED; if (wr == 0) PG8_G8(0, a2, b2);
            PG8_WAIT_L(0); PG8_BAR; PG8_KMMA(0, 1, a3, b3); PG8_BAR; PG8_SCHED;
            PG8_KLD(1, 1); if (wr == 1) PG8_WAIT_V(0);
            PG8_WAIT_L(0); PG8_BAR; PG8_KMMA(1, 1, a3, b3); if (wr == 0) PG8_WAIT_V(0); PG8_BAR; PG8_SCHED;
#undef PG8_DMA1
#undef PG8_G8
#undef PG8_KDMA
#undef PG8_KLD
#undef PG8_KMMA
            } else
#endif
#if MK_SP4
            if constexpr (SP2) {
            const char* b1 = cB + (ptrdiff_t)(t + 1) * kstep;
#define PG8_DMA1(bufoff, gbase, voff, i_) do { unsigned vo_ = (voff)[i_]; asm volatile("" : "+v"(vo_));   \
        __builtin_amdgcn_global_load_lds((const unsigned*)((const char*)(gbase) + vo_), (PG8_LAS unsigned*)(lds + (bufoff) + ldsw + (i_) * 8192), 16, 0, 0); } while (0)
#define PG8_G6(b, pa, pb) do { PG8_STAGE(PG8_SB(b, 0), pb, voffB); PG8_STAGE(PG8_SB(b, 1), (pb) + hstep, voffB); PG8_STAGEA(PG8_SA(b, 0), pa, voffA); } while (0)
#define PG8_G2(b, pa) PG8_STAGEA(PG8_SA(b, 1), (pa) + hstep, voffA)
#define PG8_ROWDMA(r, bT, paT, pbT, bL, paL) do { if (wr == 1) { \
            if ((r) == 0) PG8_DMA1(PG8_SB(bT, 0), pbT, voffB, 0); else if ((r) == 1) PG8_DMA1(PG8_SB(bT, 0), pbT, voffB, 1); \
            else if ((r) == 2) PG8_DMA1(PG8_SB(bT, 1), (pbT) + hstep, voffB, 0); else if ((r) == 3) PG8_DMA1(PG8_SB(bT, 1), (pbT) + hstep, voffB, 1); \
            else if ((r) == 4) PG8_DMA1(PG8_SA(bT, 0), paT, voffA, 0); else if ((r) == 5) PG8_DMA1(PG8_SA(bT, 0), paT, voffA, 1); \
        } else { if ((r) == 0) PG8_DMA1(PG8_SA(bL, 1), (paL) + hstep, voffA, 0); else if ((r) == 1) PG8_DMA1(PG8_SA(bL, 1), (paL) + hstep, voffA, 1); } } while (0)
#define PG8_MMA_ROW(ai, m) do { _Pragma("unroll") for (int n = 0; n < 2; ++n) _Pragma("unroll") for (int k = 0; k < 2; ++k) { \
        acc[ai][0][m][n] = __builtin_amdgcn_mfma_f32_16x16x32_bf16(B0[n][k], At[m][k], acc[ai][0][m][n], 0, 0, 0); acc[ai][1][m][n] = __builtin_amdgcn_mfma_f32_16x16x32_bf16(B1[n][k], At[m][k], acc[ai][1][m][n], 0, 0, 0); } } while (0)
#define PG8_SEG_MMA(b, bT, paT, pbT, bL, paL) do { __builtin_amdgcn_s_setprio(MK_PRIO); \
        _Pragma("unroll") for (int m = 0; m < 4; ++m) { PG8_MMA_ROW(0, m); _Pragma("unroll") for (int k = 0; k < 2; ++k) At[m][k] = *(const PG8_LAS bf16x8*)(lds + PG8_SA(b, 1) + PG8_AOFF(m, k)); PG8_ROWDMA(m, bT, paT, pbT, bL, paL); PG8_SCHED; } \
        _Pragma("unroll") for (int m = 0; m < 4; ++m) { PG8_MMA_ROW(1, m); PG8_ROWDMA(4 + m, bT, paT, pbT, bL, paL); PG8_SCHED; } \
        __builtin_amdgcn_s_setprio(0); } while (0)
            PG8_LDB(B0, 0, 0); PG8_LDB(B1, 0, 1); PG8_SCHED; PG8_LDA(At, 0, 0); PG8_SCHED;
            if (wr == 0) { PG8_G6(1, a1, b1); PG8_WAIT_V(6); } else { PG8_G2(1, a1); PG8_WAIT_V(2); }
            PG8_WAIT_L(0); PG8_BAR;
            PG8_SEG_MMA(0, 0, a2, b2, 1, a1);
            if (wr == 0) PG8_WAIT_V(2); else PG8_WAIT_V(6);
            PG8_WAIT_L(0); PG8_BAR; PG8_SCHED;
            PG8_LDB(B0, 1, 0); PG8_LDB(B1, 1, 1); PG8_SCHED; PG8_LDA(At, 1, 0); PG8_SCHED;
            if (wr == 0) { PG8_G6(0, a2, b2); PG8_WAIT_V(6); } else { PG8_G2(0, a2); PG8_WAIT_V(2); }
            PG8_WAIT_L(0); PG8_BAR;
            PG8_SEG_MMA(1, 1, a3, b3, 0, a2);
            if (wr == 0) PG8_WAIT_V(2); else PG8_WAIT_V(6);
            PG8_WAIT_L(0); PG8_BAR; PG8_SCHED;
#undef PG8_DMA1
#undef PG8_G6
#undef PG8_G2
#undef PG8_ROWDMA
#undef PG8_MMA_ROW
#undef PG8_SEG_MMA
            } else
#endif
            if constexpr (SP2) {
            PG8_LDB(B0, 0, 0); PG8_LDB(B1, 0, 1); PG8_SCHED; PG8_LDA(At, 0, 0); PG8_STAGEA(PG8_SA(1, 1), a1 + hstep, voffA);
            PG8_WAIT_V(8); PG8_WAIT_L(0); PG8_BAR; if (MK_EARLY > 0) { PG8_MMA_PAIR_BAR(0, At, B0, B1); } else { PG8_MMA(0, 0, At, B0); PG8_MMA(0, 1, At, B1); PG8_BAR; } PG8_SCHED;
            PG8_LDA(At, 0, 1); PG8_STAGE(PG8_SB(0, 0), b2, voffB); PG8_STAGE(PG8_SB(0, 1), b2 + hstep, voffB); PG8_STAGEA(PG8_SA(0, 0), a2, voffA);
            PG8_WAIT_V(8); PG8_WAIT_L(0); PG8_BAR; if (MK_EARLY > 0) { PG8_MMA_PAIR_BAR(1, At, B0, B1); } else { PG8_MMA(1, 0, At, B0); PG8_MMA(1, 1, At, B1); PG8_BAR; } PG8_SCHED;
            PG8_LDB(B0, 1, 0); PG8_LDB(B1, 1, 1); PG8_SCHED; PG8_LDA(At, 1, 0); PG8_STAGEA(PG8_SA(0, 1), a2 + hstep, voffA);
            PG8_WAIT_V(8); PG8_WAIT_L(0); PG8_BAR; if (MK_EARLY > 0) { PG8_MMA_PAIR_BAR(0, At, B0, B1); } else { PG8_MMA(0, 0, At, B0); PG8_MMA(0, 1, At, B1); PG8_BAR; } PG8_SCHED;
            PG8_LDA(At, 1, 1); PG8_STAGE(PG8_SB(1, 0), b3, voffB); PG8_STAGE(PG8_SB(1, 1), b3 + hstep, voffB); PG8_STAGEA(PG8_SA(1, 0), a3, voffA);
            PG8_WAIT_V(8); PG8_WAIT_L(0); PG8_BAR; if (MK_EARLY > 0) { PG8_MMA_PAIR_BAR(1, At, B0, B1); } else { PG8_MMA(1, 0, At, B0); PG8_MMA(1, 1, At, B1); PG8_BAR; } PG8_SCHED;
            } else {
            PG8_LDB(B0, 0, 0); PG8_SCHED; PG8_LDA(At, 0, 0); PG8_STAGEA(PG8_SA(1, 1), a1 + hstep, voffA);
            PG8_WAIT_L(8); PG8_BAR; PG8_WAIT_L(0); PG8_MMA(0, 0, At, B0); PG8_BAR; PG8_SCHED;
            PG8_LDB(B1, 0, 1); PG8_STAGE(PG8_SB(0, 0), b2, voffB);
            PG8_BAR; PG8_WAIT_L(0); PG8_MMA(0, 1, At, B1); PG8_BAR;
            PG8_LDA(At, 0, 1); PG8_STAGEA(PG8_SA(0, 0), a2, voffA);
            PG8_BAR; PG8_WAIT_L(0); PG8_MMA(1, 0, At, B0); PG8_BAR; PG8_SCHED;
            PG8_STAGE(PG8_SB(0, 1), b2 + hstep, voffB);
            PG8_WAIT_V(6); PG8_BAR; PG8_MMA(1, 1, At, B1); PG8_BAR;
            PG8_LDB(B0, 1, 0); PG8_SCHED; PG8_LDA(At, 1, 0); PG8_STAGEA(PG8_SA(0, 1), a2 + hstep, voffA);
            PG8_WAIT_L(8); PG8_BAR; PG8_WAIT_L(0); PG8_MMA(0, 0, At, B0); PG8_BAR; PG8_SCHED;
            PG8_LDB(B1, 1, 1); PG8_STAGE(PG8_SB(1, 0), b3, voffB);
            PG8_BAR; PG8_WAIT_L(0); PG8_MMA(0, 1, At, B1); PG8_BAR;
            PG8_LDA(At, 1, 1); PG8_STAGEA(PG8_SA(1, 0), a3, voffA);
            PG8_BAR; PG8_WAIT_L(0); PG8_MMA(1, 0, At, B0); PG8_BAR; PG8_SCHED;
            PG8_STAGE(PG8_SB(1, 1), b3 + hstep, voffB);
            PG8_WAIT_V(6); PG8_BAR; PG8_MMA(1, 1, At, B1); PG8_BAR;
            }
        }
        if constexpr (Epi::KHOOK) Epi::khook(acc, ui, 4, wr);
        if constexpr (ALIGN_EPI) { if (wr == 0) PG8_BAR; }
        if constexpr (!Epi::AFTER_DRAIN) { const int ln2_ = stg_lane(); E(acc, cur, wr, wc, ln2_ & 15, ln2_ >> 4); S.done(cur); }
        if (!has_next) break;
#pragma unroll
        for (int a = 0; a < 2; ++a)
#pragma unroll
            for (int b = 0; b < 2; ++b)
#pragma unroll
                for (int m = 0; m < 4; ++m)
#pragma unroll
                    for (int n = 0; n < 2; ++n) acc[a][b][m][n] = (f32x4){0.f, 0.f, 0.f, 0.f};
        cur = nxt; cA = nA; cB = nB; ++ui;
        if constexpr (ALIGN_EPI) { if (wr == 1) PG8_BAR; }
    }
    PG8_WAIT_V(0);
    if constexpr (!ALIGN_EPI) { if (wr == 0) PG8_BAR; }
    PG8_BAR;
    if constexpr (Epi::AFTER_DRAIN) { E.fused(acc, cur, wr, wc, fr, fq, lds, wid, lane); S.done(cur); }
#undef PG8_AOFF
#undef PG8_BOFF
#undef PG8_SA
#undef PG8_SB
#undef PG8_STAGE
#undef PG8_STAGEA
#undef PG8_LDA
#undef PG8_LDB
#undef PG8_MMA
#undef PG8_WAIT_V
#undef PG8_WAIT_L
#undef PG8_BAR
#undef PG8_SCHED
}
template <class Epi, class Sched, bool ALIGN_EPI = true>
__device__ __forceinline__ void gemm_phase_ks(PG8_LAS unsigned char* lds, const Gemm g, const Sched& S, const Epi& E, const int tid_in) {
    int tid_l_ = tid_in; asm volatile("" : "+v"(tid_l_));
    const int tid = tid_l_, wid = __builtin_amdgcn_readfirstlane(tid >> 6), lane = tid & 63, wr = wid >> 2, wc = wid & 3, fr = lane & 15, fq = lane >> 4;
    const int K = g.K, nt = K / BK, ld = g.ld;
    unsigned voffA[2], voffB[2];
#pragma unroll
    for (int i = 0; i < 2; ++i) { const int b = tid * 16 + i * 8192, st = b >> 10, sb = b & 1023, swz = sb ^ (((sb >> 9) & 1) << 5); const int R = st * 16 + (swz >> 6), C = (swz & 63) >> 1;
        const int Rb = Epi::PERM ? ((R & ~31) + perm32(R & 31)) : R;
        voffA[i] = (unsigned)(R * ld + C) * 2u; voffB[i] = (unsigned)(Rb * ld + C) * 2u; }
    const ptrdiff_t kstep = (ptrdiff_t)(BK * 2);
    const size_t tstep = (size_t)BM * ld * 2;
    const unsigned ldsw = (unsigned)wid * 1024u;
    const int fsub = lds_byte(fr, fq * 8);
    const int aoff = (wr * 4) * 1024 + fsub, boff = (wc * 2) * 1024 + fsub;
#define KS_SLOT(b, kh, ab) (((((b) * 2 + (kh)) * 2) + (ab)) * 16384)
#define KS_STAGE1(slot, gbase, voff) do { _Pragma("unroll") for (int _i = 0; _i < 2; ++_i) \
        __builtin_amdgcn_global_load_lds((const unsigned*)((const char*)(gbase) + (voff)[_i]), (PG8_LAS unsigned*)(lds + (slot) + ldsw + _i * 8192), 16, 0, 0); } while (0)
#define KS_STAGE(b, kh, pa, pb) do { KS_STAGE1(KS_SLOT(b, kh, 1), (pb) + 64 * (kh), voffB); KS_STAGE1(KS_SLOT(b, kh, 0), (pa) + 64 * (kh), voffA); } while (0)
#define KS_LD(b, kh) do { _Pragma("unroll") for (int bj = 0; bj < 2; ++bj) _Pragma("unroll") for (int n = 0; n < 2; ++n) Bf[bj][n] = *(const PG8_LAS bf16x8*)(lds + KS_SLOT(b, kh, 1) + boff + (8 * bj + n) * 1024); \
        __builtin_amdgcn_sched_barrier(0); \
        _Pragma("unroll") for (int ai = 0; ai < 2; ++ai) _Pragma("unroll") for (int m = 0; m < 4; ++m) Af[ai][m] = *(const PG8_LAS bf16x8*)(lds + KS_SLOT(b, kh, 0) + aoff + (8 * ai + m) * 1024); } while (0)
#define KS_MMA() do { __builtin_amdgcn_s_setprio(MK_PRIO); _Pragma("unroll") for (int ai = 0; ai < 2; ++ai) _Pragma("unroll") for (int bj = 0; bj < 2; ++bj) _Pragma("unroll") for (int m = 0; m < 4; ++m) _Pragma("unroll") for (int n = 0; n < 2; ++n) \
        acc[ai][bj][m][n] = __builtin_amdgcn_mfma_f32_16x16x32_bf16(Bf[bj][n], Af[ai][m], acc[ai][bj][m][n], 0, 0, 0); __builtin_amdgcn_s_setprio(0); } while (0)
#define KS_WAIT_V(n) asm volatile("s_waitcnt vmcnt(" #n ")" ::: "memory")
#define KS_WAIT_L(n) asm volatile("s_waitcnt lgkmcnt(" #n ")" ::: "memory")
#define KS_BAR __builtin_amdgcn_s_barrier()
#define KS_SCHED __builtin_amdgcn_sched_barrier(0)
    Unit cur, nxt; int ui = 0;
    if (!S.next(0, cur)) return;
    f32x4 acc[2][2][4][2];
#pragma unroll
    for (int a = 0; a < 2; ++a)
#pragma unroll
        for (int b = 0; b < 2; ++b)
#pragma unroll
            for (int m = 0; m < 4; ++m)
#pragma unroll
                for (int n = 0; n < 2; ++n) acc[a][b][m][n] = (f32x4){0.f, 0.f, 0.f, 0.f};
    bf16x8 Af[2][4], Bf[2][2];
    const char* cA = (const char*)g.A + (size_t)(cur.pm & g.pm_mask) * tstep; const char* cB = (const char*)g.Bt + (size_t)(cur.pn & g.pn_mask) * tstep;
    S.a_ready(cur);
    KS_STAGE(0, 0, cA, cB); KS_STAGE(0, 1, cA, cB);
    if (wr == 1) KS_BAR;
    KS_WAIT_V(4); KS_BAR;
    KS_STAGE(1, 0, cA + kstep, cB + kstep);
    KS_WAIT_V(4); KS_BAR;
    for (;;) {
        const bool has_next = S.next(ui + 1, nxt);
        const char* nA = has_next ? (const char*)g.A + (size_t)(nxt.pm & g.pm_mask) * tstep : cA; const char* nB = has_next ? (const char*)g.Bt + (size_t)(nxt.pn & g.pn_mask) * tstep : cB;
        for (int t = 0; t < nt; t += 2) {
            const bool last = (t == nt - 2);
            const char* a1 = cA + (ptrdiff_t)(t + 1) * kstep; const char* b1 = cB + (ptrdiff_t)(t + 1) * kstep;
            const char* a2 = last ? nA : cA + (ptrdiff_t)(t + 2) * kstep; const char* b2 = last ? nB : cB + (ptrdiff_t)(t + 2) * kstep;
            const char* a3 = a2 + kstep; const char* b3 = b2 + kstep;
            if (last && has_next) S.a_ready(nxt);
            KS_LD(0, 0); KS_STAGE(1, 1, a1, b1);
            KS_WAIT_V(8); KS_WAIT_L(0); KS_BAR; KS_MMA(); KS_BAR; KS_SCHED;
            KS_LD(0, 1); KS_STAGE(0, 0, a2, b2);
            KS_WAIT_V(8); KS_WAIT_L(0); KS_BAR; KS_MMA(); KS_BAR; KS_SCHED;
            KS_LD(1, 0); KS_STAGE(0, 1, a2, b2);
            KS_WAIT_V(8); KS_WAIT_L(0); KS_BAR; KS_MMA(); KS_BAR; KS_SCHED;
            KS_LD(1, 1); KS_STAGE(1, 0, a3, b3);
            KS_WAIT_V(8); KS_WAIT_L(0); KS_BAR; KS_MMA(); KS_BAR; KS_SCHED;
        }
        if constexpr (ALIGN_EPI) { if (wr == 0) KS_BAR; }
        E(acc, cur, wr, wc, fr, fq); S.done(cur);
        if (!has_next) break;
#pragma unroll
        for (int a = 0; a < 2; ++a)
#pragma unroll
            for (int b = 0; b < 2; ++b)
#pragma unroll
                for (int m = 0; m < 4; ++m)
#pragma unroll
                    for (int n = 0; n < 2; ++n) acc[a][b][m][n] = (f32x4){0.f, 0.f, 0.f, 0.f};
        cur = nxt; cA = nA; cB = nB; ++ui;
        if constexpr (ALIGN_EPI) { if (wr == 1) KS_BAR; }
    }
    KS_WAIT_V(0);
    if constexpr (!ALIGN_EPI) { if (wr == 0) KS_BAR; }
    KS_BAR;
#undef KS_SLOT
#undef KS_STAGE1
#undef KS_STAGE
#undef KS_LD
#undef KS_MMA
#undef KS_WAIT_V
#undef KS_WAIT_L
#undef KS_BAR
#undef KS_SCHED
}
}

constexpr int NWAVES = 8;
constexpr int BATCH = 2, SEQ = 8192, M = BATCH * SEQ, D = 2048, FF = 5632, DEPTH = 4, PLE = 256;
constexpr int LDF = pg8::DFF;
constexpr int NUP = 2 * FF;
constexpr int GIN = 6160, NIN = 6144;
constexpr int NCHUNK = 128;
constexpr int NPH = 1 + 10 * DEPTH;

constexpr size_t MiB = 1u << 20;
constexpr size_t WS_CTL = 0, CTL_ZERO_BYTES = 1 * MiB;
constexpr size_t WS_WUP = 1 * MiB;
constexpr size_t WS_WDN = WS_WUP + 352 * MiB;
constexpr size_t WS_WGATE = WS_WDN + 184 * MiB;
constexpr size_t WS_WPLE = WS_WGATE + 32 * MiB;
constexpr size_t WS_WIN = WS_WPLE + 4 * MiB;
constexpr size_t WS_WGO = WS_WIN + 56 * MiB;
constexpr size_t WS_WKV = WS_WGO + 16 * MiB;
constexpr size_t WS_WQ = WS_WKV + 2 * MiB;
constexpr size_t WS_WSO = WS_WQ + 16 * MiB;
constexpr size_t WS_HB = WS_WSO + 16 * MiB;
constexpr size_t WS_SS = WS_HB + 128 * MiB;
constexpr size_t WS_PB = WS_SS + 4 * MiB;
constexpr size_t WS_PP = WS_PB + 32 * MiB;
constexpr size_t WS_KX = WS_PP + 64 * MiB;
constexpr size_t WS_VX = WS_KX + 8 * MiB;
constexpr size_t WS_SCR = WS_VX + 8 * MiB;
constexpr size_t WS_ACT = WS_SCR;
constexpr size_t WS_QB = WS_SCR, WS_KB = WS_SCR + 32 * MiB, WS_VB = WS_SCR + 64 * MiB, WS_RB = WS_SCR + 128 * MiB;
constexpr size_t WS_A1 = WS_SCR + 192 * MiB;
constexpr size_t WS_SO2 = WS_SCR + 208 * MiB;
constexpr size_t WS_WA1 = WS_CTL + 768 * 1024;
constexpr size_t WS_QD = WS_SCR + 256 * MiB, WS_KDT = WS_SCR + 288 * MiB, WS_AT = WS_SCR + 320 * MiB, WS_DEC = WS_SCR + 328 * MiB;
constexpr size_t WS_OB = WS_SCR + 336 * MiB;
constexpr size_t WS_OG = WS_SCR;
constexpr size_t WS_QN = WS_SCR, WS_AO = WS_SCR + 64 * MiB;
constexpr size_t WS_END = WS_SCR + 464 * MiB;
constexpr int CW_TMO = 0, CW_CODE = 1, CW_BAR = 4096;
constexpr size_t WS_BIAST = WS_CTL + 512 * 1024;

constexpr int RING_OFF = 0, RING_BYTES = 131072;
constexpr int LDSCTL_OFF = RING_BYTES, MISC_OFF = LDSCTL_OFF + 320;
constexpr int STG_OFF = pg8::STG_LDS_OFF; static_assert(STG_OFF == RING_BYTES + 2048, "staging tiles");
constexpr int HSC_OFF = STG_OFF + 8 * pg8::STG_BYTES; static_assert(HSC_OFF == pg8::HSC_LDS_OFF, "head-scale table");
constexpr int LDS_BYTES = HSC_OFF + 8192;

#define GAS __attribute__((address_space(1)))
#define LAS __attribute__((address_space(3)))
typedef unsigned short bf16;
typedef unsigned v4u __attribute__((ext_vector_type(4)));
typedef unsigned v2u __attribute__((ext_vector_type(2)));
typedef float f32x4 __attribute__((ext_vector_type(4)));
typedef short bf16x8 __attribute__((ext_vector_type(8)));
typedef GAS unsigned gu32;
#define RLX_AGENT __ATOMIC_RELAXED, __HIP_MEMORY_SCOPE_AGENT
#define LDS_WAIT() asm volatile("s_waitcnt lgkmcnt(0)" ::: "memory")
#define VM_WAIT() asm volatile("s_waitcnt vmcnt(0)" ::: "memory")
__device__ __forceinline__ unsigned pk2(float lo, float hi) { return pg8::cvt_pk_bf16(lo, hi); }
__device__ __forceinline__ float bf2f(unsigned short b) { return __uint_as_float((unsigned)b << 16); }
__device__ __forceinline__ unsigned short f2bf(float f) { return (unsigned short)(pg8::cvt_pk_bf16(f, 0.f) & 0xffffu); }
#define MFMA16(a, b, c) __builtin_amdgcn_mfma_f32_16x16x32_bf16((a), (b), (c), 0, 0, 0)

#define XB_TMO      128
#define XB_XCNT(j)  (256  + 64 * (j))
#define XB_XSUB(j)  (1280 + 64 * (j))
#define XB_XGEN(j)  (2304 + 64 * (j))
#define XB_TOP      3328
#define XB_TOPGEN   3392
#define XCD_BAR_WORDS 3456
#define XB_SPIN_CAP (1u << 18)

__device__ __forceinline__ unsigned xb_ld(unsigned* p)              { return __hip_atomic_load(p, __ATOMIC_RELAXED, __HIP_MEMORY_SCOPE_AGENT); }
__device__ __forceinline__ unsigned xb_add(unsigned* p, unsigned v) { return __hip_atomic_fetch_add(p, v, __ATOMIC_RELAXED, __HIP_MEMORY_SCOPE_AGENT); }
__device__ __forceinline__ unsigned xb_xcc_id() { return (unsigned)__builtin_amdgcn_s_getreg((3 << 11) | 20) & 0xFu; }
#define XB_SPIN(cond, bar) do { unsigned _sp = 0; while (cond) { __builtin_amdgcn_s_sleep(1); \
    if ((++_sp & 255u) == 0u) { if (xb_ld(&(bar)[XB_TMO])) break; if (_sp > XB_SPIN_CAP) { atomicAdd(&(bar)[XB_TMO], 1u); break; } } } } while (0)

struct XcdBarrier {
    bool lead;
    unsigned* bar; unsigned x;
    volatile LAS unsigned* st;
};

__device__ __forceinline__ XcdBarrier xcd_barrier_post(unsigned* bar, volatile LAS unsigned* st, bool lead) {
    XcdBarrier b; b.bar = bar; b.x = xb_xcc_id(); b.st = st; b.lead = lead;
    if (lead) (void)xb_add(&bar[XB_XCNT(b.x)], 1u);
    return b;
}
__device__ __forceinline__ void xcd_barrier_complete(unsigned* bar, unsigned x, unsigned& nloc, unsigned& nx) {
    const unsigned G = gridDim.x * gridDim.y * gridDim.z;
    unsigned sum, cnt, mine, sp = 0u;
    for (;;) {
        sum = 0u; cnt = 0u; mine = 0u;
#pragma unroll
        for (unsigned j = 0; j < 16; ++j) { const unsigned c = xb_ld(&bar[XB_XCNT(j)]); sum += c; cnt += (c > 0u) ? 1u : 0u; mine = (j == x) ? c : mine; }
        if (sum == G) break;
        __builtin_amdgcn_s_sleep(1);
        if ((++sp & 255u) == 0u) { if (xb_ld(&bar[XB_TMO])) break; if (sp > XB_SPIN_CAP) { atomicAdd(&bar[XB_TMO], 1u); break; } }
    }
    nloc = mine > 0u ? mine : 1u; nx = cnt > 0u ? cnt : 1u;
}

__device__ __forceinline__ void xcd_barrier(const XcdBarrier& b) {
    asm volatile("s_waitcnt vmcnt(0)" ::: "memory");
    __syncthreads();
    if (b.lead) {
        unsigned* bar = b.bar;
        __builtin_amdgcn_s_waitcnt(0);
        unsigned nloc = b.st[0], nx = b.st[1];
        if (nloc == 0u) { xcd_barrier_complete(bar, b.x, nloc, nx); b.st[0] = nloc; b.st[1] = nx; }
        const unsigned old = xb_add(&bar[XB_XSUB(b.x)], 1u);
        const unsigned gen = old / nloc;
        if (old + 1u == (gen + 1u) * nloc) {
            __builtin_amdgcn_fence(__ATOMIC_RELEASE, "agent");
            asm volatile("s_waitcnt vmcnt(0)" ::: "memory");
            const unsigned og = xb_add(&bar[XB_TOP], 1u);
            const unsigned tg = og / nx;
            if (og + 1u == (tg + 1u) * nx) xb_add(&bar[XB_TOPGEN], 1u);
            else XB_SPIN(xb_ld(&bar[XB_TOPGEN]) == tg, bar);
            __builtin_amdgcn_fence(__ATOMIC_ACQUIRE, "agent");
            xb_add(&bar[XB_XGEN(b.x)], 1u);
            asm volatile("s_waitcnt vmcnt(0)" ::: "memory");
        } else {
            XB_SPIN(xb_ld(&bar[XB_XGEN(b.x)]) == gen, bar);
            __builtin_amdgcn_fence(__ATOMIC_ACQUIRE, "agent");
            asm volatile("s_waitcnt vmcnt(0)" ::: "memory");
        }
    }
    __syncthreads();
}

struct Frame {
    LAS unsigned char* lds;
    volatile LAS unsigned* MISC;
    gu32* ctl;
    int tid, lane, wave;
    int vcu, G;
};
#define LDS_BAR() do { asm volatile("s_waitcnt lgkmcnt(0)" ::: "memory"); __builtin_amdgcn_s_barrier(); asm volatile("" ::: "memory"); } while (0)
__device__ __forceinline__ float wave_sum(float v) {
#pragma unroll
    for (int o = 1; o < 64; o <<= 1) v += __shfl_xor(v, o);
    return v;
}

#ifndef MK_W_NT
#define MK_W_NT 1
#endif
#ifndef MK_W_NTST
#define MK_W_NTST 1
#endif
#if MK_W_NT
#define MK_WLOAD(p) __builtin_nontemporal_load(p)
#else
#define MK_WLOAD(p) (*(p))
#endif
__device__ __forceinline__ int t5_bucket(int d) { if (d < 16) return d; const int l = 16 + (int)(logf((float)d / 16.0f) / logf(8.0f) * 16.0f); return l < 31 ? l : 31; }
__device__ __forceinline__ void p0_store_item(LAS float* scr, bf16* WT, int K, int k0, int dst_row0, int lane) {
    LDS_WAIT(); asm volatile("" ::: "memory");
    const int c = lane & 7;
#pragma unroll
    for (int j = 0; j < 4; ++j) { const int n = (lane >> 3) + 8 * j; const LAS float* s = scr + (8 * c) * 33 + n;
        v4u o; o.x = pk2(s[0 * 33], s[1 * 33]); o.y = pk2(s[2 * 33], s[3 * 33]); o.z = pk2(s[4 * 33], s[5 * 33]); o.w = pk2(s[6 * 33], s[7 * 33]);
#if MK_W_NTST
        __builtin_nontemporal_store(o, (GAS v4u*)(WT + (size_t)(dst_row0 + n) * K + k0 + 8 * c)); }
#else
        *(GAS v4u*)(WT + (size_t)(dst_row0 + n) * K + k0 + 8 * c) = o; }
#endif
    LDS_WAIT(); asm volatile("" ::: "memory");
}
__device__ __forceinline__ void p0_item(const float* W, int N, int n0, int k0, const float* gain, int gmask, bf16* WT, int K, int dst_row0, LAS float* scr, int lane) {
    float v[32];
#pragma unroll
    for (int i = 0; i < 32; ++i) { const int k = k0 + 2 * i + (lane >> 5); v[i] = MK_WLOAD(W + (size_t)k * N + n0 + (lane & 31)); }
    if (gain) {
#pragma unroll
        for (int i = 0; i < 32; ++i) { const int k = k0 + 2 * i + (lane >> 5); v[i] *= gain[k & gmask]; } }
#pragma unroll
    for (int i = 0; i < 32; ++i) scr[(2 * i + (lane >> 5)) * 33 + (lane & 31)] = v[i];
    p0_store_item(scr, WT, K, k0, dst_row0, lane);
}
struct In { const float *x, *p, *norm_g, *ffn_wg, *ffn_wu, *ffn_wd, *ple_w, *ple_gate_w, *gla_w_in, *gla_w_a2, *gla_b_a, *gla_norm_g, *gla_w_o, *kv_norm_g, *w_kv, *k_norm_g, *rel_bias, *swa_w_q, *q_norm_g, *sinks, *swa_w_o; };

__device__ __forceinline__ void p0_prologue(Frame& F, const In& I, unsigned char* ws) {
    LAS float* scr = (LAS float*)(F.lds + RING_OFF + F.wave * 16384);
    const int gw = F.vcu * NWAVES + F.wave, NGW = F.G * NWAVES, lane = F.lane;
    constexpr int IT_UP = 32 * 176, IT_DN = 88 * 64, IT_SQ = 32 * 64, IT_PLE = 4 * 64, IT_IN = 32 * 192, IT_GF = 0, IT_KV = 32 * 16;
    constexpr int C1 = 8 * IT_UP, C2 = C1 + 8 * IT_UP, C3 = C2 + 8 * IT_DN, C4 = C3 + 4 * IT_SQ, C5 = C4 + 4 * IT_PLE, C6 = C5 + 2 * IT_IN, C7 = C6 + 2 * IT_GF, C8 = C7 + 2 * IT_SQ, C9 = C8 + IT_KV, C10 = C9 + 2 * IT_SQ, C11 = C10 + 2 * IT_SQ;
    for (int it = gw; it < C11; it += NGW) {
        int r = it;
        if (r < C2) {
            const int isu = r >= C1; if (isu) r -= C1;
            const int j = r / IT_UP, q = r % IT_UP, kb = q / 176, nb = q % 176, n0 = 32 * nb, L = j >> 1, f = j & 1;
            const float* W = (isu ? I.ffn_wu : I.ffn_wg) + (size_t)j * D * FF;
            p0_item(W, FF, n0, 64 * kb, I.norm_g + (L * 4 + 2 * f) * D, 0x7fffffff, (bf16*)(ws + WS_WUP) + (size_t)j * NUP * D, D, (n0 >> 7) * 256 + (n0 & 127) + 128 * isu, scr, lane);
            continue; }
        r -= C2;
        if (r < 8 * IT_DN) { const int j = r / IT_DN, q = r % IT_DN, kb = q / 64, nb = q % 64;
            p0_item(I.ffn_wd + (size_t)j * FF * D, D, 32 * nb, 64 * kb, nullptr, 0, (bf16*)(ws + WS_WDN) + (size_t)j * D * LDF, LDF, 32 * nb, scr, lane); continue; }
        r -= 8 * IT_DN;
        if (r < 4 * IT_SQ) { const int j = r / IT_SQ, q = r % IT_SQ, kb = q / 64, nb = q % 64;
            p0_item(I.ple_gate_w + (size_t)j * D * D, D, 32 * nb, 64 * kb, I.norm_g + (j * 4 + 3) * D, 0x7fffffff, (bf16*)(ws + WS_WGATE) + (size_t)j * D * D, D, 32 * nb, scr, lane); continue; }
        r -= 4 * IT_SQ;
        if (r < 4 * IT_PLE) { const int j = r / IT_PLE, q = r % IT_PLE, kb = q / 64, nb = q % 64;
            p0_item(I.ple_w + (size_t)j * PLE * D, D, 32 * nb, 64 * kb, nullptr, 0, (bf16*)(ws + WS_WPLE) + (size_t)j * D * PLE, PLE, 32 * nb, scr, lane); continue; }
        r -= 4 * IT_PLE;
        if (r < 2 * IT_IN) { const int j = r / IT_IN, q = r % IT_IN, kb = q / 192, nb = q % 192;
            p0_item(I.gla_w_in + (size_t)j * D * GIN, GIN, 32 * nb, 64 * kb, I.norm_g + (j * 4 + 1) * D, 0x7fffffff, (bf16*)(ws + WS_WIN) + (size_t)j * NIN * D, D, 32 * nb, scr, lane); continue; }
        r -= 2 * IT_IN;
        r -= 2 * IT_GF;
        if (r < 2 * IT_SQ) { const int j = r / IT_SQ, q = r % IT_SQ, kb = q / 64, nb = q % 64;
            p0_item(I.gla_w_o + (size_t)j * D * D, D, 32 * nb, 64 * kb, I.gla_norm_g + j * 512, 511, (bf16*)(ws + WS_WGO) + (size_t)j * D * D, D, 32 * nb, scr, lane); continue; }
        r -= 2 * IT_SQ;
        if (r < IT_KV) { const int kb = r / 16, nb = r % 16, n0 = 32 * nb;
            p0_item(I.w_kv, 512, n0, 64 * kb, I.kv_norm_g, 0x7fffffff, (bf16*)(ws + WS_WKV), D, (n0 & ~255) + 128 * ((n0 >> 5) & 1) + 32 * ((n0 >> 6) & 3), scr, lane); continue; }
        r -= IT_KV;
        if (r < 2 * IT_SQ) { const int j = r / IT_SQ, q = r % IT_SQ, kb = q / 64, nb = q % 64, n0 = 32 * nb;
            p0_item(I.swa_w_q + (size_t)j * D * D, D, n0, 64 * kb, I.norm_g + ((2 + j) * 4 + 1) * D, 0x7fffffff, (bf16*)(ws + WS_WQ) + (size_t)j * D * D, D, (n0 & ~255) + 128 * ((n0 >> 5) & 1) + 32 * ((n0 >> 6) & 3), scr, lane); continue; }
        r -= 2 * IT_SQ;
        { const int j = r / IT_SQ, q = r % IT_SQ, kb = q / 64, nb = q % 64;
            p0_item(I.swa_w_o + (size_t)j * D * D, D, 32 * nb, 64 * kb, nullptr, 0, (bf16*)(ws + WS_WSO) + (size_t)j * D * D, D, 32 * nb, scr, lane); }
    }
    { bf16* wa = (bf16*)(ws + WS_WA1); for (int t = (F.vcu * NWAVES + F.wave) * 64 + lane; t < 2 * 16 * D; t += F.G * NWAVES * 64) { const int j = t >> 15, r = (t >> 11) & 15, k = t & 2047;
        wa[t] = f2bf(I.norm_g[(j * 4 + 1) * D + k] * I.gla_w_in[(size_t)j * D * GIN + (size_t)k * GIN + 6144 + r]); } }
    { float* bt = (float*)(ws + WS_BIAST); const int t = (F.vcu * NWAVES + F.wave) * 64 + lane; if (t < 32 * 128) { const int hqh = t >> 7, dist = t & 127; bt[t] = I.rel_bias[t5_bucket(dist) * 32 + hqh]; } }
    { const size_t n8 = (size_t)DEPTH * M * PLE / 8; GAS v4u* o = (GAS v4u*)(ws + WS_PB);
        for (size_t i = (size_t)gw * 64 + lane; i < n8; i += (size_t)NGW * 64) { const f32x4 a = ((const GAS f32x4*)I.p)[2 * i], b = ((const GAS f32x4*)I.p)[2 * i + 1];
            v4u w; w.x = pk2(a[0], a[1]); w.y = pk2(a[2], a[3]); w.z = pk2(b[0], b[1]); w.w = pk2(b[2], b[3]); o[i] = w; } }
    { bf16* hb0 = (bf16*)(ws + WS_HB); float* ss0 = (float*)(ws + WS_SS);
        for (int m = gw; m < M; m += NGW) { const GAS f32x4* xr = (const GAS f32x4*)(I.x + (size_t)m * D); float s = 0.f;
#pragma unroll
            for (int j = 0; j < 4; ++j) { const f32x4 a = xr[128 * j + 2 * lane], b = xr[128 * j + 2 * lane + 1]; s += pg8::dot4(a) + pg8::dot4(b);
                v4u w; w.x = pk2(a[0], a[1]); w.y = pk2(a[2], a[3]); w.z = pk2(b[0], b[1]); w.w = pk2(b[2], b[3]); *(GAS v4u*)(hb0 + (size_t)m * D + 512 * j + 8 * lane) = w; }
            s = wave_sum(s);
            if (lane < 32) ss0[(size_t)m * 32 + lane] = (lane == 0) ? s : 0.f; } }
}

typedef float f32x2v __attribute__((ext_vector_type(2)));
__device__ __forceinline__ void gla_a1(Frame& F, const bf16* hb, const float* ss, const bf16* wa, float* a1) {
    LAS bf16* WA = (LAS bf16*)(F.lds);
    const int tid = F.tid, lane = F.lane, r16 = lane & 15, quad = lane >> 4;
#pragma unroll
    for (int e = 0; e < 8; ++e) { const int d = tid + 512 * e, row = d >> 8, ch = d & 255; *(LAS v4u*)(WA + row * 2056 + ch * 8) = *(const GAS v4u*)(wa + row * 2048 + ch * 8); }
    __syncthreads();
    for (int rt = F.vcu + F.G * F.wave; rt < M / 16; rt += F.G * NWAVES) {
        const bf16* ap = hb + (size_t)(16 * rt + r16) * D + 8 * quad; const LAS bf16* bp = WA + r16 * 2056 + 8 * quad;
        f32x4 c0 = {0.f, 0.f, 0.f, 0.f}, c1 = c0, c2 = c0, c3 = c0;
#pragma unroll 8
        for (int ks = 0; ks < 64; ks += 4) {
            c0 = MFMA16(*(const GAS bf16x8*)(ap + 32 * ks), *(const LAS bf16x8*)(bp + 32 * ks), c0);
            c1 = MFMA16(*(const GAS bf16x8*)(ap + 32 * ks + 32), *(const LAS bf16x8*)(bp + 32 * ks + 32), c1);
            c2 = MFMA16(*(const GAS bf16x8*)(ap + 32 * ks + 64), *(const LAS bf16x8*)(bp + 32 * ks + 64), c2);
            c3 = MFMA16(*(const GAS bf16x8*)(ap + 32 * ks + 96), *(const LAS bf16x8*)(bp + 32 * ks + 96), c3); }
        const f32x4 acc = (c0 + c1) + (c2 + c3);
        const GAS f32x4* sp = (const GAS f32x4*)(ss + (size_t)(16 * rt + r16) * 32 + 8 * quad); const f32x4 sa = sp[0], sb = sp[1];
        float s = ((sa[0] + sa[1]) + (sa[2] + sa[3])) + ((sb[0] + sb[1]) + (sb[2] + sb[3]));
        s += __shfl_xor(s, 16); s += __shfl_xor(s, 32);
        const float rstd = 1.0f / sqrtf(s * (1.0f / (float)D) + pg8::RMS_EPS);
#pragma unroll
        for (int j = 0; j < 4; ++j) { const float rj = __shfl(rstd, 4 * quad + j); a1[(size_t)(16 * rt + 4 * quad + j) * 16 + r16] = acc[j] * rj; }
    }
    __syncthreads();
}
struct G1Regs { unsigned q[16], k[16]; };
__device__ __forceinline__ void g1_load(G1Regs& R, int u, const bf16* qb, const bf16* kb, int c2, int tq) {
    const int bh = u >> 7, n = u & 127, b = bh >> 2, h = bh & 3;
    const size_t row0 = (size_t)b * SEQ + 64 * n + 16 * tq; const int cc = h * 256 + 2 * c2;
#pragma unroll
    for (int i = 0; i < 16; ++i) { R.q[i] = *(const GAS unsigned*)(qb + (row0 + i) * 1024 + cc); R.k[i] = *(const GAS unsigned*)(kb + (row0 + i) * 1024 + cc); }
}
__device__ __forceinline__ void g1_stage_a1(LAS float* dst, int u, const float* a1, int tid) {
    if (tid < 256) { const int bh = u >> 7, n = u & 127, b = bh >> 2; *(LAS f32x4*)(dst + 4 * tid) = *(const GAS f32x4*)(a1 + ((size_t)b * SEQ + 64 * n) * 16 + 4 * tid); }
}
template <int VAR = 0  > __device__ __forceinline__ void gla_g1(Frame& F, const bf16* qb, const bf16* kb, const float* a1, const float* w2, const float* b_a, bf16* qd, bf16* kdT, bf16* at, float* dec) {
    LAS bf16* QD = (LAS bf16*)(F.lds);
    LAS bf16* KI = (LAS bf16*)(F.lds + 33792);
    LAS bf16* KT = (LAS bf16*)(F.lds + 67584);
    LAS f32x2v* TOT = (LAS f32x2v*)(F.lds + 104448);
    LAS float* A1S = (LAS float*)(F.lds + 108544);
    LAS bf16* ATS = (LAS bf16*)(F.lds + 116736);
    const int tid = F.tid, c2 = tid & 127, tq = tid >> 7, lane = F.lane, w = F.wave, r16 = lane & 15, quad = lane >> 4;
    const int per = (1024 + F.G - 1) / F.G;
    G1Regs R; const int u0 = F.vcu * per;
    if (u0 < 1024) { g1_load(R, u0, qb, kb, c2, tq); g1_stage_a1(A1S, u0, a1, tid); }
    LDS_BAR();
    int cur_h = -1; float w2x[16], w2y[16]; float bax = 0.f, bay = 0.f;
    for (int i0 = 0; i0 < per; ++i0) {
        const int u = u0 + i0; if (u >= 1024) break;
        const int h = (u >> 7) & 3;
        if (h != cur_h) { cur_h = h;
#pragma unroll
            for (int r = 0; r < 16; ++r) { const f32x2v t = *(const GAS f32x2v*)(w2 + r * 1024 + h * 256 + 2 * c2); w2x[r] = t.x; w2y[r] = t.y; }
            const f32x2v t = *(const GAS f32x2v*)(b_a + h * 256 + 2 * c2); bax = t.x; bay = t.y; }
        const LAS float* as = A1S + (i0 & 1) * 1024 + (16 * tq) * 16;
        f32x2v bs[16];
        { f32x2v run = {0.f, 0.f};
#pragma unroll
            for (int i = 0; i < 16; ++i) { const f32x4 a0 = *(const LAS f32x4*)(as + 16 * i), a1v = *(const LAS f32x4*)(as + 16 * i + 4), a2 = *(const LAS f32x4*)(as + 16 * i + 8), a3 = *(const LAS f32x4*)(as + 16 * i + 12);
                float zx = bax, zy = bay;
#pragma unroll
                for (int r = 0; r < 4; ++r) { zx += a0[r] * w2x[r] + a1v[r] * w2x[4 + r] + a2[r] * w2x[8 + r] + a3[r] * w2x[12 + r]; zy += a0[r] * w2y[r] + a1v[r] * w2y[4 + r] + a2[r] * w2y[8 + r] + a3[r] * w2y[12 + r]; }
                run.x += (fminf(zx, 0.f) - __logf(1.0f + __expf(-fabsf(zx)))) * 0.0625f; run.y += (fminf(zy, 0.f) - __logf(1.0f + __expf(-fabsf(zy)))) * 0.0625f; bs[i] = run; } }
        unsigned qv[16], kv[16];
#pragma unroll
        for (int i = 0; i < 16; ++i) { qv[i] = R.q[i]; kv[i] = R.k[i]; }
        TOT[tq * 128 + c2] = bs[15];
        const bool nxt_ = (i0 + 1 < per && u + 1 < 1024); f32x4 a1n = {0.f, 0.f, 0.f, 0.f};
        if (nxt_) { if (tid < 256) { const int un = u + 1, bhn = un >> 7, nn = un & 127, bn = bhn >> 2; a1n = *(const GAS f32x4*)(a1 + ((size_t)bn * SEQ + 64 * nn) * 16 + 4 * tid); }
            g1_load(R, u + 1, qb, kb, c2, tq); }
        LDS_BAR();
        f32x2v pre = {0.f, 0.f}, tot = {0.f, 0.f};
#pragma unroll
        for (int t = 0; t < 4; ++t) { const f32x2v v = TOT[t * 128 + c2]; if (t < tq) { pre.x += v.x; pre.y += v.y; } tot.x += v.x; tot.y += v.y; }
        float kdx[16], kdy[16];
#pragma unroll
        for (int i = 0; i < 16; ++i) { const float bx = bs[i].x + pre.x, by = bs[i].y + pre.y;
            const float qx = __uint_as_float(qv[i] << 16), qy = __uint_as_float(qv[i] & 0xffff0000u), kx_ = __uint_as_float(kv[i] << 16), ky_ = __uint_as_float(kv[i] & 0xffff0000u);
            *(LAS unsigned*)(QD + (16 * tq + i) * 264 + 2 * c2) = pk2(qx * __expf(bx), qy * __expf(by));
            *(LAS unsigned*)(KI + (16 * tq + i) * 264 + 2 * c2) = pk2(kx_ * __expf(-bx), ky_ * __expf(-by));
            kdx[i] = kx_ * __expf(tot.x - bx); kdy[i] = ky_ * __expf(tot.y - by); }
#pragma unroll
        for (int e = 0; e < 2; ++e) { v4u wx, wy;
            wx.x = pk2(kdx[8 * e], kdx[8 * e + 1]); wx.y = pk2(kdx[8 * e + 2], kdx[8 * e + 3]); wx.z = pk2(kdx[8 * e + 4], kdx[8 * e + 5]); wx.w = pk2(kdx[8 * e + 6], kdx[8 * e + 7]);
            wy.x = pk2(kdy[8 * e], kdy[8 * e + 1]); wy.y = pk2(kdy[8 * e + 2], kdy[8 * e + 3]); wy.z = pk2(kdy[8 * e + 4], kdy[8 * e + 5]); wy.w = pk2(kdy[8 * e + 6], kdy[8 * e + 7]);
            *(LAS v4u*)(KT + (2 * c2) * 72 + 16 * tq + 8 * e) = wx; *(LAS v4u*)(KT + (2 * c2 + 1) * 72 + 16 * tq + 8 * e) = wy; }
        if (tq == 0) *(GAS f32x2v*)(dec + (size_t)u * 256 + 2 * c2) = (f32x2v){__expf(tot.x), __expf(tot.y)};
        LDS_BAR();
        if (VAR != 1) { const int ti = w >> 1;
#pragma unroll
            for (int tt = 0; tt < 2; ++tt) { const int tj = (w & 1) * 2 + tt; f32x4 a4 = {0.f, 0.f, 0.f, 0.f};
                if (tj <= ti) {
#pragma unroll
                    for (int ks = 0; ks < 8; ++ks) { const bf16x8 A = *(const LAS bf16x8*)(QD + (16 * ti + r16) * 264 + 32 * ks + 8 * quad), B = *(const LAS bf16x8*)(KI + (16 * tj + r16) * 264 + 32 * ks + 8 * quad); a4 = MFMA16(A, B, a4); } }
#pragma unroll
                for (int j = 0; j < 4; ++j) { const int ii = 16 * ti + 4 * quad + j, jj = 16 * tj + r16; ATS[(((ii >> 4) * 2 + (jj >> 5)) * 64 + ((jj & 31) >> 3) * 16 + (ii & 15)) * 8 + (jj & 7)] = f2bf(jj <= ii ? a4[j] : 0.f); } } }
        if (VAR != 1 && VAR != 3)
#pragma unroll
        for (int e = 0; e < 4; ++e) { const int d = tid + 512 * e, blk = d >> 6, ln = d & 63, row = 16 * (blk >> 3) + (ln & 15), ch = 4 * (blk & 7) + (ln >> 4);
            *(GAS v4u*)(qd + (size_t)u * 16384 + d * 8) = *(const LAS v4u*)(QD + row * 264 + ch * 8); }
        if (VAR != 1 && VAR != 3)
#pragma unroll
        for (int e = 0; e < 4; ++e) { const int d = tid + 512 * e, blk = d >> 6, ln = d & 63, row = 16 * (blk >> 1) + (ln & 15), ch = 4 * (blk & 1) + (ln >> 4);
            *(GAS v4u*)(kdT + (size_t)u * 16384 + d * 8) = *(const LAS v4u*)(KT + row * 72 + ch * 8); }
        if (nxt_ && tid < 256) *(LAS f32x4*)(A1S + ((i0 + 1) & 1) * 1024 + 4 * tid) = a1n;
        LDS_BAR();
        if (VAR != 1 && VAR != 2) *(GAS v4u*)(at + (size_t)u * 4096 + tid * 8) = *(const LAS v4u*)(ATS + tid * 8);
        LDS_BAR();
    }
}
struct ScanBig { bf16x8 q[4]; bf16x8 k0[2], k1[2]; v4u v; };
struct ScanSmall { bf16x8 a; f32x4 d0, d1; };
struct ScanOff { unsigned q, a, k, d, v; };
__device__ __forceinline__ void scan_load_big_kv(ScanBig& R, int n, int bh, const bf16* kdT, const bf16* vrow, const ScanOff& O, int tid) {
    const size_t u = (size_t)(bh * NCHUNK + n);
    if (tid >= 256 && tid < 384) R.v = *(const GAS v4u*)((const GAS char*)vrow + (size_t)n * (64 * 4096) + O.v);
    const GAS char* kp = (const GAS char*)kdT + u * 32768 + O.k;
#pragma unroll
    for (int ks = 0; ks < 2; ++ks) { R.k0[ks] = *(const GAS bf16x8*)(kp + 1024 * ks); R.k1[ks] = *(const GAS bf16x8*)(kp + 2048 + 1024 * ks); }
}
__device__ __forceinline__ void scan_load_big_q(ScanBig& R, int n, int bh, const bf16* qd, const ScanOff& O) {
    const size_t u = (size_t)(bh * NCHUNK + n);
    const GAS char* qp = (const GAS char*)qd + u * 32768 + O.q;
#pragma unroll
    for (int ks = 0; ks < 4; ++ks) R.q[ks] = *(const GAS bf16x8*)(qp + 1024 * ks);
}
__device__ __forceinline__ void scan_load_big(ScanBig& R, int n, int bh, const bf16* qd, const bf16* kdT, const bf16* vrow, const ScanOff& O, int tid) {
    scan_load_big_kv(R, n, bh, kdT, vrow, O, tid); scan_load_big_q(R, n, bh, qd, O);
}
__device__ __forceinline__ void scan_load_small(ScanSmall& R, int n, int bh, const bf16* at, const float* dec, const bf16* vrow, const ScanOff& O, int tid) {
    const size_t u = (size_t)(bh * NCHUNK + n);
    R.a = *(const GAS bf16x8*)((const GAS char*)at + u * 8192 + O.a);
    const GAS char* dp = (const GAS char*)dec + u * 1024 + O.d;
    R.d0 = *(const GAS f32x4*)dp; R.d1 = *(const GAS f32x4*)(dp + 64);
}
template <int VAR = 0  > __device__ __forceinline__ void gla_scan(Frame& F, const bf16* qd, const bf16* kdT, const bf16* at, const float* dec, const bf16* vb, bf16* ob) {
    LAS bf16* ST = (LAS bf16*)(F.lds);
    LAS bf16* VT = (LAS bf16*)(F.lds + 16896);
    LAS f32x4* OP = (LAS f32x4*)(F.lds + 21504);
    const int tid = F.tid, lane = F.lane, w = F.wave, r16 = lane & 15, quad = lane >> 4, rt = w & 3, kh = w >> 2;
#define SCAN_BAR() do { asm volatile("s_waitcnt lgkmcnt(0)" ::: "memory"); __builtin_amdgcn_s_barrier(); asm volatile("" ::: "memory"); } while (0)
#ifdef PROBE_SCANHALF
    for (int item = F.vcu; item < ((F.vcu & 1) ? 0 : F.vcu + 2); ++item) {
#else
    for (int item = F.vcu; item < 256; item += F.G) {
#endif
        const int bh = item >> 5, sl = item & 31, b = bh >> 2, h = bh & 3;
        const size_t tok0 = (size_t)b * SEQ; const int vcol = h * 512 + 16 * sl;
        const bf16* vrow = vb + tok0 * 2048 + vcol; bf16* ob_item = ob + tok0 * 2048 + vcol; const unsigned ooff = (unsigned)(((16 * rt + 4 * quad) * 2048 + r16) * 2);
        f32x4 S0 = {0.f, 0.f, 0.f, 0.f}, S1 = {0.f, 0.f, 0.f, 0.f}, oprev = {0.f, 0.f, 0.f, 0.f};
        ScanBig B0, B1, B2, B3; ScanSmall T0, T1;
        ScanOff O; O.q = (unsigned)(((rt * 8 + 4 * kh) * 64 + lane) * 16); O.a = (unsigned)(((rt * 2 + kh) * 64 + lane) * 16); O.k = (unsigned)(((4 * w) * 64 + lane) * 16);
        O.d = (unsigned)((32 * w + 4 * quad) * 4); O.v = (unsigned)((((tid - 256) & 127) >> 1) * 4096 + 16 * (tid & 1));
        scan_load_big(B0, 0, bh, qd, kdT, vrow, O, tid); scan_load_small(T0, 0, bh, at, dec, vrow, O, tid);
        scan_load_big(B1, 1, bh, qd, kdT, vrow, O, tid); scan_load_big(B2, 2, bh, qd, kdT, vrow, O, tid);
#define SCAN_STEP(n_, BC, BN, TC, TN) do { const int n = (n_); const int buf = n & 1; \
            scan_load_big_kv(BN, (VAR == 4) ? 0 : ((n + 3 < NCHUNK) ? n + 3 : NCHUNK - 1), bh, kdT, vrow, O, tid);        \
            LAS bf16* st = ST + buf * (16 * 264); LAS bf16* vt = VT + buf * (16 * 72); \
            if (tid >= 256 && tid < 384) { const int tok = (tid - 256) >> 1, hh = tid & 1; const v4u v = BC.v; \
                vt[(8 * hh + 0) * 72 + tok] = (bf16)(v.x & 0xffffu); vt[(8 * hh + 1) * 72 + tok] = (bf16)(v.x >> 16); vt[(8 * hh + 2) * 72 + tok] = (bf16)(v.y & 0xffffu); vt[(8 * hh + 3) * 72 + tok] = (bf16)(v.y >> 16); \
                vt[(8 * hh + 4) * 72 + tok] = (bf16)(v.z & 0xffffu); vt[(8 * hh + 5) * 72 + tok] = (bf16)(v.z >> 16); vt[(8 * hh + 6) * 72 + tok] = (bf16)(v.w & 0xffffu); vt[(8 * hh + 7) * 72 + tok] = (bf16)(v.w >> 16); } \
            { v2u p0, p1; p0.x = pk2(S0[0], S0[1]); p0.y = pk2(S0[2], S0[3]); p1.x = pk2(S1[0], S1[1]); p1.y = pk2(S1[2], S1[3]); \
                *(LAS v2u*)(st + r16 * 264 + 32 * w + 4 * quad) = p0; *(LAS v2u*)(st + r16 * 264 + 32 * w + 16 + 4 * quad) = p1; } \
            SCAN_BAR(); \
            scan_load_small(TN, (VAR == 4) ? 0 : ((n + 1 < NCHUNK) ? n + 1 : NCHUNK - 1), bh, at, dec, vrow, O, tid); \
            if (VAR != 1 && kh == 0 && n > 0) { const f32x4 po = OP[((n - 1) & 1) * 256 + rt * 64 + lane]; const f32x4 of = oprev + po; GAS bf16* op_ = (GAS bf16*)((GAS char*)ob_item + (size_t)(n - 1) * (64 * 4096) + ooff); \
                if (VAR == 3) { if (of[0] + of[1] + of[2] + of[3] == 12345.678f) op_[0] = 1; } else { op_[0] = f2bf(of[0]); op_[2048] = f2bf(of[1]); op_[4096] = f2bf(of[2]); op_[6144] = f2bf(of[3]); } } \
            { f32x4 c0 = S0 * TC.d0, c1 = S1 * TC.d1; \
                _Pragma("unroll") for (int ks = 0; ks < 2; ++ks) { const bf16x8 B = *(const LAS bf16x8*)(vt + r16 * 72 + 32 * ks + 8 * quad); c0 = MFMA16(BC.k0[ks], B, c0); c1 = MFMA16(BC.k1[ks], B, c1); } \
                S0 = c0; S1 = c1; } \
            scan_load_big_q(BN, (VAR == 4) ? 0 : ((n + 3 < NCHUNK) ? n + 3 : NCHUNK - 1), bh, qd, O); \
            if (VAR != 1) { f32x4 o = {0.f, 0.f, 0.f, 0.f}; \
                _Pragma("unroll") for (int ks = 0; ks < 4; ++ks) o = MFMA16(BC.q[ks], *(const LAS bf16x8*)(st + r16 * 264 + 128 * kh + 32 * ks + 8 * quad), o); \
                o = MFMA16(TC.a, *(const LAS bf16x8*)(vt + r16 * 72 + 32 * kh + 8 * quad), o); \
                if (kh) OP[buf * 256 + rt * 64 + lane] = o; else oprev = o; } \
        } while (0)
        for (int n4 = 0; n4 < NCHUNK; n4 += 4) { SCAN_STEP(n4, B0, B3, T0, T1); SCAN_STEP(n4 + 1, B1, B0, T1, T0); SCAN_STEP(n4 + 2, B2, B1, T0, T1); SCAN_STEP(n4 + 3, B3, B2, T1, T0); }
        SCAN_BAR();
        if (kh == 0) { const f32x4 po = OP[(127 & 1) * 256 + rt * 64 + lane]; const f32x4 of = oprev + po; GAS bf16* op_ = (GAS bf16*)((GAS char*)ob_item + (size_t)127 * (64 * 4096) + ooff);
            op_[0] = f2bf(of[0]); op_[2048] = f2bf(of[1]); op_[4096] = f2bf(of[2]); op_[6144] = f2bf(of[3]); }
        SCAN_BAR();
    }
#undef SCAN_STEP
#undef SCAN_BAR
}
__device__ __forceinline__ void gla_g3(Frame& F, const bf16* ob, const bf16* rb, bf16* og) {
    const int gw = F.vcu * NWAVES + F.wave, NGW = F.G * NWAVES, lane = F.lane;
    constexpr int NIT = M * 4;
#define G3_LOAD(OW, RW, OFF, base) do { _Pragma("unroll") for (int j = 0; j < 4; ++j) { const int it = (base) + j * NGW, ic = it < NIT ? it : NIT - 1; OFF[j] = (size_t)(ic >> 2) * 2048 + (ic & 3) * 512 + lane * 8; \
        OW[j] = *(const GAS v4u*)(ob + OFF[j]); RW[j] = *(const GAS v4u*)(rb + OFF[j]); } } while (0)
#define G3_PROC(OW, RW, OFF, base) do { _Pragma("unroll") for (int j = 0; j < 4; ++j) { f32x4 a, b, r0, r1; pg8::unpack8(OW[j], a, b); pg8::unpack8(RW[j], r0, r1); \
        const float s = wave_sum(pg8::dot4(a) + pg8::dot4(b)); const float rstd = 1.0f / sqrtf(s * (1.0f / 512.0f) + pg8::RMS_EPS); \
        if ((base) + j * NGW < NIT) *(GAS v4u*)(og + OFF[j]) = pg8::pack8(a * rstd * r0, b * rstd * r1); } } while (0)
    v4u owA[4], rwA[4], owB[4], rwB[4]; size_t offA[4], offB[4];
    int it0 = gw;
    if (it0 < NIT) G3_LOAD(owA, rwA, offA, it0);
    while (it0 < NIT) {
        const int it1 = it0 + 4 * NGW;
        G3_LOAD(owB, rwB, offB, it1);
        G3_PROC(owA, rwA, offA, it0);
        if (it1 >= NIT) break;
        const int it2 = it1 + 4 * NGW;
        G3_LOAD(owA, rwA, offA, it2);
        G3_PROC(owB, rwB, offB, it1);
        it0 = it2;
    }
#undef G3_LOAD
#undef G3_PROC
}

template <int VAR = 0  > __device__ __forceinline__ void swa_attn(Frame& F, const bf16* qn, const bf16* kx, const bf16* vx, const float* biasT, const float* sinks, bf16* ao) {
    LAS bf16* KS = (LAS bf16*)(F.lds);
    LAS bf16* VT = (LAS bf16*)(F.lds + 36864);
    const int tid = F.tid, lane = F.lane, g = F.wave, r16 = lane & 15, quad = lane >> 4;
    const int per = (512 + F.G - 1) / F.G;
    for (int i0 = 0; i0 < per; ++i0) {
        const int u = F.vcu * per + i0; if (u >= 512) break;
        const int b = u >> 8, kvh = (u >> 6) & 3, nb = u & 63;
        const int hq = kvh * 8 + g;
        const bf16* qp = qn + ((size_t)b * SEQ + 128 * nb + r16) * 2048 + hq * 64 + 8 * quad;
        bf16x8 Qa[8], Qb[8];
#pragma unroll
        for (int t = 0; t < 8; ++t) { Qa[t] = *(const GAS bf16x8*)(qp + (size_t)(16 * t) * 2048); Qb[t] = *(const GAS bf16x8*)(qp + (size_t)(16 * t) * 2048 + 32); }
        { const int key = tid >> 1, hh = tid & 1, kpos = 128 * (nb - 1) + key;
            v4u kv[4], vv[4];
            if (kpos >= 0) { const GAS v4u* kp = (const GAS v4u*)(kx + ((size_t)b * SEQ + kpos) * 256 + kvh * 64 + 32 * hh); const GAS v4u* vp = (const GAS v4u*)(vx + ((size_t)b * SEQ + kpos) * 256 + kvh * 64 + 32 * hh);
#pragma unroll
                for (int e = 0; e < 4; ++e) { kv[e] = kp[e]; vv[e] = vp[e]; } }
            else {
#pragma unroll
                for (int e = 0; e < 4; ++e) { kv[e] = (v4u){0u, 0u, 0u, 0u}; vv[e] = (v4u){0u, 0u, 0u, 0u}; } }
#pragma unroll
            for (int e = 0; e < 4; ++e) { *(LAS v4u*)(KS + key * 72 + 32 * hh + 8 * e) = kv[e];
                LAS bf16* vtp = VT + (32 * hh + 8 * e) * 264 + key;
                vtp[0 * 264] = (bf16)(vv[e].x & 0xffffu); vtp[1 * 264] = (bf16)(vv[e].x >> 16); vtp[2 * 264] = (bf16)(vv[e].y & 0xffffu); vtp[3 * 264] = (bf16)(vv[e].y >> 16);
                vtp[4 * 264] = (bf16)(vv[e].z & 0xffffu); vtp[5 * 264] = (bf16)(vv[e].z >> 16); vtp[6 * 264] = (bf16)(vv[e].w & 0xffffu); vtp[7 * 264] = (bf16)(vv[e].w >> 16); } }
        const float sink = sinks[hq];
        float bm[9][4];
#pragma unroll
        for (int t9 = 0; t9 < 9; ++t9)
#pragma unroll
            for (int j = 0; j < 4; ++j) { const int dist = r16 + 128 - 16 * t9 - 4 * quad - j; bm[t9][j] = (dist >= 0 && dist < 128) ? biasT[hq * 128 + (dist & 127)] : -INFINITY; }
        LDS_BAR();
#pragma unroll
        for (int qt = 0; qt < (VAR == 1 ? 0 : 8); ++qt) {
            __builtin_amdgcn_sched_barrier(0);
            const bf16x8 Q0 = Qa[qt], Q1 = Qb[qt];
            f32x4 S[9];
#pragma unroll
            for (int t9 = 0; t9 < 9; ++t9) { const LAS bf16* kp = KS + (16 * (qt + t9) + r16) * 72 + 8 * quad;
                f32x4 z = {0.f, 0.f, 0.f, 0.f}; z = MFMA16(*(const LAS bf16x8*)kp, Q0, z); S[t9] = MFMA16(*(const LAS bf16x8*)(kp + 32), Q1, z); }
            if (VAR == 3) { bf16* op3 = ao + ((size_t)b * SEQ + 128 * nb + 16 * qt + r16) * 2048 + hq * 64 + 4 * quad; float t3 = 0.f;
#pragma unroll
                for (int t9 = 0; t9 < 9; ++t9) t3 += S[t9][0] + S[t9][1] + S[t9][2] + S[t9][3];
                v2u w3; w3.x = pk2(t3, t3); w3.y = w3.x; *(GAS v2u*)op3 = w3; continue; }
            float mx = sink;
            if (nb > 0) {
#pragma unroll
                for (int t9 = 0; t9 < 9; ++t9)
#pragma unroll
                    for (int j = 0; j < 4; ++j) { const float s = S[t9][j] + bm[t9][j]; S[t9][j] = s; mx = fmaxf(mx, s); }
            } else {
#pragma unroll
                for (int t9 = 0; t9 < 9; ++t9)
#pragma unroll
                    for (int j = 0; j < 4; ++j) { const int sj = 16 * (qt + t9) + 4 * quad + j; const float s = (sj >= 128) ? S[t9][j] + bm[t9][j] : -INFINITY; S[t9][j] = s; mx = fmaxf(mx, s); }
            }
            mx = fmaxf(mx, __shfl_xor(mx, 16)); mx = fmaxf(mx, __shfl_xor(mx, 32));
            float l = 0.f;
#pragma unroll
            for (int t9 = 0; t9 < 9; ++t9)
#pragma unroll
                for (int j = 0; j < 4; ++j) { const float p = __expf(S[t9][j] - mx); S[t9][j] = p; l += p; }
            l += __shfl_xor(l, 16); l += __shfl_xor(l, 32); l += __expf(sink - mx);
            const float inv = 1.0f / l;
            f32x4 O[4];
#pragma unroll
            for (int dt = 0; dt < 4; ++dt) O[dt] = (VAR == 2) ? (f32x4){inv + S[0][0] + S[8][3], l, mx, 0.f} : (f32x4){0.f, 0.f, 0.f, 0.f};
#pragma unroll
            for (int kp5 = 0; kp5 < (VAR == 2 ? 0 : 5); ++kp5) { const int ta = 2 * kp5, tb = (2 * kp5 + 1 < 9) ? 2 * kp5 + 1 : 8;
                v4u pw; pw.x = pk2(S[ta][0] * inv, S[ta][1] * inv); pw.y = pk2(S[ta][2] * inv, S[ta][3] * inv);
                if (2 * kp5 + 1 < 9) { pw.z = pk2(S[tb][0] * inv, S[tb][1] * inv); pw.w = pk2(S[tb][2] * inv, S[tb][3] * inv); } else { pw.z = 0u; pw.w = 0u; }
                const bf16x8 P = __builtin_bit_cast(bf16x8, pw);
                const int kta = qt + ta, ktb = (qt + 2 * kp5 + 1) < 15 ? (qt + 2 * kp5 + 1) : 15;
#pragma unroll
                for (int dt = 0; dt < 4; ++dt) { const v2u lo = *(const LAS v2u*)(VT + (16 * dt + r16) * 264 + 16 * kta + 4 * quad), hi = *(const LAS v2u*)(VT + (16 * dt + r16) * 264 + 16 * ktb + 4 * quad);
                    v4u bw; bw.x = lo.x; bw.y = lo.y; bw.z = hi.x; bw.w = hi.y; O[dt] = MFMA16(__builtin_bit_cast(bf16x8, bw), P, O[dt]); } }
            bf16* op = ao + ((size_t)b * SEQ + 128 * nb + 16 * qt + r16) * 2048 + hq * 64 + 4 * quad;
#pragma unroll
            for (int dt = 0; dt < 4; ++dt) { v2u w2; w2.x = pk2(O[dt][0], O[dt][1]); w2.y = pk2(O[dt][2], O[dt][3]); *(GAS v2u*)(op + 16 * dt) = w2; }
            __builtin_amdgcn_sched_barrier(0);
        }
        LDS_BAR();
    }
}

__device__ __forceinline__ void rstd_table_fill(Frame& F, const float* ss, const pg8::StaticOrder& S) {
    pg8::Unit u0; const bool has = S.next(0, u0);
    LAS float* tab = (LAS float*)(F.lds + pg8::RSTD_LDS_OFF); LAS int* tag = (LAS int*)(F.lds + pg8::RSTD_TAG_OFF);
    if (has && F.tid < 256) { const GAS f32x4* p = (const GAS f32x4*)(ss + (size_t)(u0.pm * 256 + F.tid) * 32); float s = 0.f;
#pragma unroll
        for (int e = 0; e < 8; ++e) { const f32x4 v = p[e]; s += (v[0] + v[1]) + (v[2] + v[3]); }
        tab[F.tid] = 1.0f / sqrtf(s * (1.0f / (float)D) + pg8::RMS_EPS); }
    if (F.tid == 0) *tag = has ? u0.pm + 1 : 0;
    __syncthreads();
}
#ifndef MK_ONE_LAUNCH
#define MK_ONE_LAUNCH 1
#endif
#ifndef STREAM_BF16
#define STREAM_BF16 0
#endif
__device__ __forceinline__ bool wg_leader(int wave_s) { int l; asm volatile("v_mbcnt_lo_u32_b32 %0, -1, 0\n\tv_mbcnt_hi_u32_b32 %0, -1, %0" : "=v"(l)); return wave_s == 0 && l == 0; }
template <class T> __device__ __forceinline__ T* opq(T* p) { asm volatile("" : "+s"(p)); return p; }
__device__ __forceinline__ int opqi(int v) { asm volatile("" : "+s"(v)); return v; }
struct Args { const float* in[21]; float* out; unsigned char* ws; int ph_lo, ph_hi; };
#define HB0_ ((bf16*)(ws + WS_HB))
#define HB1_ ((bf16*)(ws + WS_HB) + (size_t)M * D)
#define SS0_ ((float*)(ws + WS_SS))
#define SS1_ ((float*)(ws + WS_SS) + (size_t)M * 32)
typedef const __attribute__((address_space(4))) Args* KArgs;
__device__ __forceinline__ KArgs kargs() { KArgs p = (KArgs)__builtin_amdgcn_kernarg_segment_ptr(); asm volatile("" : "+s"(p)); return p; }
#if MK_ONE_LAUNCH
#define SEAM(p) do { if ((p) + 1 < hi) { XcdBarrier bar_; bar_.bar = (unsigned*)((gu32*)(kargs()->ws + WS_CTL) + CW_BAR); bar_.x = xb_xcc_id(); bar_.lead = wg_leader(wv_); bar_.st = (volatile LAS unsigned*)((LAS unsigned char*)lds + MISC_OFF) + 8; xcd_barrier(bar_); } } while (0)
#define FORCE_BAR2() do { XcdBarrier bar_; bar_.bar = (unsigned*)((gu32*)(kargs()->ws + WS_CTL) + CW_BAR); bar_.x = xb_xcc_id(); bar_.lead = wg_leader(wv_); bar_.st = (volatile LAS unsigned*)((LAS unsigned char*)lds + MISC_OFF) + 8; xcd_barrier(bar_); } while (0)
#else
#define SEAM(p) do { } while (0)
#endif
#define IN(k) (lo <= (k) && (k) < hi)
#define PH_LOCALS const KArgs ap = kargs(); unsigned char* const ws = ap->ws; float* const out = ap->out; const int G_ = opqi((int)gridDim.x); const int bx_ = opqi((int)blockIdx.x); (void)out; (void)G_; (void)bx_; \
    Frame Fp; { int t_ = (wv_ << 6) | pg8::stg_lane(); asm volatile("" : "+v"(t_)); Fp.lds = (LAS unsigned char*)lds; Fp.MISC = nullptr; Fp.ctl = nullptr; Fp.tid = t_; Fp.lane = t_ & 63; Fp.wave = __builtin_amdgcn_readfirstlane(t_ >> 6); Fp.G = G_; Fp.vcu = (G_ % 8 == 0) ? (bx_ % 8) * (G_ / 8) + bx_ / 8 : bx_; } \
    const pg8::Stg SG_ = (LAS unsigned*)((LAS unsigned char*)lds + STG_OFF + Fp.wave * pg8::STG_BYTES); (void)SG_

template <int L, bool RR = false> __device__ __forceinline__ void layer_body(const int lo, const int hi, const int wv_) {
    extern __shared__ __attribute__((aligned(16))) unsigned char lds[];
#ifndef PROBE_DBLBAR
#define PROBE_DBLBAR 0
#endif
#ifndef PROBE_G1_VAR
#define PROBE_G1_VAR 0
#endif
#ifndef PROBE_SCAN_VAR
#define PROBE_SCAN_VAR 0
#endif
#ifndef PROBE_ATTN_VAR
#define PROBE_ATTN_VAR 0
#endif
#ifndef MK_KS
#define MK_KS 0
#endif
#if MK_KS
#define GEMM_SEL(EPI, DIAGV) pg8::gemm_phase_ks<EPI, pg8::StaticOrder, AL>
#else
#define GEMM_SEL(EPI, DIAGV) pg8::gemm_phase<EPI, pg8::StaticOrder, AL, SP, DIAGV>
#endif
#ifndef MK_WGM_SQ
#define MK_WGM_SQ 8
#endif
#ifndef MK_WGM_UP
#define MK_WGM_UP 8
#endif
#ifndef MK_DOWN_DIAG
#define MK_DOWN_DIAG 0
#endif
#ifndef MK_AL
#define MK_AL true
#endif
#ifndef MK_SP
#define MK_SP true
#endif
    constexpr bool AL = MK_AL, SP = MK_SP;
        const int p0 = 1 + 10 * L;
        if (IN(p0 + 0)) { PH_LOCALS;
            { pg8::Gemm g{HB0_, (const bf16*)(ws + WS_WUP) + (size_t)(2 * L) * NUP * D, M, NUP, D, D}; pg8::StaticOrder S; S.init(M, NUP, G_, bx_, MK_WGM_UP); auto pre_ = [&]() { rstd_table_fill(Fp, SS0_, S); };
              pg8::EpiSwiGLU E{(bf16*)(ws + WS_ACT), SS0_};
              GEMM_SEL(pg8::EpiSwiGLU, 0)(Fp.lds + RING_OFF, g, S, E, Fp.tid, pre_); }
            if (L == 2) { pg8::Gemm g{HB0_, (const bf16*)(ws + WS_WKV), M, 512, D, D}; pg8::StaticOrder S; S.init(M, 512, G_, bx_); auto pre_ = [&]() { rstd_table_fill(Fp, SS0_, S); };
              pg8::EpiHeadNorm E{(bf16*)(ws + WS_KX), (bf16*)(ws + WS_VX), 256, SS0_, (ap->in[15]), 1.0f, 1};
              GEMM_SEL(pg8::EpiHeadNorm, 0)(Fp.lds + RING_OFF, g, S, E, Fp.tid, pre_); }
            if (L == 2 && G_ == 256 && bx_ >= 128) { pg8::Gemm g{(const bf16*)(ws + WS_PB) + (size_t)L * M * PLE, (const bf16*)(ws + WS_WPLE) + (size_t)L * D * PLE, M, D, opqi(PLE), PLE}; pg8::StaticOrder S; S.init(M, D, 128, bx_ - 128, MK_WGM_SQ);
              pg8::EpiPlainBf16 E{(bf16*)(ws + WS_PP), D};
              GEMM_SEL(pg8::EpiPlainBf16, 0)(Fp.lds + RING_OFF, g, S, E, Fp.tid); }
            SEAM(p0 + 0);
        }
        if (IN(p0 + 1)) { PH_LOCALS;
            pg8::Gemm g{(const bf16*)(ws + WS_ACT), (const bf16*)(ws + WS_WDN) + (size_t)(2 * L) * D * LDF, M, D, FF, LDF}; pg8::StaticOrder S; S.init(M, D, G_, bx_, 4);
#ifdef PROBE_AMASK
            if (RR) { g.pm_mask = PROBE_AMASK; g.pn_mask = PROBE_BMASK; }
#endif
#if STREAM_BF16
            typedef pg8::EpiResid_T<(L > 0) || RR, false> EpiD1;
#else
            typedef pg8::EpiResid EpiD1;
#endif
            EpiD1 E{(L == 0 && !RR) ? (ap->in[0]) : out, out, HB1_, SS1_, HB0_, RR ? 0.f : 0.5f};
            GEMM_SEL(EpiD1, MK_DOWN_DIAG)(Fp.lds + RING_OFF, g, S, E, Fp.tid);
            SEAM(p0 + 1);
        }
        if (L < 2) {
            if (IN(p0 + 2)) { PH_LOCALS;
                pg8::Gemm g{HB1_, (const bf16*)(ws + WS_WIN) + (size_t)L * NIN * D, M, NIN, D, D}; pg8::StaticOrder S; S.init(M, NIN, G_, bx_); auto pre_ = [&]() { rstd_table_fill(Fp, SS1_, S); };
                pg8::EpiInProj E{(bf16*)(ws + WS_QB), (bf16*)(ws + WS_KB), (bf16*)(ws + WS_VB), (bf16*)(ws + WS_RB), SS1_};
                GEMM_SEL(pg8::EpiInProj, 0)(Fp.lds + RING_OFF, g, S, E, Fp.tid, pre_);
                gla_a1(Fp, HB1_, SS1_, (const bf16*)(ws + WS_WA1) + (size_t)L * 16 * D, (float*)(ws + WS_A1));
                SEAM(p0 + 2);
            }
            if (IN(p0 + 3)) { PH_LOCALS; gla_g1<RR ? PROBE_G1_VAR : 0>(Fp, (const bf16*)(ws + WS_QB), (const bf16*)(ws + WS_KB), (const float*)(ws + WS_A1), (ap->in[9]) + (size_t)L * 16 * 1024, (ap->in[10]) + L * 1024, (bf16*)(ws + WS_QD), (bf16*)(ws + WS_KDT), (bf16*)(ws + WS_AT), (float*)(ws + WS_DEC)); SEAM(p0 + 3); }
            if (IN(p0 + 4)) { PH_LOCALS; gla_scan<RR ? PROBE_SCAN_VAR : 0>(Fp, (const bf16*)(ws + WS_QD), (const bf16*)(ws + WS_KDT), (const bf16*)(ws + WS_AT), (const float*)(ws + WS_DEC), (const bf16*)(ws + WS_VB), (bf16*)(ws + WS_OB)); SEAM(p0 + 4); }
            if (IN(p0 + 5)) { PH_LOCALS; gla_g3(Fp, (const bf16*)(ws + WS_OB), (const bf16*)(ws + WS_RB), (bf16*)(ws + WS_OG)); SEAM(p0 + 5); }
        } else {
            if (IN(p0 + 2)) { PH_LOCALS;
                pg8::Gemm g{HB1_, (const bf16*)(ws + WS_WQ) + (size_t)(L - 2) * D * D, M, D, D, D}; pg8::StaticOrder S; S.init(M, D, G_, bx_, MK_WGM_SQ); auto pre_ = [&]() { rstd_table_fill(Fp, SS1_, S); };
                pg8::EpiHeadNorm E{(bf16*)(ws + WS_QN), nullptr, 2048, SS1_, (ap->in[18]) + (L - 2) * 64, 0.125f, 8};
                GEMM_SEL(pg8::EpiHeadNorm, 0)(Fp.lds + RING_OFF, g, S, E, Fp.tid, pre_);
                SEAM(p0 + 2);
            }
            if (IN(p0 + 3)) { PH_LOCALS; swa_attn<RR ? PROBE_ATTN_VAR : 0>(Fp, (const bf16*)(ws + WS_QN), (const bf16*)(ws + WS_KX), (const bf16*)(ws + WS_VX), (const float*)(ws + WS_BIAST), (ap->in[19]) + (L - 2) * 32, (bf16*)(ws + WS_AO)); SEAM(p0 + 3); }
        }
        if (IN(p0 + 6)) { PH_LOCALS;
            pg8::Gemm g{L < 2 ? (const bf16*)(ws + WS_OG) : (const bf16*)(ws + WS_AO), L < 2 ? (const bf16*)(ws + WS_WGO) + (size_t)L * D * D : (const bf16*)(ws + WS_WSO) + (size_t)(L - 2) * D * D, M, D, D, D};
            pg8::StaticOrder S; S.init(M, D, G_, bx_, MK_WGM_SQ);
#if STREAM_BF16
            typedef pg8::EpiResid_T<true, false> EpiO;
#else
            typedef pg8::EpiResid EpiO;
#endif
            EpiO E{out, out, HB0_, SS0_, HB1_, RR ? 0.f : 1.0f};
            GEMM_SEL(EpiO, 0)(Fp.lds + RING_OFF, g, S, E, Fp.tid);
            SEAM(p0 + 6);
        }
        if (IN(p0 + 7)) { PH_LOCALS;
#ifdef PROBE_CLOCK
            unsigned long long pc_t0 = 0, pc_r0 = 0; if (L == 0) { pc_t0 = __builtin_readcyclecounter(); pc_r0 = __builtin_amdgcn_s_memrealtime(); }
#endif
            pg8::Gemm g{HB0_, (const bf16*)(ws + WS_WUP) + (size_t)(2 * L + 1) * NUP * D, M, NUP, D, D}; pg8::StaticOrder S; S.init(M, NUP, G_, bx_, MK_WGM_UP); auto pre_ = [&]() { rstd_table_fill(Fp, SS0_, S); };
#ifdef PROBE_NOEPI
            typedef pg8::EpiSwiGLU_T<RR> EpiUp2;
#else
            typedef pg8::EpiSwiGLU EpiUp2;
#endif
            EpiUp2 E{(bf16*)(ws + WS_ACT), SS0_};
#ifdef PROBE_SPLITUP
            { pg8::OffsetOrder S1; S1.init(M, NUP, G_, bx_, MK_WGM_UP); S1.off = 0; S1.cnt = 6; pg8::gemm_phase<EpiUp2, pg8::OffsetOrder, AL, SP>(Fp.lds + RING_OFF, g, S1, E, Fp.tid);
              FORCE_BAR2();
              pg8::OffsetOrder S2; S2.init(M, NUP, G_, bx_, MK_WGM_UP); S2.off = 6; S2.cnt = 5; pg8::gemm_phase<EpiUp2, pg8::OffsetOrder, AL, SP>(Fp.lds + RING_OFF, g, S2, E, Fp.tid); }
#elif defined(PROBE_DIAG)
            GEMM_SEL(EpiUp2, RR ? PROBE_DIAG : 0)(Fp.lds + RING_OFF, g, S, E, Fp.tid);
#else
            GEMM_SEL(EpiUp2, 0)(Fp.lds + RING_OFF, g, S, E, Fp.tid, pre_);
#endif
#ifdef PROBE_CLOCK
            if (L == 0 && bx_ == 0 && Fp.tid == 0) { const unsigned long long dt = __builtin_readcyclecounter() - pc_t0, dr = __builtin_amdgcn_s_memrealtime() - pc_r0;
                ((float*)(ws + WS_CTL))[200000] = (float)dt / (float)dr * 0.1f; }
#endif
            SEAM(p0 + 7);
        }
        if (IN(p0 + 8)) {
            { PH_LOCALS; pg8::Gemm g{(const bf16*)(ws + WS_ACT), (const bf16*)(ws + WS_WDN) + (size_t)(2 * L + 1) * D * LDF, M, D, FF, LDF}; pg8::StaticOrder S; S.init(M, D, G_, bx_, 4);
#if STREAM_BF16
              typedef pg8::EpiResid_T<true, false> EpiD2;
#else
              typedef pg8::EpiResid EpiD2;
#endif
              EpiD2 E{out, out, HB1_, SS1_, HB0_, RR ? 0.f : 0.5f};
              GEMM_SEL(EpiD2, MK_DOWN_DIAG)(Fp.lds + RING_OFF, g, S, E, Fp.tid); }
            SEAM(p0 + 8);
        }
        if (IN(p0 + 9)) {
            { PH_LOCALS; if (!(L == 2 && G_ == 256)) {
              pg8::Gemm g{(const bf16*)(ws + WS_PB) + (size_t)L * M * PLE, (const bf16*)(ws + WS_WPLE) + (size_t)L * D * PLE, M, D, opqi(PLE), PLE}; pg8::StaticOrder S; S.init(M, D, G_, bx_, MK_WGM_SQ);
              pg8::EpiPlainBf16 E{(bf16*)(ws + WS_PP), D};
              GEMM_SEL(pg8::EpiPlainBf16, 0)(Fp.lds + RING_OFF, g, S, E, Fp.tid); } }
          { PH_LOCALS;
            pg8::Gemm g{HB1_, (const bf16*)(ws + WS_WGATE) + (size_t)L * D * D, M, D, D, D}; pg8::StaticOrder S; S.init(M, D, G_, bx_, MK_WGM_SQ); auto pre_ = [&]() { rstd_table_fill(Fp, SS1_, S); };
#if STREAM_BF16
            typedef pg8::EpiPleGate_T<true, L == DEPTH - 1> EpiG;
#else
            typedef pg8::EpiPleGate EpiG;
#endif
            EpiG E{out, HB0_, SS1_, SS0_, (const bf16*)(ws + WS_PP), HB1_};
            GEMM_SEL(EpiG, 0)(Fp.lds + RING_OFF, g, S, E, Fp.tid, pre_); }
            SEAM(p0 + 9);
        }
    }

__global__ void __launch_bounds__(NWAVES * 64, 2) yoco_fwd(Args args_unused_) {
    extern __shared__ __attribute__((aligned(16))) unsigned char lds[];
    Frame F;
    F.lds = (LAS unsigned char*)lds;
    F.MISC = (volatile LAS unsigned*)(F.lds + MISC_OFF);
    F.tid = threadIdx.x; F.lane = F.tid & 63; F.wave = __builtin_amdgcn_readfirstlane(F.tid >> 6);
    const int wv_ = F.wave;
    F.G = gridDim.x; { const int bx = blockIdx.x; F.vcu = (F.G % 8 == 0) ? (bx % 8) * (F.G / 8) + bx / 8 : bx; }
    F.ctl = nullptr;
    for (int u = F.tid; u < (LDS_BYTES - LDSCTL_OFF) / 4; u += NWAVES * 64) ((LAS unsigned*)(F.lds + LDSCTL_OFF))[u] = 0u;
    __syncthreads();
    const int lo = kargs()->ph_lo, hi = kargs()->ph_hi;
#if MK_ONE_LAUNCH
    { unsigned char* ws0 = kargs()->ws; (void)xcd_barrier_post((unsigned*)((gu32*)(ws0 + WS_CTL) + CW_BAR), (volatile LAS unsigned*)((LAS unsigned char*)lds + MISC_OFF) + 8, wg_leader(wv_)); }
#endif
#ifndef PROBE_DBLBAR
#define PROBE_DBLBAR 0
#endif
#ifndef PROBE_SCAN_VAR
#define PROBE_SCAN_VAR 0
#endif
#ifndef PROBE_ATTN_VAR
#define PROBE_ATTN_VAR 0
#endif
#ifndef MK_WGM_SQ
#define MK_WGM_SQ 8
#endif
#ifndef MK_WGM_UP
#define MK_WGM_UP 8
#endif
#ifndef MK_DOWN_DIAG
#define MK_DOWN_DIAG 0
#endif
#ifndef MK_AL
#define MK_AL true
#endif
#ifndef MK_SP
#define MK_SP true
#endif
    constexpr bool AL = MK_AL, SP = MK_SP;

    if (IN(0)) { PH_LOCALS;
        In I; I.x = ap->in[0]; I.p = ap->in[1]; I.norm_g = ap->in[2]; I.ffn_wg = ap->in[3]; I.ffn_wu = ap->in[4]; I.ffn_wd = ap->in[5]; I.ple_w = ap->in[6]; I.ple_gate_w = ap->in[7];
        I.gla_w_in = ap->in[8]; I.gla_w_a2 = ap->in[9]; I.gla_b_a = ap->in[10]; I.gla_norm_g = ap->in[11]; I.gla_w_o = ap->in[12]; I.kv_norm_g = ap->in[13]; I.w_kv = ap->in[14]; I.k_norm_g = ap->in[15];
        I.rel_bias = ap->in[16]; I.swa_w_q = ap->in[17]; I.q_norm_g = ap->in[18]; I.sinks = ap->in[19]; I.swa_w_o = ap->in[20];
        p0_prologue(Fp, I, ws); SEAM(0); }

#ifndef PROBE_SLOT
#define PROBE_SLOT (-1)
#endif
#ifndef PROBE_LAYERS
#define PROBE_LAYERS 0
#endif
#ifndef PROBE_PROLOGUE
#define PROBE_PROLOGUE 0
#endif
#define FORCE_BAR() do { XcdBarrier bar_; bar_.bar = (unsigned*)((gu32*)(kargs()->ws + WS_CTL) + CW_BAR); bar_.x = xb_xcc_id(); bar_.lead = wg_leader(wv_); bar_.st = (volatile LAS unsigned*)((LAS unsigned char*)lds + MISC_OFF) + 8; xcd_barrier(bar_); } while (0)
#define LAYER(L_) do { layer_body<L_>(lo, hi, wv_); \
    if (PROBE_SLOT >= 0 && ((PROBE_LAYERS >> L_) & 1)) { FORCE_BAR(); layer_body<L_, true>(1 + 10 * L_ + PROBE_SLOT, 1 + 10 * L_ + PROBE_SLOT + 1, wv_); FORCE_BAR(); } } while (0)
    if (PROBE_PROLOGUE) { PH_LOCALS;
        In I; I.x = ap->in[0]; I.p = ap->in[1]; I.norm_g = ap->in[2]; I.ffn_wg = ap->in[3]; I.ffn_wu = ap->in[4]; I.ffn_wd = ap->in[5]; I.ple_w = ap->in[6]; I.ple_gate_w = ap->in[7];
        I.gla_w_in = ap->in[8]; I.gla_w_a2 = ap->in[9]; I.gla_b_a = ap->in[10]; I.gla_norm_g = ap->in[11]; I.gla_w_o = ap->in[12]; I.kv_norm_g = ap->in[13]; I.w_kv = ap->in[14]; I.k_norm_g = ap->in[15];
        I.rel_bias = ap->in[16]; I.swa_w_q = ap->in[17]; I.q_norm_g = ap->in[18]; I.sinks = ap->in[19]; I.swa_w_o = ap->in[20];
        p0_prologue(Fp, I, ws); FORCE_BAR(); }
    LAYER(0); LAYER(1); LAYER(2); LAYER(3);
#ifdef PROBE_CLOCK
    FORCE_BAR();
    if (blockIdx.x == 0 && wg_leader(wv_)) { unsigned char* ws = kargs()->ws; float* out = kargs()->out; out[0] += ((const float*)(ws + WS_CTL))[200000] * 0.125f; }
#endif
#undef IN
#undef SEAM
}

extern "C" void kernel_launch(void* const* d_in, const int* in_sizes, int n_in, void* d_out, int out_size, void* d_ws, size_t ws_size, hipStream_t stream) {
    static int grid = 0;
    if (grid == 0) {
        if (n_in != 21 || in_sizes[0] != M * D || out_size != M * D || ws_size < WS_END) { fprintf(stderr, "kernel_launch: unexpected shapes (n_in %d, in0 %d, out %d, ws %zu < %zu); nothing launched\n", n_in, n_in > 0 ? in_sizes[0] : -1, out_size, ws_size, (size_t)WS_END); grid = -1; return; }
        int dev = 0, cus = 0, per_cu = 0;
        if (hipGetDevice(&dev) != hipSuccess || hipDeviceGetAttribute(&cus, hipDeviceAttributeMultiprocessorCount, dev) != hipSuccess) { grid = -1; return; }
        if (hipFuncSetAttribute((const void*)yoco_fwd, hipFuncAttributeMaxDynamicSharedMemorySize, LDS_BYTES) != hipSuccess) { fprintf(stderr, "kernel_launch: hipFuncSetAttribute failed\n"); grid = -1; return; }
        if (hipOccupancyMaxActiveBlocksPerMultiprocessor(&per_cu, (const void*)yoco_fwd, NWAVES * 64, LDS_BYTES) != hipSuccess || per_cu < 1) fprintf(stderr, "kernel_launch: occupancy query reports %d blocks per CU\n", per_cu);
        (void)hipGetLastError();
        grid = cus;
    }
    if (grid < 0) return;
    if (hipMemsetAsync((char*)d_ws + WS_CTL, 0, CTL_ZERO_BYTES, stream) != hipSuccess) return;
    Args a{};
    for (int i = 0; i < 21; ++i) a.in[i] = (const float*)d_in[i];
    a.out = (float*)d_out; a.ws = (unsigned char*)d_ws;
#if MK_ONE_LAUNCH
    a.ph_lo = 0; a.ph_hi = NPH;
    hipLaunchKernelGGL(yoco_fwd, dim3(grid), dim3(NWAVES * 64), LDS_BYTES, stream, a);
#else
    for (int ph = 0; ph < NPH; ++ph) {
        const int k = (ph - 1) % 10, L = (ph - 1) / 10;
        if (ph > 0 && L >= 2 && (k == 4 || k == 5)) continue;
        a.ph_lo = ph; a.ph_hi = ph + 1;
        hipLaunchKernelGGL(yoco_fwd, dim3(grid), dim3(NWAVES * 64), LDS_BYTES, stream, a);
    }
#endif
}
```
